# Optimizing an MI355X kernel written in HIP

```python
import jax, jax.numpy as jnp
from jax import lax
import numpy as np

D_MODEL = 1024
BATCH = 2
SEQ = 8192
DEPTH = 1

N_META = 16
GRID_W = 64
EXPAND = 2
D_MIX = EXPAND * D_MODEL
GLA_WIDTH = D_MIX // 2
GLA_HEADS = 4
GLA_DV = GLA_WIDTH // GLA_HEADS
GLA_DK = GLA_DV // 2
GLA_KEY_WIDTH = GLA_HEADS * GLA_DK
GLA_GATE_RANK = 16
GLA_TAU = 16.0
GLA_CHUNK = 64
NA_WIDTH = D_MIX - GLA_WIDTH
NA_HEAD_DIM = 64
NA_HEADS = NA_WIDTH // NA_HEAD_DIM
NA_WIN_H_MAX = 8
NA_WIN_W = 16
RMS_EPS = 1e-6

IN_SPLIT_WIDTHS = (GLA_KEY_WIDTH, GLA_KEY_WIDTH, GLA_WIDTH, GLA_GATE_RANK, GLA_GATE_RANK, GLA_WIDTH,
                   NA_WIDTH, NA_WIDTH, NA_WIDTH, NA_WIDTH)
D_IN_PROJ = sum(IN_SPLIT_WIDTHS)

kernel_name = "hybrid_gla_natten_meta_encoder"


def _rmsnorm(x, g):
    xf = x.astype(jnp.float32)
    y = xf * lax.rsqrt(jnp.mean(xf * xf, axis=-1, keepdims=True) + RMS_EPS)
    return (y * g.astype(jnp.float32)).astype(x.dtype)


def _gla_chunked(q, k, v, g):
    B, T, H, DK = q.shape
    DV = v.shape[-1]
    C = GLA_CHUNK
    N = T // C
    q = q.reshape(B, N, C, H, DK)
    k = k.reshape(B, N, C, H, DK)
    v = v.reshape(B, N, C, H, DV)
    G = jnp.cumsum(g.astype(jnp.float32).reshape(B, N, C, H, DK), axis=2)
    G_last = G[:, :, -1:]
    q_in = q * jnp.exp(G)
    k_in = k * jnp.exp(-G)
    k_st = k * jnp.exp(G_last - G)
    mask = jnp.tril(jnp.ones((C, C), dtype=bool))
    A = jnp.einsum('bnihd,bnjhd->bnhij', q_in, k_in)
    A = jnp.where(mask, A, 0.0)
    o_intra = jnp.einsum('bnhij,bnjhv->bnihv', A, v)
    U = jnp.einsum('bnjhd,bnjhv->bnhdv', k_st, v)
    a = jnp.exp(G_last[:, :, 0])

    def step(S, inp):
        a_n, U_n = inp
        return a_n[..., None] * S + U_n, S

    S0 = jnp.zeros((B, H, DK, DV), dtype=U.dtype)
    _, S_prev = lax.scan(step, S0, (jnp.moveaxis(a, 1, 0), jnp.moveaxis(U, 1, 0)))
    S_prev = jnp.moveaxis(S_prev, 0, 1)
    o_inter = jnp.einsum('bnihd,bnhdv->bnihv', q_in, S_prev)
    return (o_intra + o_inter).reshape(B, T, H, DV).astype(v.dtype)


def _neighbourhood_attention(q, k, v, qm, km, vm, rpb, meta_bias):
    B, R, W, H, D = q.shape
    wh = min(NA_WIN_H_MAX, R)
    ww = NA_WIN_W
    scale = D ** -0.5
    cols = jnp.arange(W)
    cs = jnp.clip(cols - ww // 2, 0, W - ww)
    col_idx = cs[:, None] + jnp.arange(ww)[None, :]
    col_bias_idx = col_idx - cols[:, None] + (NA_WIN_W - 1)
    mb = meta_bias[None, :, None, :]

    def row_block(r):
        rs = jnp.clip(r - wh // 2, 0, R - wh)
        q_r = lax.dynamic_index_in_dim(q, r, axis=1, keepdims=False)
        k_blk = lax.dynamic_slice_in_dim(k, rs, wh, axis=1)
        v_blk = lax.dynamic_slice_in_dim(v, rs, wh, axis=1)
        k_g = k_blk[:, :, col_idx]
        v_g = v_blk[:, :, col_idx]
        s_loc = jnp.einsum('bchd,bicjhd->bhcij', q_r, k_g) * scale
        row_bias_idx = rs + jnp.arange(wh) - r + (NA_WIN_H_MAX - 1)
        bias = rpb[:, row_bias_idx][:, :, col_bias_idx]
        s_loc = s_loc + jnp.transpose(bias, (0, 2, 1, 3))[None]
        s_meta = jnp.einsum('bchd,bmhd->bhcm', q_r, km) * scale + mb
        s = jnp.concatenate([s_loc.reshape(B, H, W, wh * ww), s_meta], axis=-1)
        p = jax.nn.softmax(s.astype(jnp.float32), axis=-1).astype(v.dtype)
        p_loc = p[..., :wh * ww].reshape(B, H, W, wh, ww)
        p_meta = p[..., wh * ww:]
        return (jnp.einsum('bhcij,bicjhd->bchd', p_loc, v_g)
                + jnp.einsum('bhcm,bmhd->bchd', p_meta, vm))

    o = lax.map(row_block, jnp.arange(R))
    o = jnp.moveaxis(o, 0, 1)
    s_mm = jnp.einsum('bqhd,bmhd->bhqm', qm, km) * scale + mb
    p_mm = jax.nn.softmax(s_mm.astype(jnp.float32), axis=-1).astype(vm.dtype)
    om = jnp.einsum('bhqm,bmhd->bqhd', p_mm, vm)
    return o, om


def setup_inputs(seed: int = 0) -> dict:
    key = jax.random.key(seed)
    ks = jax.random.split(key, 16)
    f32 = jnp.float32
    nrm = lambda k, s, sc: jax.random.normal(k, s, f32) * sc
    return {
        "x": nrm(ks[0], (BATCH, SEQ, D_MODEL), 1.0),
        "meta_tokens": nrm(ks[1], (N_META, D_MODEL), 1.0),
        "norm_g": 1.0 + nrm(ks[2], (DEPTH, D_MODEL), 0.02),
        "w_in": nrm(ks[3], (DEPTH, D_MODEL, D_IN_PROJ), D_MODEL ** -0.5),
        "w_decay_fwd": nrm(ks[4], (DEPTH, GLA_GATE_RANK, GLA_KEY_WIDTH), GLA_GATE_RANK ** -0.5),
        "b_decay_fwd": nrm(ks[5], (DEPTH, GLA_KEY_WIDTH), 0.1),
        "w_decay_bwd": nrm(ks[6], (DEPTH, GLA_GATE_RANK, GLA_KEY_WIDTH), GLA_GATE_RANK ** -0.5),
        "b_decay_bwd": nrm(ks[7], (DEPTH, GLA_KEY_WIDTH), 0.1),
        "gla_out_norm_g": 1.0 + nrm(ks[8], (DEPTH, GLA_DV), 0.02),
        "q_norm_g": 1.0 + nrm(ks[9], (DEPTH, NA_HEAD_DIM), 0.02),
        "k_norm_g": 1.0 + nrm(ks[10], (DEPTH, NA_HEAD_DIM), 0.02),
        "rpb": nrm(ks[11], (DEPTH, NA_HEADS, 2 * NA_WIN_H_MAX - 1, 2 * NA_WIN_W - 1), 0.02),
        "meta_bias": nrm(ks[12], (DEPTH, NA_HEADS, N_META), 0.02),
        "w_out": nrm(ks[13], (DEPTH, D_MIX, D_MODEL), D_MIX ** -0.5),
    }


def reference(x, meta_tokens, norm_g, w_in, w_decay_fwd, b_decay_fwd, w_decay_bwd, b_decay_bwd,
              gla_out_norm_g, q_norm_g, k_norm_g, rpb, meta_bias, w_out):
    B, S, _ = x.shape
    R = S // GRID_W
    L = N_META + S
    pad = GLA_CHUNK - N_META
    split_at = [int(v) for v in np.cumsum(IN_SPLIT_WIDTHS)[:-1]]
    h = jnp.concatenate([jnp.broadcast_to(meta_tokens[None], (B, N_META, D_MODEL)).astype(x.dtype), x], axis=1)

    def pad_front(t):
        return jnp.pad(t, ((0, 0), (pad, 0), (0, 0), (0, 0)))

    def flip(t):
        return jnp.flip(t, axis=1)

    for l in range(DEPTH):
        u = _rmsnorm(h, norm_g[l])
        z = u @ w_in[l]
        gq, gk, gv, r_f, r_b, g_gate, nq, nk, nv, n_gate = jnp.split(z, split_at, axis=-1)

        q = (gq * GLA_DK ** -0.5).reshape(B, L, GLA_HEADS, GLA_DK)
        k = gk.reshape(B, L, GLA_HEADS, GLA_DK)
        v = gv.reshape(B, L, GLA_HEADS, GLA_DV)
        lg_f = (jax.nn.log_sigmoid(r_f @ w_decay_fwd[l] + b_decay_fwd[l]) / GLA_TAU).reshape(B, L, GLA_HEADS, GLA_DK)
        lg_b = (jax.nn.log_sigmoid(r_b @ w_decay_bwd[l] + b_decay_bwd[l]) / GLA_TAU).reshape(B, L, GLA_HEADS, GLA_DK)
        qp, kp, vp = pad_front(q), pad_front(k), pad_front(v)
        o_f = _gla_chunked(qp, kp, vp, pad_front(lg_f))
        o_b = flip(_gla_chunked(flip(qp), flip(kp), flip(vp), flip(pad_front(lg_b))))
        o_gla = _rmsnorm((o_f + o_b)[:, pad:], gla_out_norm_g[l]).reshape(B, L, GLA_WIDTH)
        o_gla = o_gla * jax.nn.silu(g_gate)

        qn = _rmsnorm(nq.reshape(B, L, NA_HEADS, NA_HEAD_DIM), q_norm_g[l])
        kn = _rmsnorm(nk.reshape(B, L, NA_HEADS, NA_HEAD_DIM), k_norm_g[l])
        vn = nv.reshape(B, L, NA_HEADS, NA_HEAD_DIM)
        grid = lambda t: t[:, N_META:].reshape(B, R, GRID_W, NA_HEADS, NA_HEAD_DIM)
        o_grid, o_meta = _neighbourhood_attention(grid(qn), grid(kn), grid(vn),
                                                  qn[:, :N_META], kn[:, :N_META], vn[:, :N_META],
                                                  rpb[l], meta_bias[l])
        o_na = jnp.concatenate([o_meta, o_grid.reshape(B, S, NA_HEADS, NA_HEAD_DIM)], axis=1).reshape(B, L, NA_WIDTH)
        o_na = o_na * jax.nn.silu(n_gate)

        h = h + jnp.concatenate([o_gla, o_na], axis=-1) @ w_out[l]

    return h[:, N_META:]
```

```cpp
#include <hip/hip_runtime.h>
#include <hip/hip_cooperative_groups.h>
#include <cstdio>
#include <cstdint>
namespace cg = cooperative_groups;
namespace pg8 {
#define PG8_LAS __attribute__((address_space(3)))
typedef unsigned short bf16_t;
typedef short bf16x8 __attribute__((ext_vector_type(8)));
typedef float f32x4 __attribute__((ext_vector_type(4)));
typedef unsigned u32x4 __attribute__((ext_vector_type(4)));
constexpr int BM = 256, BK = 64, HALF = 128, HTB = HALF * BK * 2  , STAGE_BYTES = 8 * HTB, NXCD = 8, WGM = 8;

__host__ __device__ __forceinline__ int lds_byte(int r, int c) { const int st = (r >> 4) * 2 + (c >> 5), rr = r & 15, cc = c & 31, ob = rr * 64 + cc * 2; return st * 1024 + (ob ^ (((ob >> 9) & 1) << 5)); }
__host__ __device__ __forceinline__ void stage_rc(int b, int& R, int& C) { const int st = b / 1024, sb = b % 1024, swz = sb ^ (((sb >> 9) & 1) << 5); R = (st >> 1) * 16 + swz / 64; C = (st & 1) * 32 + (swz % 64) / 2; }
__host__ __device__ __forceinline__ int perm32(int rho) { const int n = rho >> 4, i = rho & 15; return 8 * (i >> 2) + 4 * n + (i & 3); }

struct Unit { int pm, pn; };
struct Gemm { const bf16_t* A; const bf16_t* Bt; int M, N, K; };

struct StaticOrder {
    int nM, nN, nwg, G, c;
    __host__ __device__ void init(int M, int N, int G_, int c_) { nM = M / BM; nN = N / BM; nwg = nM * nN; G = G_; c = c_; }
    __host__ __device__ bool next(int i, Unit& u) const {
        const long L = (long)i * G + c; if (L >= nwg) return false;
        int wgid = (int)L; { const int q = nwg / NXCD, r = nwg % NXCD, xcd = wgid % NXCD, off = wgid / NXCD; wgid = (xcd < r ? xcd * (q + 1) : r * (q + 1) + (xcd - r) * q) + off; }
        const int nig = WGM * nN, gid = wgid / nig, fm = gid * WGM, gsz = (nM - fm) < WGM ? (nM - fm) : WGM;
        u.pm = fm + ((wgid % nig) % gsz); u.pn = (wgid % nig) / gsz; return true;
    }
    __device__ __forceinline__ void a_ready(const Unit&) const {}
    __device__ __forceinline__ void done(const Unit&) const {}
};

__device__ __forceinline__ unsigned cvt_pk_bf16(float lo, float hi) { unsigned r; asm volatile("v_cvt_pk_bf16_f32 %0, %1, %2" : "=v"(r) : "v"(lo), "v"(hi)); return r; }
template <class Epi, class Sched, bool ALIGN_EPI = false, bool SP2 = false>
__device__ __forceinline__ void gemm_phase(PG8_LAS unsigned char* lds, const Gemm g, const Sched& S, const Epi& E) {
    const int tid = threadIdx.x, wid = __builtin_amdgcn_readfirstlane(tid >> 6), lane = tid & 63, wr = wid >> 2, wc = wid & 3, fr = lane & 15, fq = lane >> 4;
    const int K = g.K, nt = K / BK;
    unsigned voffA[2], voffB[2];
#pragma unroll
    for (int i = 0; i < 2; ++i) { int R, C; stage_rc(tid * 16 + i * 8192, R, C); const int Rb = Epi::PERM ? ((R & ~31) + perm32(R & 31)) : R;
        voffA[i] = (unsigned)(R * K + C) * 2u; voffB[i] = (unsigned)(Rb * K + C) * 2u; }
    const size_t kstep = (size_t)(BK * 2);
    const size_t hstep = (size_t)HALF * K * 2;
    const size_t tstep = 2 * hstep;
    const unsigned ldsw = (unsigned)wid * 1024u;
    const int aoff = lds_byte(wr * 64 + fr, fq * 8), boff = lds_byte(wc * 32 + fr, fq * 8);
#define PG8_SA(b, h) (((b) * 2 + (h)) * HTB)
#define PG8_SB(b, h) ((4 + (b) * 2 + (h)) * HTB)
#define PG8_STAGE(bufoff, gbase, voff) do { _Pragma("unroll") for (int _i = 0; _i < 2; ++_i) \
        __builtin_amdgcn_global_load_lds((const unsigned*)((const char*)(gbase) + (voff)[_i]), (PG8_LAS unsigned*)(lds + (bufoff) + ldsw + _i * 8192), 16, 0, 0); } while (0)
#define PG8_LDA(dst, b, h) do { _Pragma("unroll") for (int m = 0; m < 4; ++m) _Pragma("unroll") for (int k = 0; k < 2; ++k) dst[m][k] = *(const PG8_LAS bf16x8*)(lds + PG8_SA(b, h) + aoff + m * 2048 + k * 1024); } while (0)
#define PG8_LDB(dst, b, h) do { _Pragma("unroll") for (int n = 0; n < 2; ++n) _Pragma("unroll") for (int k = 0; k < 2; ++k) dst[n][k] = *(const PG8_LAS bf16x8*)(lds + PG8_SB(b, h) + boff + n * 2048 + k * 1024); } while (0)
#define PG8_MMA(ai, bj, At, Bt) do { __builtin_amdgcn_s_setprio(1); _Pragma("unroll") for (int m = 0; m < 4; ++m) _Pragma("unroll") for (int n = 0; n < 2; ++n) _Pragma("unroll") for (int k = 0; k < 2; ++k) \
        acc[ai][bj][m][n] = __builtin_amdgcn_mfma_f32_16x16x32_bf16(Bt[n][k], At[m][k], acc[ai][bj][m][n], 0, 0, 0); __builtin_amdgcn_s_setprio(0); } while (0)
#define PG8_WAIT_V(n) asm volatile("s_waitcnt vmcnt(" #n ")" ::: "memory")
#define PG8_WAIT_L(n) asm volatile("s_waitcnt lgkmcnt(" #n ")" ::: "memory")
#define PG8_BAR __builtin_amdgcn_s_barrier()
#define PG8_SCHED __builtin_amdgcn_sched_barrier(0)
    Unit cur, nxt; int ui = 0;
    if (!S.next(0, cur)) return;
    f32x4 acc[2][2][4][2];
#pragma unroll
    for (int a = 0; a < 2; ++a)
#pragma unroll
        for (int b = 0; b < 2; ++b)
#pragma unroll
            for (int m = 0; m < 4; ++m)
#pragma unroll
                for (int n = 0; n < 2; ++n) acc[a][b][m][n] = (f32x4){0.f, 0.f, 0.f, 0.f};
    bf16x8 At[4][2], B0[2][2], B1[2][2];
    const char* cA = (const char*)g.A + (size_t)cur.pm * tstep; const char* cB = (const char*)g.Bt + (size_t)cur.pn * tstep;
    S.a_ready(cur);
    if constexpr (SP2) {
        PG8_STAGE(PG8_SB(0, 0), cB, voffB); PG8_STAGE(PG8_SB(0, 1), cB + hstep, voffB); PG8_STAGE(PG8_SA(0, 0), cA, voffA); PG8_STAGE(PG8_SA(0, 1), cA + hstep, voffA);
        if (wr == 1) PG8_BAR;
        PG8_WAIT_V(2); PG8_BAR;
        PG8_STAGE(PG8_SB(1, 0), cB + kstep, voffB); PG8_STAGE(PG8_SA(1, 0), cA + kstep, voffA); PG8_STAGE(PG8_SB(1, 1), cB + hstep + kstep, voffB);
        PG8_WAIT_V(6); PG8_BAR;
    } else {
        PG8_STAGE(PG8_SB(0, 0), cB, voffB); PG8_STAGE(PG8_SA(0, 0), cA, voffA); PG8_STAGE(PG8_SB(0, 1), cB + hstep, voffB); PG8_STAGE(PG8_SA(0, 1), cA + hstep, voffA);
        if (wr == 1) PG8_BAR;
        PG8_WAIT_V(4); PG8_BAR;
        PG8_STAGE(PG8_SB(1, 0), cB + kstep, voffB); PG8_STAGE(PG8_SA(1, 0), cA + kstep, voffA); PG8_STAGE(PG8_SB(1, 1), cB + hstep + kstep, voffB);
        PG8_WAIT_V(6); PG8_BAR;
    }
    for (;;) {
        const bool has_next = S.next(ui + 1, nxt);
        const char* nA = has_next ? (const char*)g.A + (size_t)nxt.pm * tstep : cA; const char* nB = has_next ? (const char*)g.Bt + (size_t)nxt.pn * tstep : cB;
        for (int t = 0; t < nt; t += 2) {
            const bool last = (t == nt - 2);
            const char* a1 = cA + (size_t)(t + 1) * kstep;
            const char* a2 = last ? nA : cA + (size_t)(t + 2) * kstep; const char* b2 = last ? nB : cB + (size_t)(t + 2) * kstep;
            const char* a3 = a2 + kstep; const char* b3 = b2 + kstep;
            if (last && has_next) S.a_ready(nxt);
            if constexpr (SP2) {
            PG8_LDB(B0, 0, 0); PG8_LDB(B1, 0, 1); PG8_SCHED; PG8_LDA(At, 0, 0); PG8_STAGE(PG8_SA(1, 1), a1 + hstep, voffA);
            PG8_WAIT_V(8); PG8_WAIT_L(0); PG8_BAR; PG8_MMA(0, 0, At, B0); PG8_MMA(0, 1, At, B1); PG8_BAR; PG8_SCHED;
            PG8_LDA(At, 0, 1); PG8_STAGE(PG8_SB(0, 0), b2, voffB); PG8_STAGE(PG8_SB(0, 1), b2 + hstep, voffB); PG8_STAGE(PG8_SA(0, 0), a2, voffA);
            PG8_WAIT_V(8); PG8_WAIT_L(0); PG8_BAR; PG8_MMA(1, 0, At, B0); PG8_MMA(1, 1, At, B1); PG8_BAR; PG8_SCHED;
            PG8_LDB(B0, 1, 0); PG8_LDB(B1, 1, 1); PG8_SCHED; PG8_LDA(At, 1, 0); PG8_STAGE(PG8_SA(0, 1), a2 + hstep, voffA);
            PG8_WAIT_V(8); PG8_WAIT_L(0); PG8_BAR; PG8_MMA(0, 0, At, B0); PG8_MMA(0, 1, At, B1); PG8_BAR; PG8_SCHED;
            PG8_LDA(At, 1, 1); PG8_STAGE(PG8_SB(1, 0), b3, voffB); PG8_STAGE(PG8_SB(1, 1), b3 + hstep, voffB); PG8_STAGE(PG8_SA(1, 0), a3, voffA);
            PG8_WAIT_V(8); PG8_WAIT_L(0); PG8_BAR; PG8_MMA(1, 0, At, B0); PG8_MMA(1, 1, At, B1); PG8_BAR; PG8_SCHED;
            } else {
            PG8_LDB(B0, 0, 0); PG8_SCHED; PG8_LDA(At, 0, 0); PG8_STAGE(PG8_SA(1, 1), a1 + hstep, voffA);
            PG8_WAIT_L(8); PG8_BAR; PG8_WAIT_L(0); PG8_MMA(0, 0, At, B0); PG8_BAR; PG8_SCHED;
            PG8_LDB(B1, 0, 1); PG8_STAGE(PG8_SB(0, 0), b2, voffB);
            PG8_BAR; PG8_WAIT_L(0); PG8_MMA(0, 1, At, B1); PG8_BAR;
            PG8_LDA(At, 0, 1); PG8_STAGE(PG8_SA(0, 0), a2, voffA);
            PG8_BAR; PG8_WAIT_L(0); PG8_MMA(1, 0, At, B0); PG8_BAR; PG8_SCHED;
            PG8_STAGE(PG8_SB(0, 1), b2 + hstep, voffB);
            PG8_WAIT_V(6); PG8_BAR; PG8_MMA(1, 1, At, B1); PG8_BAR;
            PG8_LDB(B0, 1, 0); PG8_SCHED; PG8_LDA(At, 1, 0); PG8_STAGE(PG8_SA(0, 1), a2 + hstep, voffA);
            PG8_WAIT_L(8); PG8_BAR; PG8_WAIT_L(0); PG8_MMA(0, 0, At, B0); PG8_BAR; PG8_SCHED;
            PG8_LDB(B1, 1, 1); PG8_STAGE(PG8_SB(1, 0), b3, voffB);
            PG8_BAR; PG8_WAIT_L(0); PG8_MMA(0, 1, At, B1); PG8_BAR;
            PG8_LDA(At, 1, 1); PG8_STAGE(PG8_SA(1, 0), a3, voffA);
            PG8_BAR; PG8_WAIT_L(0); PG8_MMA(1, 0, At, B0); PG8_BAR; PG8_SCHED;
            PG8_STAGE(PG8_SB(1, 1), b3 + hstep, voffB);
            PG8_WAIT_V(6); PG8_BAR; PG8_MMA(1, 1, At, B1); PG8_BAR;
            }
        }
        if constexpr (ALIGN_EPI) { if (wr == 0) PG8_BAR; }
        if constexpr (!Epi::AFTER_DRAIN) { E(acc, cur, wr, wc, fr, fq); S.done(cur); }
        if (!has_next) break;
#pragma unroll
        for (int a = 0; a < 2; ++a)
#pragma unroll
            for (int b = 0; b < 2; ++b)
#pragma unroll
                for (int m = 0; m < 4; ++m)
#pragma unroll
                    for (int n = 0; n < 2; ++n) acc[a][b][m][n] = (f32x4){0.f, 0.f, 0.f, 0.f};
        cur = nxt; cA = nA; cB = nB; ++ui;
        if constexpr (ALIGN_EPI) { if (wr == 1) PG8_BAR; }
    }
    PG8_WAIT_V(0);
    if constexpr (!ALIGN_EPI) { if (wr == 0) PG8_BAR; }
    PG8_BAR;
    if constexpr (Epi::AFTER_DRAIN) { E.fused(acc, cur, wr, wc, fr, fq, lds, wid, lane); S.done(cur); }
#undef PG8_SA
#undef PG8_SB
#undef PG8_STAGE
#undef PG8_LDA
#undef PG8_LDB
#undef PG8_MMA
#undef PG8_WAIT_V
#undef PG8_WAIT_L
#undef PG8_BAR
#undef PG8_SCHED
}
}

#define DI __device__ __forceinline__
typedef unsigned short bf16_t;
typedef short bf16x8 __attribute__((ext_vector_type(8)));
typedef float f32x4 __attribute__((ext_vector_type(4)));
typedef float f32x2 __attribute__((ext_vector_type(2)));
typedef float f32x16 __attribute__((ext_vector_type(16)));
typedef unsigned u32x4 __attribute__((ext_vector_type(4)));
typedef unsigned u32x2 __attribute__((ext_vector_type(2)));
typedef __bf16 bf2_t __attribute__((ext_vector_type(2)));

constexpr int NTOK = 16384, SEQ = 8192, DM = 1024, NIN = 7200, NWAVES = 8;
constexpr float RMS_EPS = 1e-6f;
constexpr float LOG2E = 1.4426950408889634f;
constexpr size_t MiB = (size_t)1 << 20;
constexpr size_t WS_ZM = 0, WS_VMT = 512 * 1024, WS_UM = 640 * 1024, WS_WS = 704 * 1024, WS_R = 1 * MiB, WS_WO = 3 * MiB, WS_XW = 8 * MiB,
                 WS_AO = 54 * MiB, WS_NK = 118 * MiB, WS_NVT = 150 * MiB, WS_VGT = 182 * MiB, WS_QG = 214 * MiB, WS_KG = 230 * MiB, WS_OB = 214 * MiB,
                 WS_PKF = WS_XW, WS_PKB = WS_NK, WS_END = 246 * MiB;
constexpr int PK_BYTES = 41472;
constexpr int PK_A_OFF = 40960;
constexpr int LDS_BYTES = 147456;

DI unsigned pk2(float lo, float hi) { f32x2 v = {lo, hi}; bf2_t b = __builtin_convertvector(v, bf2_t); return __builtin_bit_cast(unsigned, b); }
DI float bf2f(bf16_t u) { return __uint_as_float(((unsigned)u) << 16); }
DI float wave_sum(float v) {
#pragma unroll
    for (int o = 1; o < 64; o <<= 1) v += __shfl_xor(v, o);
    return v;
}
DI float silu_f(float x) { return x * __builtin_amdgcn_rcpf(1.f + __expf(-x)); }
DI int crow(int reg, int h) { return (reg & 3) + 8 * (reg >> 2) + 4 * h; }
#define MFMA32(a, b, c) __builtin_amdgcn_mfma_f32_32x32x16_bf16((a), (b), (c), 0, 0, 0)
#define MFMA16(a, b, c) __builtin_amdgcn_mfma_f32_16x16x32_bf16((a), (b), (c), 0, 0, 0)

struct Args {
    const float *x, *meta, *norm_g, *w_in, *wd_f, *bd_f, *wd_b, *bd_b, *gla_g, *qn_g, *kn_g, *rpb, *meta_bias, *w_out;
    float* out; unsigned char* ws;
};

DI int phys_norm(int wt, int lc) { return 256 * wt + 128 * ((lc >> 5) & 1) + 32 * (lc >> 6) + (lc & 31); }

DI void p0_transpose_item(const float* W, int ldw, int k0, int n0, bf16_t* WT, int ldwt, int row0, float* scr, int lane) {
#pragma unroll 8
    for (int i = 0; i < 32; ++i) { const int kk = 2 * i + (lane >> 5); scr[kk * 33 + (lane & 31)] = W[(size_t)(k0 + kk) * ldw + n0 + (lane & 31)]; }
    asm volatile("s_waitcnt lgkmcnt(0)" ::: "memory");
    const int c = lane & 7;
#pragma unroll
    for (int j = 0; j < 4; ++j) { const int n = (lane >> 3) + 8 * j; const float* s = scr + (8 * c) * 33 + n;
        u32x4 o; o.x = pk2(s[0 * 33], s[1 * 33]); o.y = pk2(s[2 * 33], s[3 * 33]); o.z = pk2(s[4 * 33], s[5 * 33]); o.w = pk2(s[6 * 33], s[7 * 33]);
        *(u32x4*)(WT + (size_t)(row0 + n) * ldwt + k0 + 8 * c) = o; }
    asm volatile("s_waitcnt lgkmcnt(0)" ::: "memory");
}
DI int wt_base(int wt) {
    if (wt < 2) return 0 + 256 * wt;
    if (wt < 4) return 512 + 256 * (wt - 2);
    if (wt < 8) return 2080 + 256 * (wt - 4);
    if (wt < 12) return 3104 + 256 * (wt - 8);
    if (wt < 16) return 4128 + 256 * (wt - 12);
    if (wt < 20) return 6176 + 256 * (wt - 16);
    if (wt < 24) return 1024 + 256 * (wt - 20);
    return 5152 + 256 * (wt - 24);
}
DI void rms_row_to_bf16(const float* xrow, const float* g, bf16_t* orow, int lane) {
    const f32x4* xr = (const f32x4*)xrow + lane; const f32x4* gr = (const f32x4*)g + lane;
    f32x4 v[4]; float s = 0.f;
#pragma unroll
    for (int j = 0; j < 4; ++j) { v[j] = xr[64 * j]; s += (v[j].x * v[j].x + v[j].y * v[j].y) + (v[j].z * v[j].z + v[j].w * v[j].w); }
    const float rstd = 1.0f / sqrtf(wave_sum(s) * (1.f / DM) + RMS_EPS);
    unsigned long long* o8 = (unsigned long long*)orow + lane;
#pragma unroll
    for (int j = 0; j < 4; ++j) { const f32x4 gg = gr[64 * j];
        o8[64 * j] = (unsigned long long)pk2(v[j].x * rstd * gg.x, v[j].y * rstd * gg.y) | ((unsigned long long)pk2(v[j].z * rstd * gg.z, v[j].w * rstd * gg.w) << 32); }
}
DI void p0_phase(const Args& a, unsigned char* lds, int vcu, int G, int wave, int lane) {
    unsigned char* ws = a.ws;
    float* scr = (float*)(lds + wave * 16384);
    bf16_t* XW = (bf16_t*)(ws + WS_XW); bf16_t* WSs = (bf16_t*)(ws + WS_WS); bf16_t* WO = (bf16_t*)(ws + WS_WO); bf16_t* UM = (bf16_t*)(ws + WS_UM);
    const int gw = vcu * NWAVES + wave, NGW = G * NWAVES;
    constexpr int I_A = 28 * 8 * 16, I_B = 16, I_C = 32 * 32;
    for (int it = gw; it < I_A + I_B + I_C; it += NGW) {
        int r = it;
        if (r < I_A) { const int wt = r >> 7, g = (r >> 4) & 7, kb = r & 15;
            const int lc0 = (wt < 20) ? (64 * (g & 3) + 32 * (g >> 2)) : 32 * g;
            p0_transpose_item(a.w_in, NIN, 64 * kb, wt_base(wt) + lc0, XW, DM, NTOK + 256 * wt + 32 * g, scr, lane); continue; }
        r -= I_A;
        if (r < I_B) { p0_transpose_item(a.w_in, NIN, 64 * r, 2048, WSs, DM, 0, scr, lane); continue; }
        r -= I_B;
        { const int kb = r >> 5, nb = r & 31; p0_transpose_item(a.w_out, DM, 64 * kb, 32 * nb, WO, 2048, 32 * nb, scr, lane); }
    }
    for (int m = gw; m < NTOK + 16; m += NGW) {
        if (m < NTOK) rms_row_to_bf16(a.x + (size_t)m * DM, a.norm_g, XW + (size_t)m * DM, lane);
        else rms_row_to_bf16(a.meta + (size_t)(m - NTOK) * DM, a.norm_g, UM + (size_t)(m - NTOK) * DM, lane);
    }
}

DI void skinny_task(const bf16_t* A, const bf16_t* B, float* O, int ldo, int lane) {
    const int r = lane & 15, q = lane >> 4;
    const bf16x8* ap = (const bf16x8*)(A + (size_t)r * DM + 8 * q);
    const bf16x8* b0 = (const bf16x8*)(B + (size_t)r * DM + 8 * q);
    const bf16x8* b1 = (const bf16x8*)(B + (size_t)(16 + r) * DM + 8 * q);
    f32x4 acc0 = {0.f, 0.f, 0.f, 0.f}, acc1 = {0.f, 0.f, 0.f, 0.f};
#pragma unroll 8
    for (int ks = 0; ks < 32; ++ks) { const bf16x8 av = ap[4 * ks]; acc0 = MFMA16(av, b0[4 * ks], acc0); acc1 = MFMA16(av, b1[4 * ks], acc1); }
#pragma unroll
    for (int i = 0; i < 4; ++i) { O[(size_t)(4 * q + i) * ldo + r] = acc0[i]; O[(size_t)(4 * q + i) * ldo + 16 + r] = acc1[i]; }
}
DI void p1_skinny(const Args& a, int vcu, int G, int wave, int lane) {
    unsigned char* ws = a.ws;
    const bf16_t* XW = (const bf16_t*)(ws + WS_XW); const bf16_t* WSs = (const bf16_t*)(ws + WS_WS); const bf16_t* UM = (const bf16_t*)(ws + WS_UM);
    float* R = (float*)(ws + WS_R); float* ZM = (float*)(ws + WS_ZM);
    const int gw = vcu * NWAVES + wave, NGW = G * NWAVES;
    for (int t = gw; t < 1024 + 225; t += NGW) {
        if (t < 1024) skinny_task(XW + (size_t)t * 16 * DM, WSs, R + (size_t)t * 16 * 32, 32, lane);
        else { const int c = t - 1024;
            if (c < 224) skinny_task(UM, XW + (size_t)(NTOK + 32 * c) * DM, ZM + 32 * c, NIN, lane);
            else skinny_task(UM, WSs, ZM + 7168, NIN, lane); }
    }
}

struct OrderIn {
    int G, c;
    DI bool next(int i, pg8::Unit& u) const {
        const long L = (long)i * G + c; if (L >= 1792) return false;
        const int ii = (int)(L >> 8), cc = (int)(L & 255), xcd = cc & 7, j = cc >> 3, tok = 8 * xcd + (j & 7), w4 = j >> 3;
        if (ii < 5) { u.pm = tok; u.pn = 64 + 4 * ii + w4; } else { u.pm = 64 + 20 + 4 * (ii - 5) + w4; u.pn = tok; }
        return true;
    }
    DI void a_ready(const pg8::Unit&) const {}
    DI void done(const pg8::Unit&) const {}
};

struct EpiIn {
    static constexpr bool PERM = true, AFTER_DRAIN = false;
    bf16_t *QG, *KG, *GG, *NGt, *AO, *NK, *VGT, *NVT; const float *qn_g, *kn_g;
    DI void operator()(const f32x4 (&acc)[2][2][4][2], const pg8::Unit& u, int wr, int wc, int fr, int fq) const {
        if (u.pm < 64) {
            const int wt = u.pn - 64;
            const int row0 = u.pm * 256 + wr * 64 + fr;
            if (wt < 8 || wt >= 16) {
                bf16_t* base; int ld; float sc = 1.f; bool act = false;
                if (wt < 2) { base = QG + 256 * wt; ld = 512; sc = 0.08838834764831845f; }
                else if (wt < 4) { base = KG + 256 * (wt - 2); ld = 512; }
                else if (wt < 8) { base = GG + 256 * (wt - 4); ld = 1024; act = true; }
                else { base = NGt + 256 * (wt - 16); ld = 1024; act = true; }
#pragma unroll
                for (int ai = 0; ai < 2; ++ai)
#pragma unroll
                    for (int m = 0; m < 4; ++m) { bf16_t* rowp = base + (size_t)(row0 + ai * 128 + m * 16) * ld + 64 * wc + 8 * fq;
#pragma unroll
                        for (int bj = 0; bj < 2; ++bj) { f32x4 v0 = acc[ai][bj][m][0], v1 = acc[ai][bj][m][1];
                            if (act) { v0 = (f32x4){silu_f(v0[0]), silu_f(v0[1]), silu_f(v0[2]), silu_f(v0[3])}; v1 = (f32x4){silu_f(v1[0]), silu_f(v1[1]), silu_f(v1[2]), silu_f(v1[3])}; }
                            v0 = v0 * sc; v1 = v1 * sc;
                            u32x4 w; w.x = pk2(v0[0], v0[1]); w.y = pk2(v0[2], v0[3]); w.z = pk2(v1[0], v1[1]); w.w = pk2(v1[2], v1[3]);
                            *(u32x4*)(rowp + 32 * bj) = w; } }
            } else {
                const bool isq = wt < 12; const float* g = isq ? qn_g : kn_g; const float gs = isq ? (0.125f * LOG2E) : 1.0f;
                bf16_t* base = isq ? (AO + 1024 + 256 * (wt - 8)) : (NK + 256 * (wt - 12)); const int ld = isq ? 2048 : 1024;
                f32x4 gv[2][2];
#pragma unroll
                for (int bj = 0; bj < 2; ++bj)
#pragma unroll
                    for (int n = 0; n < 2; ++n) gv[bj][n] = *(const f32x4*)(g + 32 * bj + 8 * fq + 4 * n) * gs;
#pragma unroll
                for (int ai = 0; ai < 2; ++ai)
#pragma unroll
                    for (int m = 0; m < 4; ++m) {
                        float ss = 0.f;
#pragma unroll
                        for (int bj = 0; bj < 2; ++bj)
#pragma unroll
                            for (int n = 0; n < 2; ++n) { const f32x4 v = acc[ai][bj][m][n]; ss += (v[0] * v[0] + v[1] * v[1]) + (v[2] * v[2] + v[3] * v[3]); }
                        ss += __shfl_xor(ss, 16); ss += __shfl_xor(ss, 32);
                        const float rstd = 1.0f / sqrtf(ss * (1.f / 64.f) + RMS_EPS);
                        bf16_t* rowp = base + (size_t)(row0 + ai * 128 + m * 16) * ld + 64 * wc + 8 * fq;
#pragma unroll
                        for (int bj = 0; bj < 2; ++bj) { const f32x4 v0 = acc[ai][bj][m][0] * rstd * gv[bj][0], v1 = acc[ai][bj][m][1] * rstd * gv[bj][1];
                            u32x4 w; w.x = pk2(v0[0], v0[1]); w.y = pk2(v0[2], v0[3]); w.z = pk2(v1[0], v1[1]); w.w = pk2(v1[2], v1[3]);
                            *(u32x4*)(rowp + 32 * bj) = w; }
                    }
            }
        } else {
            const int wt = u.pm - 64;
            bf16_t* base = (wt < 24) ? (VGT + (size_t)(256 * (wt - 20)) * NTOK) : (NVT + (size_t)(256 * (wt - 24)) * NTOK);
            const int row0 = wr * 64 + fr, col0 = u.pn * 256 + wc * 32 + 8 * fq;
#pragma unroll
            for (int ai = 0; ai < 2; ++ai)
#pragma unroll
                for (int m = 0; m < 4; ++m) { bf16_t* rowp = base + (size_t)(row0 + ai * 128 + m * 16) * NTOK + col0;
#pragma unroll
                    for (int bj = 0; bj < 2; ++bj) { const f32x4 v0 = acc[ai][bj][m][0], v1 = acc[ai][bj][m][1];
                        u32x4 w; w.x = pk2(v0[0], v0[1]); w.y = pk2(v0[2], v0[3]); w.z = pk2(v1[0], v1[1]); w.w = pk2(v1[2], v1[3]);
                        *(u32x4*)(rowp + 128 * bj) = w; } }
        }
    }
};

struct EpiOut {
    static constexpr bool PERM = false, AFTER_DRAIN = false;
    const float* x; float* out;
    DI void operator()(const f32x4 (&acc)[2][2][4][2], const pg8::Unit& u, int wr, int wc, int fr, int fq) const {
        const int row0 = u.pm * 256 + wr * 64 + fr, col0 = u.pn * 256 + wc * 32 + 4 * fq;
#pragma unroll
        for (int ai = 0; ai < 2; ++ai)
#pragma unroll
            for (int m = 0; m < 4; ++m) { const size_t off = (size_t)(row0 + ai * 128 + m * 16) * DM + col0;
#pragma unroll
                for (int bj = 0; bj < 2; ++bj)
#pragma unroll
                    for (int n = 0; n < 2; ++n) { const f32x4 xs = *(const f32x4*)(x + off + bj * 128 + n * 16); *(f32x4*)(out + off + bj * 128 + n * 16) = xs + acc[ai][bj][m][n]; } }
    }
};

constexpr int NA_KM = 0, NA_VM = 32768, NA_RPB = 65536, NA_MB = NA_RPB + 16 * 465 * 4;
DI void na_phase(const Args& a, unsigned char* lds, int vcu, int G, int wave, int lane) {
    unsigned char* ws = a.ws;
    const float* ZM = (const float*)(ws + WS_ZM);
    bf16_t* AO = (bf16_t*)(ws + WS_AO); const bf16_t* NK = (const bf16_t*)(ws + WS_NK); const bf16_t* NVT = (const bf16_t*)(ws + WS_NVT);
    const bf16_t* NGt = (const bf16_t*)a.out + (size_t)NTOK * 1024;
    bf16_t* KM = (bf16_t*)(lds + NA_KM); bf16_t* VM = (bf16_t*)(lds + NA_VM); float* RPB = (float*)(lds + NA_RPB); float* MB = (float*)(lds + NA_MB);
    const int tid = wave * 64 + lane;
    for (int p = wave; p < 256; p += NWAVES) { const int h = p >> 4, m = p & 15, d = lane;
        const float v = ZM[(size_t)m * NIN + 256 * (12 + (h >> 2)) + 128 * (d >> 5) + 32 * (h & 3) + (d & 31)];
        const float rstd = 1.0f / sqrtf(wave_sum(v * v) * (1.f / 64.f) + RMS_EPS);
        KM[(h * 16 + m) * 64 + d] = (bf16_t)(pk2(v * rstd * a.kn_g[d], 0.f) & 0xffffu); }
    for (int e = tid; e < 16 * 64 * 16; e += 512) { const int m = e & 15, d = (e >> 4) & 63, h = e >> 10;
        VM[e] = (bf16_t)(pk2(ZM[(size_t)m * NIN + 256 * (24 + (h >> 2)) + 64 * (h & 3) + d], 0.f) & 0xffffu); }
    for (int e = tid; e < 16 * 465; e += 512) RPB[e] = a.rpb[e] * LOG2E;
    if (tid < 256) MB[tid] = a.meta_bias[tid] * LOG2E;
    __syncthreads();
    const int n_iter = (2048 + G - 1) / G;
    const int n = lane & 15, q4 = lane >> 4;
    for (int it = 0; it < n_iter; ++it) {
        const int idx = vcu * n_iter + it; if (idx >= 2048) break;
        const int br = idx >> 3, hp = idx & 7, b = br >> 7, r = br & 127;
        const int h = 2 * hp + (wave >> 2), qt = wave & 3;
        const int c0 = (qt == 0) ? 0 : (qt == 1) ? 8 : (qt == 2) ? 24 : 32;
        int rs = r - 4; rs = rs < 0 ? 0 : (rs > 120 ? 120 : rs);
        const int qc = 16 * qt + n;
        int cs = qc - 8; cs = cs < 0 ? 0 : (cs > 48 ? 48 : cs);
        const size_t qtok = (size_t)b * SEQ + r * 64 + qc;
        bf16x8 qf[2];
#pragma unroll
        for (int ks = 0; ks < 2; ++ks) qf[ks] = *(const bf16x8*)(AO + qtok * 2048 + 1024 + h * 64 + 32 * ks + 8 * q4);
        f32x4 sc[17];
        const int kcol_base = c0 + 8 * (n >> 2) + (n & 3);
#pragma unroll
        for (int kr = 0; kr < 8; ++kr) {
#pragma unroll
            for (int t = 0; t < 2; ++t) {
                const size_t ktok = (size_t)b * SEQ + (rs + kr) * 64 + kcol_base + 4 * t;
                const bf16x8 k0 = *(const bf16x8*)(NK + ktok * 1024 + h * 64 + 8 * q4);
                const bf16x8 k1 = *(const bf16x8*)(NK + ktok * 1024 + h * 64 + 32 + 8 * q4);
                f32x4 z = {0.f, 0.f, 0.f, 0.f};
                z = MFMA16(k0, qf[0], z); z = MFMA16(k1, qf[1], z);
                sc[2 * kr + t] = z;
            }
        }
        {
            const bf16x8 k0 = *(const bf16x8*)(KM + (h * 16 + n) * 64 + 8 * q4);
            const bf16x8 k1 = *(const bf16x8*)(KM + (h * 16 + n) * 64 + 32 + 8 * q4);
            f32x4 z = {0.f, 0.f, 0.f, 0.f};
            z = MFMA16(k0, qf[0], z); z = MFMA16(k1, qf[1], z);
            sc[16] = z;
        }
        float mx = -1e30f;
        const float* rp = RPB + h * 465;
#pragma unroll
        for (int kr = 0; kr < 8; ++kr) {
            const int drow = rs + kr - r + 7;
#pragma unroll
            for (int t = 0; t < 2; ++t)
#pragma unroll
                for (int i = 0; i < 4; ++i) {
                    const int kc = c0 + 8 * q4 + 4 * t + i;
                    const bool valid = (kc >= cs) && (kc < cs + 16);
                    int dcol = kc - qc + 15; dcol = dcol < 0 ? 0 : (dcol > 30 ? 30 : dcol);
                    const float bias = rp[drow * 31 + dcol];
                    const float s = valid ? (sc[2 * kr + t][i] + bias) : -1e30f;
                    sc[2 * kr + t][i] = s; mx = fmaxf(mx, s);
                }
        }
#pragma unroll
        for (int i = 0; i < 4; ++i) { const float s = sc[16][i] + MB[h * 16 + 4 * q4 + i]; sc[16][i] = s; mx = fmaxf(mx, s); }
        mx = fmaxf(mx, __shfl_xor(mx, 16)); mx = fmaxf(mx, __shfl_xor(mx, 32));
        float sum = 0.f;
#pragma unroll
        for (int j = 0; j < 17; ++j)
#pragma unroll
            for (int i = 0; i < 4; ++i) { const float p = __builtin_amdgcn_exp2f(sc[j][i] - mx); sc[j][i] = p; sum += p; }
        sum += __shfl_xor(sum, 16); sum += __shfl_xor(sum, 32);
        const float inv = 1.0f / sum;
        f32x4 o[4];
#pragma unroll
        for (int dt = 0; dt < 4; ++dt) o[dt] = (f32x4){0.f, 0.f, 0.f, 0.f};
#pragma unroll
        for (int kr = 0; kr < 8; ++kr) {
            u32x4 pw; pw.x = pk2(sc[2 * kr][0], sc[2 * kr][1]); pw.y = pk2(sc[2 * kr][2], sc[2 * kr][3]); pw.z = pk2(sc[2 * kr + 1][0], sc[2 * kr + 1][1]); pw.w = pk2(sc[2 * kr + 1][2], sc[2 * kr + 1][3]);
            const bf16x8 pf = __builtin_bit_cast(bf16x8, pw);
            const size_t vtok = (size_t)b * SEQ + (rs + kr) * 64 + c0 + 8 * q4;
#pragma unroll
            for (int dt = 0; dt < 4; ++dt) {
                const bf16x8 vf = *(const bf16x8*)(NVT + (size_t)(h * 64 + 16 * dt + n) * NTOK + vtok);
                o[dt] = MFMA16(vf, pf, o[dt]);
            }
        }
        {
            u32x4 pw; pw.x = pk2(sc[16][0], sc[16][1]); pw.y = pk2(sc[16][2], sc[16][3]); pw.z = 0u; pw.w = 0u;
            const bf16x8 pf = __builtin_bit_cast(bf16x8, pw);
#pragma unroll
            for (int dt = 0; dt < 4; ++dt) {
                const u32x2 lo = *(const u32x2*)(VM + ((h * 64 + 16 * dt + n) * 16 + 4 * q4));
                u32x4 vw; vw.x = lo.x; vw.y = lo.y; vw.z = 0u; vw.w = 0u;
                o[dt] = MFMA16(__builtin_bit_cast(bf16x8, vw), pf, o[dt]);
            }
        }
#pragma unroll
        for (int dt = 0; dt < 4; ++dt) {
            const int d0 = h * 64 + 16 * dt + 4 * q4;
            const u32x2 gw = *(const u32x2*)(NGt + qtok * 1024 + d0);
            const float g0 = __uint_as_float(gw.x << 16), g1 = __uint_as_float(gw.x & 0xffff0000u), g2 = __uint_as_float(gw.y << 16), g3 = __uint_as_float(gw.y & 0xffff0000u);
            u32x2 w; w.x = pk2(o[dt][0] * inv * g0, o[dt][1] * inv * g1); w.y = pk2(o[dt][2] * inv * g2, o[dt][3] * inv * g3);
            *(u32x2*)(AO + qtok * 2048 + 1024 + d0) = w;
        }
    }
}

constexpr int PREP_LD = 136;
constexpr int PREP_TILE = 64 * PREP_LD * 2;
constexpr int PREP_R = 4 * PREP_TILE, PREP_PART = PREP_R + 8192;
DI float logsig16(float x) { return (fminf(x, 0.f) - __logf(1.f + __expf(-fabsf(x)))) * (1.f / 16.f); }
DI int phys_gk(int c) { return phys_norm(2 + (c >> 8), c & 255); }
DI void prep_phase(const Args& a, unsigned char* lds, int vcu, int G, int wave, int lane) {
    unsigned char* ws = a.ws;
    const float* ZM = (const float*)(ws + WS_ZM); const float* R = (const float*)(ws + WS_R);
    const bf16_t* QG = (const bf16_t*)(ws + WS_QG); const bf16_t* KG = (const bf16_t*)(ws + WS_KG);
    unsigned char* PKF = ws + WS_PKF; unsigned char* PKB = ws + WS_PKB; bf16_t* VMT = (bf16_t*)(ws + WS_VMT);
    const int tid = wave * 64 + lane;
    bf16_t* T_QF = (bf16_t*)(lds); bf16_t* T_KF = (bf16_t*)(lds + PREP_TILE); bf16_t* T_QB = (bf16_t*)(lds + 2 * PREP_TILE); bf16_t* T_KB = (bf16_t*)(lds + 3 * PREP_TILE);
    float* RS = (float*)(lds + PREP_R); float* PART = (float*)(lds + PREP_PART);
    for (int task = vcu; task < 1024 + 8; task += G) {
        if (task >= 1024) {
            const int mt = task - 1024, b = mt >> 2, h = mt & 3;
            unsigned char* pk = PKF + (size_t)((b * 4 + h) * 129) * PK_BYTES;
            for (int p = tid; p < PK_BYTES / 16; p += 512) *(u32x4*)(pk + p * 16) = (u32x4){0u, 0u, 0u, 0u};
            __syncthreads();
            if (tid < 128) { const int d = tid;
                float wd[16];
#pragma unroll
                for (int k = 0; k < 16; ++k) wd[k] = a.wd_f[k * 512 + h * 128 + d];
                const float bd = a.bd_f[h * 128 + d];
                float G_[16]; float run = 0.f;
#pragma unroll
                for (int m = 0; m < 16; ++m) { float dot = bd;
#pragma unroll
                    for (int k = 0; k < 16; ++k) dot += ZM[(size_t)m * NIN + 7168 + k] * wd[k];
                    run += logsig16(dot); G_[m] = run; }
                unsigned kw[8];
#pragma unroll
                for (int m = 0; m < 16; m += 2) { const float k0 = ZM[(size_t)m * NIN + phys_gk(h * 128 + d)] * __expf(run - G_[m]);
                    const float k1 = ZM[(size_t)(m + 1) * NIN + phys_gk(h * 128 + d)] * __expf(run - G_[m + 1]); kw[m >> 1] = pk2(k0, k1); }
                const int dt = d >> 5, r = d & 31;
                *(u32x4*)(pk + (dt * 4 + 3) * 1024 + (0 * 32 + r) * 16) = (u32x4){kw[0], kw[1], kw[2], kw[3]};
                *(u32x4*)(pk + (dt * 4 + 3) * 1024 + (1 * 32 + r) * 16) = (u32x4){kw[4], kw[5], kw[6], kw[7]};
                *(float*)(pk + PK_A_OFF + d * 4) = 1.0f;
            }
            if (b == 0 && tid < 256) { const int v = tid; const int c = h * 256 + v; bf16_t* row = VMT + (size_t)c * 64;
                for (int j = 0; j < 48; j += 8) *(u32x4*)(row + j) = (u32x4){0u, 0u, 0u, 0u};
                unsigned vw[8];
#pragma unroll
                for (int m = 0; m < 16; m += 2) vw[m >> 1] = pk2(ZM[(size_t)m * NIN + 256 * (20 + (c >> 8)) + (c & 255)], ZM[(size_t)(m + 1) * NIN + 256 * (20 + (c >> 8)) + (c & 255)]);
                *(u32x4*)(row + 48) = (u32x4){vw[0], vw[1], vw[2], vw[3]}; *(u32x4*)(row + 56) = (u32x4){vw[4], vw[5], vw[6], vw[7]}; }
            __syncthreads();
            continue;
        }
        const int b = task >> 9, h = (task >> 7) & 3, c = task & 127;
        const size_t tok0 = (size_t)b * SEQ + c * 64;
        unsigned char* pkf = PKF + (size_t)((b * 4 + h) * 129 + 1 + c) * PK_BYTES;
        unsigned char* pkb = PKB + (size_t)((b * 4 + h) * 128 + c) * PK_BYTES;
        { const f32x4* src = (const f32x4*)(R + tok0 * 32); ((f32x4*)RS)[tid] = src[tid]; }
        const int d = tid & 127, tq = tid >> 7;
        float wf[16], wb[16];
#pragma unroll
        for (int k = 0; k < 16; ++k) { wf[k] = a.wd_f[k * 512 + h * 128 + d]; wb[k] = a.wd_b[k * 512 + h * 128 + d]; }
        const float bf_ = a.bd_f[h * 128 + d], bb_ = a.bd_b[h * 128 + d];
        __syncthreads();
        float pf[16], pb[16];
        { float rf = 0.f, rb = 0.f;
#pragma unroll
          for (int jj = 0; jj < 16; ++jj) { const float* rr = RS + (16 * tq + jj) * 32; float df = bf_, db = bb_;
#pragma unroll
              for (int k4 = 0; k4 < 4; ++k4) { const f32x4 x0 = *(const f32x4*)(rr + 4 * k4), x1 = *(const f32x4*)(rr + 16 + 4 * k4);
                  df += x0[0] * wf[4 * k4] + x0[1] * wf[4 * k4 + 1] + x0[2] * wf[4 * k4 + 2] + x0[3] * wf[4 * k4 + 3];
                  db += x1[0] * wb[4 * k4] + x1[1] * wb[4 * k4 + 1] + x1[2] * wb[4 * k4 + 2] + x1[3] * wb[4 * k4 + 3]; }
              rf += logsig16(df); rb += logsig16(db); pf[jj] = rf; pb[jj] = rb; }
          PART[(0 * 4 + tq) * 128 + d] = rf; PART[(1 * 4 + tq) * 128 + d] = rb; }
        __syncthreads();
        float offf = 0.f, totf = 0.f, offb = 0.f, totb = 0.f;
#pragma unroll
        for (int q = 0; q < 4; ++q) { const float tf = PART[(0 * 4 + q) * 128 + d], tb = PART[(1 * 4 + q) * 128 + d]; totf += tf; totb += tb; if (q < tq) offf += tf; if (q > tq) offb += tb; }
        const float mytb = pb[15];
        unsigned ksf[8], ksb[8];
#pragma unroll
        for (int jj = 0; jj < 16; jj += 2) {
            float kstf[2], kstb[2];
#pragma unroll
            for (int e = 0; e < 2; ++e) { const int j = 16 * tq + jj + e;
                const float q = bf2f(QG[(tok0 + j) * 512 + h * 128 + d]), k = bf2f(KG[(tok0 + j) * 512 + h * 128 + d]);
                const float Gf = offf + pf[jj + e];
                const float Gb = offb + (mytb - ((jj + e) ? pb[jj + e - 1] : 0.f));
                const float ef = __expf(Gf), eb = __expf(Gb);
                T_QF[j * PREP_LD + d] = (bf16_t)(pk2(q * ef, 0.f) & 0xffffu);
                T_KF[j * PREP_LD + d] = (bf16_t)(pk2(k * __expf(-Gf), 0.f) & 0xffffu);
                T_QB[j * PREP_LD + d] = (bf16_t)(pk2(q * eb, 0.f) & 0xffffu);
                T_KB[j * PREP_LD + d] = (bf16_t)(pk2(k * __expf(-Gb), 0.f) & 0xffffu);
                kstf[e] = k * __expf(totf - Gf); kstb[e] = k * __expf(totb - Gb); }
            ksf[jj >> 1] = pk2(kstf[0], kstf[1]); ksb[jj >> 1] = pk2(kstb[0], kstb[1]);
        }
        { const int dt = d >> 5, r = d & 31;
          *(u32x4*)(pkf + (dt * 4 + tq) * 1024 + (0 * 32 + r) * 16) = (u32x4){ksf[0], ksf[1], ksf[2], ksf[3]};
          *(u32x4*)(pkf + (dt * 4 + tq) * 1024 + (1 * 32 + r) * 16) = (u32x4){ksf[4], ksf[5], ksf[6], ksf[7]};
          *(u32x4*)(pkb + (dt * 4 + tq) * 1024 + (0 * 32 + r) * 16) = (u32x4){ksb[0], ksb[1], ksb[2], ksb[3]};
          *(u32x4*)(pkb + (dt * 4 + tq) * 1024 + (1 * 32 + r) * 16) = (u32x4){ksb[4], ksb[5], ksb[6], ksb[7]};
          if (tq == 0) { *(float*)(pkf + PK_A_OFF + d * 4) = __expf(totf); *(float*)(pkb + PK_A_OFF + d * 4) = __expf(totb); } }
        __syncthreads();
        {
            const int dir = wave >> 2, jt = (wave >> 1) & 1, it = wave & 1;
            const bf16_t* TQ = dir ? T_QB : T_QF; const bf16_t* TK = dir ? T_KB : T_KF; unsigned char* pk = dir ? pkb : pkf;
            const int rho = lane & 31, hh = lane >> 5;
            const int pj = (rho & ~12) | ((rho & 4) << 1) | ((rho & 8) >> 1);
            const int jrow = 32 * jt + pj, icol = 32 * it + rho;
            f32x16 acc;
#pragma unroll
            for (int i = 0; i < 16; ++i) acc[i] = 0.f;
#pragma unroll
            for (int kd = 0; kd < 8; ++kd) { const bf16x8 af = *(const bf16x8*)(TK + jrow * PREP_LD + 16 * kd + 8 * hh); const bf16x8 bfr = *(const bf16x8*)(TQ + icol * PREP_LD + 16 * kd + 8 * hh);
                acc = MFMA32(af, bfr, acc); }
#pragma unroll
            for (int s = 0; s < 2; ++s) {
                unsigned w[4];
#pragma unroll
                for (int e = 0; e < 8; e += 2) {
                    float v[2];
#pragma unroll
                    for (int x = 0; x < 2; ++x) { const int j = 32 * jt + 16 * s + 8 * hh + e + x; const bool keep = dir ? (j >= icol) : (j <= icol); v[x] = keep ? acc[8 * s + e + x] : 0.f; }
                    w[e >> 1] = pk2(v[0], v[1]);
                }
                *(u32x4*)(pk + (32 + it * 4 + 2 * jt + s) * 1024 + lane * 16) = (u32x4){w[0], w[1], w[2], w[3]};
            }
#pragma unroll
            for (int ff = 0; ff < 4; ++ff) { const int f = (wave & 3) * 4 + ff, it2 = f >> 3, kd = f & 7;
                const bf16_t* rowp = TQ + (32 * it2 + rho) * PREP_LD + 16 * kd + 4 * hh;
                const u32x2 lo = *(const u32x2*)(rowp), hi = *(const u32x2*)(rowp + 8);
                *(u32x4*)(pk + (16 + f) * 1024 + lane * 16) = (u32x4){lo.x, lo.y, hi.x, hi.y}; }
        }
        __syncthreads();
    }
}

constexpr int SCAN_BUF = 41984;
DI bf16x8 pack8(const f32x16& x, int s) {
    u32x4 p; p.x = pk2(x[8 * s], x[8 * s + 1]); p.y = pk2(x[8 * s + 2], x[8 * s + 3]); p.z = pk2(x[8 * s + 4], x[8 * s + 5]); p.w = pk2(x[8 * s + 6], x[8 * s + 7]);
    return __builtin_bit_cast(bf16x8, p);
}
DI void scan_stage(const unsigned char* src, unsigned char* dst, int wave, int lane) {
#pragma unroll
    for (int i = 0; i < 6; ++i) { const int q = i * 8 + wave; if (q < 41)
        __builtin_amdgcn_global_load_lds((const unsigned*)(src + (size_t)q * 1024 + lane * 16), (PG8_LAS unsigned*)(dst + q * 1024), 16, 0, 0); }
}
DI void scan_phase(const Args& a, unsigned char* lds, int wave, int lane) {
    const int sb = blockIdx.x; if (sb >= 32) return;
    unsigned char* ws = a.ws;
    const int stream = (sb & 7) | ((sb >> 4) << 3), vhalf = (sb >> 3) & 1;
    const int b = stream >> 3, dir = (stream >> 2) & 1, h = stream & 3;
    const int nsteps = dir ? 128 : 129;
    const unsigned char* pkbase = dir ? (ws + WS_PKB + (size_t)((b * 4 + h) * 128) * PK_BYTES) : (ws + WS_PKF + (size_t)((b * 4 + h) * 129) * PK_BYTES);
    const bf16_t* VGT = (const bf16_t*)(ws + WS_VGT); const bf16_t* VMT = (const bf16_t*)(ws + WS_VMT);
    bf16_t* OUT = dir ? (bf16_t*)(ws + WS_OB) : (bf16_t*)(ws + WS_AO); const int ldo = dir ? 1024 : 2048;
    const int r = lane & 31, hh = lane >> 5;
    const int vcol = h * 256 + vhalf * 128 + 32 * (wave & 3) + r;
    scan_stage(pkbase + (size_t)(dir ? 127 : 0) * PK_BYTES, lds, wave, lane);
    bf16x8 vt[4], vtn[4];
    if (wave < 4) {
        if (dir == 0) {
#pragma unroll
            for (int ks = 0; ks < 4; ++ks) vt[ks] = *(const bf16x8*)(VMT + (size_t)vcol * 64 + 16 * ks + 8 * hh);
        } else {
#pragma unroll
            for (int ks = 0; ks < 4; ++ks) vt[ks] = *(const bf16x8*)(VGT + (size_t)vcol * NTOK + (size_t)b * SEQ + 127 * 64 + 16 * ks + 8 * hh);
        }
    }
    f32x16 S[4];
#pragma unroll
    for (int dt = 0; dt < 4; ++dt)
#pragma unroll
        for (int i = 0; i < 16; ++i) S[dt][i] = 0.f;
    asm volatile("s_waitcnt vmcnt(0)" ::: "memory");
    __syncthreads();
    for (int n = 0; n < nsteps; ++n) {
        const unsigned char* buf = lds + (size_t)(n & 1) * SCAN_BUF;
        const bool has_next = (n + 1 < nsteps);
        const int cn = dir ? (127 - (n + 1)) : n;
        if (has_next) scan_stage(pkbase + (size_t)(dir ? (127 - (n + 1)) : (n + 1)) * PK_BYTES, lds + (size_t)((n + 1) & 1) * SCAN_BUF, wave, lane);
        if (wave < 4) {
            if (has_next) {
#pragma unroll
                for (int ks = 0; ks < 4; ++ks) vtn[ks] = *(const bf16x8*)(VGT + (size_t)vcol * NTOK + (size_t)b * SEQ + cn * 64 + 16 * ks + 8 * hh);
            }
            if (!(dir == 0 && n == 0)) {
                const int c = dir ? (127 - n) : (n - 1);
                f32x16 o[2];
#pragma unroll
                for (int it = 0; it < 2; ++it)
#pragma unroll
                    for (int i = 0; i < 16; ++i) o[it][i] = 0.f;
#pragma unroll
                for (int dt = 0; dt < 4; ++dt) {
                    const bf16x8 s0 = pack8(S[dt], 0), s1 = pack8(S[dt], 1);
#pragma unroll
                    for (int it = 0; it < 2; ++it) {
                        const bf16x8 q0 = *(const bf16x8*)(buf + (16 + it * 8 + 2 * dt) * 1024 + lane * 16);
                        const bf16x8 q1 = *(const bf16x8*)(buf + (16 + it * 8 + 2 * dt + 1) * 1024 + lane * 16);
                        o[it] = MFMA32(q0, s0, o[it]); o[it] = MFMA32(q1, s1, o[it]);
                    }
                }
#pragma unroll
                for (int it = 0; it < 2; ++it)
#pragma unroll
                    for (int ks = 0; ks < 4; ++ks) { const bf16x8 af = *(const bf16x8*)(buf + (32 + it * 4 + ks) * 1024 + lane * 16); o[it] = MFMA32(af, vt[ks], o[it]); }
                const size_t tokb = (size_t)b * SEQ + c * 64;
#pragma unroll
                for (int it = 0; it < 2; ++it)
#pragma unroll
                    for (int g = 0; g < 16; ++g) { const int i = 32 * it + crow(g, hh); OUT[(tokb + i) * ldo + vcol] = (bf16_t)(pk2(o[it][g], 0.f) & 0xffffu); }
#pragma unroll
                for (int dt = 0; dt < 4; ++dt)
#pragma unroll
                    for (int g4 = 0; g4 < 4; ++g4) { const f32x4 av = *(const f32x4*)(buf + PK_A_OFF + (32 * dt + 8 * g4 + 4 * hh) * 4);
                        S[dt][4 * g4] *= av[0]; S[dt][4 * g4 + 1] *= av[1]; S[dt][4 * g4 + 2] *= av[2]; S[dt][4 * g4 + 3] *= av[3]; }
            }
#pragma unroll
            for (int dt = 0; dt < 4; ++dt)
#pragma unroll
                for (int ks = 0; ks < 4; ++ks) { const bf16x8 kf = *(const bf16x8*)(buf + (dt * 4 + ks) * 1024 + lane * 16); S[dt] = MFMA32(kf, vt[ks], S[dt]); }
            if (has_next) {
#pragma unroll
                for (int ks = 0; ks < 4; ++ks) vt[ks] = vtn[ks];
            }
        }
        asm volatile("s_waitcnt vmcnt(0)" ::: "memory");
        __syncthreads();
    }
}

DI void combine_phase(const Args& a, int vcu, int G, int wave, int lane) {
    unsigned char* ws = a.ws;
    bf16_t* AO = (bf16_t*)(ws + WS_AO); const bf16_t* OB = (const bf16_t*)(ws + WS_OB); const bf16_t* GG = (const bf16_t*)a.out;
    const int gw = vcu * NWAVES + wave, NGW = G * NWAVES;
    const f32x4 gn = *(const f32x4*)(a.gla_g + 4 * lane);
    for (int t = gw; t < NTOK * 4; t += NGW) {
        const size_t tok = t >> 2; const int h = t & 3;
        const u32x2 f = *(const u32x2*)(AO + tok * 2048 + h * 256 + 4 * lane);
        const u32x2 bq = *(const u32x2*)(OB + tok * 1024 + h * 256 + 4 * lane);
        const u32x2 gg = *(const u32x2*)(GG + tok * 1024 + h * 256 + 4 * lane);
        float o[4];
        o[0] = __uint_as_float(f.x << 16) + __uint_as_float(bq.x << 16); o[1] = __uint_as_float(f.x & 0xffff0000u) + __uint_as_float(bq.x & 0xffff0000u);
        o[2] = __uint_as_float(f.y << 16) + __uint_as_float(bq.y << 16); o[3] = __uint_as_float(f.y & 0xffff0000u) + __uint_as_float(bq.y & 0xffff0000u);
        const float ss = wave_sum((o[0] * o[0] + o[1] * o[1]) + (o[2] * o[2] + o[3] * o[3]));
        const float rstd = 1.0f / sqrtf(ss * (1.f / 256.f) + RMS_EPS);
        const float g0 = __uint_as_float(gg.x << 16), g1 = __uint_as_float(gg.x & 0xffff0000u), g2 = __uint_as_float(gg.y << 16), g3 = __uint_as_float(gg.y & 0xffff0000u);
        u32x2 w; w.x = pk2(o[0] * rstd * gn[0] * g0, o[1] * rstd * gn[1] * g1); w.y = pk2(o[2] * rstd * gn[2] * g2, o[3] * rstd * gn[3] * g3);
        *(u32x2*)(AO + tok * 2048 + h * 256 + 4 * lane) = w;
    }
}

__global__ void __launch_bounds__(NWAVES * 64, 2) hybrid_fwd(Args args, int ph_lo, int ph_hi) {
    extern __shared__ __attribute__((aligned(16))) unsigned char lds[];
    cg::grid_group grid = cg::this_grid();
    const int tid = threadIdx.x, lane = tid & 63, wave = __builtin_amdgcn_readfirstlane(tid >> 6);
    const int G = gridDim.x, bx = blockIdx.x;
    const int vcu = (G % 8 == 0) ? (bx % 8) * (G / 8) + bx / 8 : bx;
    unsigned char* ws = args.ws;
#define IN(k) (ph_lo <= (k) && (k) < ph_hi)
#define SEAM(k) do { if (IN(k) && IN((k) + 1)) grid.sync(); } while (0)
    if (IN(0)) { p0_phase(args, lds, vcu, G, wave, lane); }
    SEAM(0);
    if (IN(1)) {
        p1_skinny(args, vcu, G, wave, lane);
        const bf16_t* XW = (const bf16_t*)(ws + WS_XW);
        pg8::Gemm g{XW, XW, NTOK, 7168, DM};
        OrderIn S{G, bx};
        EpiIn E{(bf16_t*)(ws + WS_QG), (bf16_t*)(ws + WS_KG), (bf16_t*)args.out, (bf16_t*)args.out + (size_t)NTOK * 1024, (bf16_t*)(ws + WS_AO), (bf16_t*)(ws + WS_NK),
                (bf16_t*)(ws + WS_VGT), (bf16_t*)(ws + WS_NVT), args.qn_g, args.kn_g};
        pg8::gemm_phase<EpiIn, OrderIn, true, true>((PG8_LAS unsigned char*)lds, g, S, E);
    }
    SEAM(1);
    if (IN(2)) { na_phase(args, lds, vcu, G, wave, lane); }
    SEAM(2);
    if (IN(3)) { prep_phase(args, lds, vcu, G, wave, lane); }
    SEAM(3);
    if (IN(4)) { scan_phase(args, lds, wave, lane); }
    SEAM(4);
    if (IN(5)) { combine_phase(args, vcu, G, wave, lane); }
    SEAM(5);
    if (IN(6)) {
        pg8::Gemm g{(const bf16_t*)(ws + WS_AO), (const bf16_t*)(ws + WS_WO), NTOK, DM, 2048};
        pg8::StaticOrder S; S.init(NTOK, DM, G, bx);
        EpiOut E{args.x, args.out};
        pg8::gemm_phase<EpiOut, pg8::StaticOrder, false, true>((PG8_LAS unsigned char*)lds, g, S, E);
    }
#undef IN
#undef SEAM
}

#ifndef N_LAUNCHES
#define N_LAUNCHES 1
#endif
extern "C" void kernel_launch(void* const* d_in, const int* in_sizes, int n_in, void* d_out, int out_size, void* d_ws, size_t ws_size, hipStream_t stream) {
    static int grid = 0;
    if (grid == 0) {
        if (n_in != 14 || out_size != NTOK * DM || ws_size < WS_END) { fprintf(stderr, "kernel_launch: unexpected problem (n_in %d out %d ws %zu)\n", n_in, out_size, ws_size); grid = -1; return; }
        int dev = 0, cus = 0, per_cu = 0;
        hipGetDevice(&dev); hipDeviceGetAttribute(&cus, hipDeviceAttributeMultiprocessorCount, dev);
        if (hipFuncSetAttribute((const void*)hybrid_fwd, hipFuncAttributeMaxDynamicSharedMemorySize, LDS_BYTES) != hipSuccess) { fprintf(stderr, "kernel_launch: hipFuncSetAttribute failed\n"); grid = -1; return; }
        if (hipOccupancyMaxActiveBlocksPerMultiprocessor(&per_cu, (const void*)hybrid_fwd, NWAVES * 64, LDS_BYTES) != hipSuccess || per_cu < 1) { fprintf(stderr, "kernel_launch: occupancy query gave %d\n", per_cu); per_cu = 1; }
        (void)hipGetLastError();
        grid = cus * per_cu;
        if (grid > 256) grid = 256;
    }
    if (grid < 0) return;
    Args a{};
    a.x = (const float*)d_in[0]; a.meta = (const float*)d_in[1]; a.norm_g = (const float*)d_in[2]; a.w_in = (const float*)d_in[3];
    a.wd_f = (const float*)d_in[4]; a.bd_f = (const float*)d_in[5]; a.wd_b = (const float*)d_in[6]; a.bd_b = (const float*)d_in[7];
    a.gla_g = (const float*)d_in[8]; a.qn_g = (const float*)d_in[9]; a.kn_g = (const float*)d_in[10]; a.rpb = (const float*)d_in[11];
    a.meta_bias = (const float*)d_in[12]; a.w_out = (const float*)d_in[13];
    a.out = (float*)d_out; a.ws = (unsigned char*)d_ws;
#if N_LAUNCHES == 1
    int lo = 0, hi = 7;
    void* kargs[] = {&a, &lo, &hi};
    hipError_t e = hipLaunchCooperativeKernel((const void*)hybrid_fwd, dim3(grid), dim3(NWAVES * 64), kargs, LDS_BYTES, stream);
    if (e != hipSuccess) fprintf(stderr, "kernel_launch: cooperative launch failed: %s (grid %d)\n", hipGetErrorString(e), grid);
#else
    for (int p = 0; p < 7; ++p) hipLaunchKernelGGL(hybrid_fwd, dim3(grid), dim3(NWAVES * 64), LDS_BYTES, stream, a, p, p + 1);
#endif
}
```

```cpp
#include <hip/hip_runtime.h>
#include <hip/hip_cooperative_groups.h>
#include <cstdio>
#include <cstdint>
namespace cg = cooperative_groups;
namespace pg8 {
#define PG8_LAS __attribute__((address_space(3)))
typedef unsigned short bf16_t;
typedef short bf16x8 __attribute__((ext_vector_type(8)));
typedef float f32x4 __attribute__((ext_vector_type(4)));
typedef unsigned u32x4 __attribute__((ext_vector_type(4)));
constexpr int BM = 256, BK = 64, HALF = 128, HTB = HALF * BK * 2  , STAGE_BYTES = 8 * HTB, NXCD = 8, WGM = 8;

__host__ __device__ __forceinline__ int lds_byte(int r, int c) { const int st = (r >> 4) * 2 + (c >> 5), rr = r & 15, cc = c & 31, ob = rr * 64 + cc * 2; return st * 1024 + (ob ^ (((ob >> 9) & 1) << 5)); }
__host__ __device__ __forceinline__ void stage_rc(int b, int& R, int& C) { const int st = b / 1024, sb = b % 1024, swz = sb ^ (((sb >> 9) & 1) << 5); R = (st >> 1) * 16 + swz / 64; C = (st & 1) * 32 + (swz % 64) / 2; }
__host__ __device__ __forceinline__ int perm32(int rho) { const int n = rho >> 4, i = rho & 15; return 8 * (i >> 2) + 4 * n + (i & 3); }

struct Unit { int pm, pn; };
struct Gemm { const bf16_t* A; const bf16_t* Bt; int M, N, K; };

struct StaticOrder {
    int nM, nN, nwg, G, c;
    __host__ __device__ void init(int M, int N, int G_, int c_) { nM = M / BM; nN = N / BM; nwg = nM * nN; G = G_; c = c_; }
    __host__ __device__ bool next(int i, Unit& u) const {
        const long L = (long)i * G + c; if (L >= nwg) return false;
        int wgid = (int)L; { const int q = nwg / NXCD, r = nwg % NXCD, xcd = wgid % NXCD, off = wgid / NXCD; wgid = (xcd < r ? xcd * (q + 1) : r * (q + 1) + (xcd - r) * q) + off; }
        const int nig = WGM * nN, gid = wgid / nig, fm = gid * WGM, gsz = (nM - fm) < WGM ? (nM - fm) : WGM;
        u.pm = fm + ((wgid % nig) % gsz); u.pn = (wgid % nig) / gsz; return true;
    }
    __device__ __forceinline__ void a_ready(const Unit&) const {}
    __device__ __forceinline__ void done(const Unit&) const {}
};

__device__ __forceinline__ unsigned cvt_pk_bf16(float lo, float hi) { unsigned r; asm volatile("v_cvt_pk_bf16_f32 %0, %1, %2" : "=v"(r) : "v"(lo), "v"(hi)); return r; }
template <class Epi, class Sched, bool ALIGN_EPI = false, bool SP2 = false>
__device__ __forceinline__ void gemm_phase(PG8_LAS unsigned char* lds, const Gemm g, const Sched& S, const Epi& E) {
    const int tid = threadIdx.x, wid = __builtin_amdgcn_readfirstlane(tid >> 6), lane = tid & 63, wr = wid >> 2, wc = wid & 3, fr = lane & 15, fq = lane >> 4;
    const int K = g.K, nt = K / BK;
    unsigned voffA[2], voffB[2];
#pragma unroll
    for (int i = 0; i < 2; ++i) { int R, C; stage_rc(tid * 16 + i * 8192, R, C); const int Rb = Epi::PERM ? ((R & ~31) + perm32(R & 31)) : R;
        voffA[i] = (unsigned)(R * K + C) * 2u; voffB[i] = (unsigned)(Rb * K + C) * 2u; }
    const size_t kstep = (size_t)(BK * 2);
    const size_t hstep = (size_t)HALF * K * 2;
    const size_t tstep = 2 * hstep;
    const unsigned ldsw = (unsigned)wid * 1024u;
    const int aoff = lds_byte(wr * 64 + fr, fq * 8), boff = lds_byte(wc * 32 + fr, fq * 8);
#define PG8_SA(b, h) (((b) * 2 + (h)) * HTB)
#define PG8_SB(b, h) ((4 + (b) * 2 + (h)) * HTB)
#define PG8_STAGE(bufoff, gbase, voff) do { _Pragma("unroll") for (int _i = 0; _i < 2; ++_i) \
        __builtin_amdgcn_global_load_lds((const unsigned*)((const char*)(gbase) + (voff)[_i]), (PG8_LAS unsigned*)(lds + (bufoff) + ldsw + _i * 8192), 16, 0, 0); } while (0)
#define PG8_LDA(dst, b, h) do { _Pragma("unroll") for (int m = 0; m < 4; ++m) _Pragma("unroll") for (int k = 0; k < 2; ++k) dst[m][k] = *(const PG8_LAS bf16x8*)(lds + PG8_SA(b, h) + aoff + m * 2048 + k * 1024); } while (0)
#define PG8_LDB(dst, b, h) do { _Pragma("unroll") for (int n = 0; n < 2; ++n) _Pragma("unroll") for (int k = 0; k < 2; ++k) dst[n][k] = *(const PG8_LAS bf16x8*)(lds + PG8_SB(b, h) + boff + n * 2048 + k * 1024); } while (0)
#define PG8_MMA(ai, bj, At, Bt) do { __builtin_amdgcn_s_setprio(1); _Pragma("unroll") for (int m = 0; m < 4; ++m) _Pragma("unroll") for (int n = 0; n < 2; ++n) _Pragma("unroll") for (int k = 0; k < 2; ++k) \
        acc[ai][bj][m][n] = __builtin_amdgcn_mfma_f32_16x16x32_bf16(Bt[n][k], At[m][k], acc[ai][bj][m][n], 0, 0, 0); __builtin_amdgcn_s_setprio(0); } while (0)
#define PG8_WAIT_V(n) asm volatile("s_waitcnt vmcnt(" #n ")" ::: "memory")
#define PG8_WAIT_L(n) asm volatile("s_waitcnt lgkmcnt(" #n ")" ::: "memory")
#define PG8_BAR __builtin_amdgcn_s_barrier()
#define PG8_SCHED __builtin_amdgcn_sched_barrier(0)
    Unit cur, nxt; int ui = 0;
    if (!S.next(0, cur)) return;
    f32x4 acc[2][2][4][2];
#pragma unroll
    for (int a = 0; a < 2; ++a)
#pragma unroll
        for (int b = 0; b < 2; ++b)
#pragma unroll
            for (int m = 0; m < 4; ++m)
#pragma unroll
                for (int n = 0; n < 2; ++n) acc[a][b][m][n] = (f32x4){0.f, 0.f, 0.f, 0.f};
    bf16x8 At[4][2], B0[2][2], B1[2][2];
    const char* cA = (const char*)g.A + (size_t)cur.pm * tstep; const char* cB = (const char*)g.Bt + (size_t)cur.pn * tstep;
    S.a_ready(cur);
    if constexpr (SP2) {
        PG8_STAGE(PG8_SB(0, 0), cB, voffB); PG8_STAGE(PG8_SB(0, 1), cB + hstep, voffB); PG8_STAGE(PG8_SA(0, 0), cA, voffA); PG8_STAGE(PG8_SA(0, 1), cA + hstep, voffA);
        if (wr == 1) PG8_BAR;
        PG8_WAIT_V(2); PG8_BAR;
        PG8_STAGE(PG8_SB(1, 0), cB + kstep, voffB); PG8_STAGE(PG8_SA(1, 0), cA + kstep, voffA); PG8_STAGE(PG8_SB(1, 1), cB + hstep + kstep, voffB);
        PG8_WAIT_V(6); PG8_BAR;
    } else {
        PG8_STAGE(PG8_SB(0, 0), cB, voffB); PG8_STAGE(PG8_SA(0, 0), cA, voffA); PG8_STAGE(PG8_SB(0, 1), cB + hstep, voffB); PG8_STAGE(PG8_SA(0, 1), cA + hstep, voffA);
        if (wr == 1) PG8_BAR;
        PG8_WAIT_V(4); PG8_BAR;
        PG8_STAGE(PG8_SB(1, 0), cB + kstep, voffB); PG8_STAGE(PG8_SA(1, 0), cA + kstep, voffA); PG8_STAGE(PG8_SB(1, 1), cB + hstep + kstep, voffB);
        PG8_WAIT_V(6); PG8_BAR;
    }
    for (;;) {
        const bool has_next = S.next(ui + 1, nxt);
        const char* nA = has_next ? (const char*)g.A + (size_t)nxt.pm * tstep : cA; const char* nB = has_next ? (const char*)g.Bt + (size_t)nxt.pn * tstep : cB;
        for (int t = 0; t < nt; t += 2) {
            const bool last = (t == nt - 2);
            const char* a1 = cA + (size_t)(t + 1) * kstep;
            const char* a2 = last ? nA : cA + (size_t)(t + 2) * kstep; const char* b2 = last ? nB : cB + (size_t)(t + 2) * kstep;
            const char* a3 = a2 + kstep; const char* b3 = b2 + kstep;
            if (last && has_next) S.a_ready(nxt);
            if constexpr (SP2) {
            PG8_LDB(B0, 0, 0); PG8_LDB(B1, 0, 1); PG8_SCHED; PG8_LDA(At, 0, 0); PG8_STAGE(PG8_SA(1, 1), a1 + hstep, voffA);
            PG8_WAIT_V(8); PG8_WAIT_L(0); PG8_BAR; PG8_MMA(0, 0, At, B0); PG8_MMA(0, 1, At, B1); PG8_BAR; PG8_SCHED;
            PG8_LDA(At, 0, 1); PG8_STAGE(PG8_SB(0, 0), b2, voffB); PG8_STAGE(PG8_SB(0, 1), b2 + hstep, voffB); PG8_STAGE(PG8_SA(0, 0), a2, voffA);
            PG8_WAIT_V(8); PG8_WAIT_L(0); PG8_BAR; PG8_MMA(1, 0, At, B0); PG8_MMA(1, 1, At, B1); PG8_BAR; PG8_SCHED;
            PG8_LDB(B0, 1, 0); PG8_LDB(B1, 1, 1); PG8_SCHED; PG8_LDA(At, 1, 0); PG8_STAGE(PG8_SA(0, 1), a2 + hstep, voffA);
            PG8_WAIT_V(8); PG8_WAIT_L(0); PG8_BAR; PG8_MMA(0, 0, At, B0); PG8_MMA(0, 1, At, B1); PG8_BAR; PG8_SCHED;
            PG8_LDA(At, 1, 1); PG8_STAGE(PG8_SB(1, 0), b3, voffB); PG8_STAGE(PG8_SB(1, 1), b3 + hstep, voffB); PG8_STAGE(PG8_SA(1, 0), a3, voffA);
            PG8_WAIT_V(8); PG8_WAIT_L(0); PG8_BAR; PG8_MMA(1, 0, At, B0); PG8_MMA(1, 1, At, B1); PG8_BAR; PG8_SCHED;
            } else {
            PG8_LDB(B0, 0, 0); PG8_SCHED; PG8_LDA(At, 0, 0); PG8_STAGE(PG8_SA(1, 1), a1 + hstep, voffA);
            PG8_WAIT_L(8); PG8_BAR; PG8_WAIT_L(0); PG8_MMA(0, 0, At, B0); PG8_BAR; PG8_SCHED;
            PG8_LDB(B1, 0, 1); PG8_STAGE(PG8_SB(0, 0), b2, voffB);
            PG8_BAR; PG8_WAIT_L(0); PG8_MMA(0, 1, At, B1); PG8_BAR;
            PG8_LDA(At, 0, 1); PG8_STAGE(PG8_SA(0, 0), a2, voffA);
            PG8_BAR; PG8_WAIT_L(0); PG8_MMA(1, 0, At, B0); PG8_BAR; PG8_SCHED;
            PG8_STAGE(PG8_SB(0, 1), b2 + hstep, voffB);
            PG8_WAIT_V(6); PG8_BAR; PG8_MMA(1, 1, At, B1); PG8_BAR;
            PG8_LDB(B0, 1, 0); PG8_SCHED; PG8_LDA(At, 1, 0); PG8_STAGE(PG8_SA(0, 1), a2 + hstep, voffA);
            PG8_WAIT_L(8); PG8_BAR; PG8_WAIT_L(0); PG8_MMA(0, 0, At, B0); PG8_BAR; PG8_SCHED;
            PG8_LDB(B1, 1, 1); PG8_STAGE(PG8_SB(1, 0), b3, voffB);
            PG8_BAR; PG8_WAIT_L(0); PG8_MMA(0, 1, At, B1); PG8_BAR;
            PG8_LDA(At, 1, 1); PG8_STAGE(PG8_SA(1, 0), a3, voffA);
            PG8_BAR; PG8_WAIT_L(0); PG8_MMA(1, 0, At, B0); PG8_BAR; PG8_SCHED;
            PG8_STAGE(PG8_SB(1, 1), b3 + hstep, voffB);
            PG8_WAIT_V(6); PG8_BAR; PG8_MMA(1, 1, At, B1); PG8_BAR;
            }
        }
        if constexpr (ALIGN_EPI) { if (wr == 0) PG8_BAR; }
        if constexpr (!Epi::AFTER_DRAIN) { E(acc, cur, wr, wc, fr, fq); S.done(cur); }
        if (!has_next) break;
#pragma unroll
        for (int a = 0; a < 2; ++a)
#pragma unroll
            for (int b = 0; b < 2; ++b)
#pragma unroll
                for (int m = 0; m < 4; ++m)
#pragma unroll
                    for (int n = 0; n < 2; ++n) acc[a][b][m][n] = (f32x4){0.f, 0.f, 0.f, 0.f};
        cur = nxt; cA = nA; cB = nB; ++ui;
        if constexpr (ALIGN_EPI) { if (wr == 1) PG8_BAR; }
    }
    PG8_WAIT_V(0);
    if constexpr (!ALIGN_EPI) { if (wr == 0) PG8_BAR; }
    PG8_BAR;
    if constexpr (Epi::AFTER_DRAIN) { E.fused(acc, cur, wr, wc, fr, fq, lds, wid, lane); S.done(cur); }
#undef PG8_SA
#undef PG8_SB
#undef PG8_STAGE
#undef PG8_LDA
#undef PG8_LDB
#undef PG8_MMA
#undef PG8_WAIT_V
#undef PG8_WAIT_L
#undef PG8_BAR
#undef PG8_SCHED
}
}

#define DI __device__ __forceinline__
typedef unsigned short bf16_t;
typedef short bf16x8 __attribute__((ext_vector_type(8)));
typedef float f32x4 __attribute__((ext_vector_type(4)));
typedef float f32x2 __attribute__((ext_vector_type(2)));
typedef float f32x16 __attribute__((ext_vector_type(16)));
typedef unsigned u32x4 __attribute__((ext_vector_type(4)));
typedef unsigned u32x2 __attribute__((ext_vector_type(2)));
typedef __bf16 bf2_t __attribute__((ext_vector_type(2)));

constexpr int NTOK = 16384, SEQ = 8192, DM = 1024, NIN = 7200, NWAVES = 8;
constexpr float RMS_EPS = 1e-6f;
constexpr float LOG2E = 1.4426950408889634f;
constexpr size_t MiB = (size_t)1 << 20;
constexpr size_t WS_ZM = 0, WS_VMT = 512 * 1024, WS_UM = 640 * 1024, WS_WS = 704 * 1024, WS_R = 1 * MiB, WS_WO = 3 * MiB, WS_XW = 8 * MiB,
                 WS_AO = 54 * MiB, WS_NK = 118 * MiB, WS_NVT = 150 * MiB, WS_VGT = 182 * MiB, WS_QG = 214 * MiB, WS_KG = 230 * MiB, WS_OB = 214 * MiB,
                 WS_PKF = WS_XW, WS_PKB = WS_NK, WS_CTL = 246 * MiB, WS_END = 247 * MiB;
constexpr int PK_BYTES = 41472;
constexpr int PK_A_OFF = 40960;
constexpr int LDS_BYTES = 155648;

DI unsigned pk2(float lo, float hi) { f32x2 v = {lo, hi}; bf2_t b = __builtin_convertvector(v, bf2_t); return __builtin_bit_cast(unsigned, b); }
DI float bf2f(bf16_t u) { return __uint_as_float(((unsigned)u) << 16); }
DI float wave_sum(float v) {
#pragma unroll
    for (int o = 1; o < 64; o <<= 1) v += __shfl_xor(v, o);
    return v;
}
DI float silu_f(float x) { return x * __builtin_amdgcn_rcpf(1.f + __expf(-x)); }
DI int crow(int reg, int h) { return (reg & 3) + 8 * (reg >> 2) + 4 * h; }
#define MFMA32(a, b, c) __builtin_amdgcn_mfma_f32_32x32x16_bf16((a), (b), (c), 0, 0, 0)
#define MFMA16(a, b, c) __builtin_amdgcn_mfma_f32_16x16x32_bf16((a), (b), (c), 0, 0, 0)

struct Args {
    const float *x, *meta, *norm_g, *w_in, *wd_f, *bd_f, *wd_b, *bd_b, *gla_g, *qn_g, *kn_g, *rpb, *meta_bias, *w_out;
    float* out; unsigned char* ws;
};

DI int phys_norm(int wt, int lc) { return 256 * wt + 128 * ((lc >> 5) & 1) + 32 * (lc >> 6) + (lc & 31); }

DI void p0_transpose_item(const float* W, int ldw, int k0, int n0, bf16_t* WT, int ldwt, int row0, float* scr, int lane) {
#pragma unroll 8
    for (int i = 0; i < 32; ++i) { const int kk = 2 * i + (lane >> 5); scr[kk * 33 + (lane & 31)] = W[(size_t)(k0 + kk) * ldw + n0 + (lane & 31)]; }
    asm volatile("s_waitcnt lgkmcnt(0)" ::: "memory");
    const int c = lane & 7;
#pragma unroll
    for (int j = 0; j < 4; ++j) { const int n = (lane >> 3) + 8 * j; const float* s = scr + (8 * c) * 33 + n;
        u32x4 o; o.x = pk2(s[0 * 33], s[1 * 33]); o.y = pk2(s[2 * 33], s[3 * 33]); o.z = pk2(s[4 * 33], s[5 * 33]); o.w = pk2(s[6 * 33], s[7 * 33]);
        *(u32x4*)(WT + (size_t)(row0 + n) * ldwt + k0 + 8 * c) = o; }
    asm volatile("s_waitcnt lgkmcnt(0)" ::: "memory");
}
DI int wt_base(int wt) {
    if (wt < 2) return 0 + 256 * wt;
    if (wt < 4) return 512 + 256 * (wt - 2);
    if (wt < 8) return 2080 + 256 * (wt - 4);
    if (wt < 12) return 3104 + 256 * (wt - 8);
    if (wt < 16) return 4128 + 256 * (wt - 12);
    if (wt < 20) return 6176 + 256 * (wt - 16);
    if (wt < 24) return 1024 + 256 * (wt - 20);
    return 5152 + 256 * (wt - 24);
}
DI void rms_row_to_bf16(const float* xrow, const float* g, bf16_t* orow, int lane) {
    const f32x4* xr = (const f32x4*)xrow + lane; const f32x4* gr = (const f32x4*)g + lane;
    f32x4 v[4]; float s = 0.f;
#pragma unroll
    for (int j = 0; j < 4; ++j) { v[j] = xr[64 * j]; s += (v[j].x * v[j].x + v[j].y * v[j].y) + (v[j].z * v[j].z + v[j].w * v[j].w); }
    const float rstd = 1.0f / sqrtf(wave_sum(s) * (1.f / DM) + RMS_EPS);
    unsigned long long* o8 = (unsigned long long*)orow + lane;
#pragma unroll
    for (int j = 0; j < 4; ++j) { const f32x4 gg = gr[64 * j];
        o8[64 * j] = (unsigned long long)pk2(v[j].x * rstd * gg.x, v[j].y * rstd * gg.y) | ((unsigned long long)pk2(v[j].z * rstd * gg.z, v[j].w * rstd * gg.w) << 32); }
}
DI void p0_phase(const Args& a, unsigned char* lds, int vcu, int G, int wave, int lane) {
    unsigned char* ws = a.ws;
    float* scr = (float*)(lds + wave * 16384);
    bf16_t* XW = (bf16_t*)(ws + WS_XW); bf16_t* WSs = (bf16_t*)(ws + WS_WS); bf16_t* WO = (bf16_t*)(ws + WS_WO); bf16_t* UM = (bf16_t*)(ws + WS_UM);
    const int gw = vcu * NWAVES + wave, NGW = G * NWAVES;
    constexpr int I_A = 28 * 8 * 16, I_B = 16, I_C = 32 * 32;
    for (int it = gw; it < I_A + I_B + I_C; it += NGW) {
        int r = it;
        if (r < I_A) { const int wt = r >> 7, g = (r >> 4) & 7, kb = r & 15;
            const int lc0 = (wt < 20) ? (64 * (g & 3) + 32 * (g >> 2)) : 32 * g;
            p0_transpose_item(a.w_in, NIN, 64 * kb, wt_base(wt) + lc0, XW, DM, NTOK + 256 * wt + 32 * g, scr, lane); continue; }
        r -= I_A;
        if (r < I_B) { p0_transpose_item(a.w_in, NIN, 64 * r, 2048, WSs, DM, 0, scr, lane); continue; }
        r -= I_B;
        { const int kb = r >> 5, nb = r & 31; p0_transpose_item(a.w_out, DM, 64 * kb, 32 * nb, WO, 2048, 32 * nb, scr, lane); }
    }
    for (int m = gw; m < NTOK + 16; m += NGW) {
        if (m < NTOK) rms_row_to_bf16(a.x + (size_t)m * DM, a.norm_g, XW + (size_t)m * DM, lane);
        else rms_row_to_bf16(a.meta + (size_t)(m - NTOK) * DM, a.norm_g, UM + (size_t)(m - NTOK) * DM, lane);
    }
}

DI void skinny_task(const bf16_t* A, const bf16_t* B, float* O, int ldo, int lane) {
    const int r = lane & 15, q = lane >> 4;
    const bf16x8* ap = (const bf16x8*)(A + (size_t)r * DM + 8 * q);
    const bf16x8* b0 = (const bf16x8*)(B + (size_t)r * DM + 8 * q);
    const bf16x8* b1 = (const bf16x8*)(B + (size_t)(16 + r) * DM + 8 * q);
    f32x4 acc0 = {0.f, 0.f, 0.f, 0.f}, acc1 = {0.f, 0.f, 0.f, 0.f};
#pragma unroll 8
    for (int ks = 0; ks < 32; ++ks) { const bf16x8 av = ap[4 * ks]; acc0 = MFMA16(av, b0[4 * ks], acc0); acc1 = MFMA16(av, b1[4 * ks], acc1); }
#pragma unroll
    for (int i = 0; i < 4; ++i) { O[(size_t)(4 * q + i) * ldo + r] = acc0[i]; O[(size_t)(4 * q + i) * ldo + 16 + r] = acc1[i]; }
}
DI void p1_skinny(const Args& a, int vcu, int G, int wave, int lane) {
    unsigned char* ws = a.ws;
    const bf16_t* XW = (const bf16_t*)(ws + WS_XW); const bf16_t* WSs = (const bf16_t*)(ws + WS_WS); const bf16_t* UM = (const bf16_t*)(ws + WS_UM);
    float* R = (float*)(ws + WS_R); float* ZM = (float*)(ws + WS_ZM);
    const int gw = vcu * NWAVES + wave, NGW = G * NWAVES;
    for (int t = gw; t < 1024 + 225; t += NGW) {
        if (t < 1024) skinny_task(XW + (size_t)t * 16 * DM, WSs, R + (size_t)t * 16 * 32, 32, lane);
        else { const int c = t - 1024;
            if (c < 224) skinny_task(UM, XW + (size_t)(NTOK + 32 * c) * DM, ZM + 32 * c, NIN, lane);
            else skinny_task(UM, WSs, ZM + 7168, NIN, lane); }
    }
}

struct OrderIn {
    int G, c;
    DI bool next(int i, pg8::Unit& u) const {
        const long L = (long)i * G + c; if (L >= 1792) return false;
        const int ii = (int)(L >> 8), cc = (int)(L & 255), xcd = cc & 7, j = cc >> 3, tok = 8 * xcd + (j & 7), w4 = j >> 3;
        if (ii < 5) { u.pm = tok; u.pn = 64 + 4 * ii + w4; } else { u.pm = 64 + 20 + 4 * (ii - 5) + w4; u.pn = tok; }
        return true;
    }
    DI void a_ready(const pg8::Unit&) const {}
    DI void done(const pg8::Unit&) const {}
};

struct EpiIn {
    static constexpr bool PERM = true, AFTER_DRAIN = false;
    bf16_t *QG, *KG, *GG, *NGt, *AO, *NK, *VGT, *NVT; const float *qn_g, *kn_g;
    DI void operator()(const f32x4 (&acc)[2][2][4][2], const pg8::Unit& u, int wr, int wc, int fr, int fq) const {
        if (u.pm < 64) {
            const int wt = u.pn - 64;
            const int row0 = u.pm * 256 + wr * 64 + fr;
            if (wt < 8 || wt >= 16) {
                bf16_t* base; int ld; float sc = 1.f; bool act = false;
                if (wt < 2) { base = QG + 256 * wt; ld = 512; sc = 0.08838834764831845f; }
                else if (wt < 4) { base = KG + 256 * (wt - 2); ld = 512; }
                else if (wt < 8) { base = GG + 256 * (wt - 4); ld = 1024; act = true; }
                else { base = NGt + 256 * (wt - 16); ld = 1024; act = true; }
#pragma unroll
                for (int ai = 0; ai < 2; ++ai)
#pragma unroll
                    for (int m = 0; m < 4; ++m) { bf16_t* rowp = base + (size_t)(row0 + ai * 128 + m * 16) * ld + 64 * wc + 8 * fq;
#pragma unroll
                        for (int bj = 0; bj < 2; ++bj) { f32x4 v0 = acc[ai][bj][m][0], v1 = acc[ai][bj][m][1];
                            if (act) { v0 = (f32x4){silu_f(v0[0]), silu_f(v0[1]), silu_f(v0[2]), silu_f(v0[3])}; v1 = (f32x4){silu_f(v1[0]), silu_f(v1[1]), silu_f(v1[2]), silu_f(v1[3])}; }
                            v0 = v0 * sc; v1 = v1 * sc;
                            u32x4 w; w.x = pk2(v0[0], v0[1]); w.y = pk2(v0[2], v0[3]); w.z = pk2(v1[0], v1[1]); w.w = pk2(v1[2], v1[3]);
                            *(u32x4*)(rowp + 32 * bj) = w; } }
            } else {
                const bool isq = wt < 12; const float* g = isq ? qn_g : kn_g; const float gs = isq ? (0.125f * LOG2E) : 1.0f;
                const int kb_ = u.pm >> 5, kgrow_ = (u.pm & 31) * 4 + wr;
                bf16_t* base = isq ? (AO + 1024 + 256 * (wt - 8)) : (NK + ((size_t)((kb_ * 16 + 4 * (wt - 12) + wc) * 128 + kgrow_) * 4096)); const int ld = isq ? 2048 : 1024;
                f32x4 gv[2][2];
#pragma unroll
                for (int bj = 0; bj < 2; ++bj)
#pragma unroll
                    for (int n = 0; n < 2; ++n) gv[bj][n] = *(const f32x4*)(g + 32 * bj + 8 * fq + 4 * n) * gs;
#pragma unroll
                for (int ai = 0; ai < 2; ++ai)
#pragma unroll
                    for (int m = 0; m < 4; ++m) {
                        float ss = 0.f;
#pragma unroll
                        for (int bj = 0; bj < 2; ++bj)
#pragma unroll
                            for (int n = 0; n < 2; ++n) { const f32x4 v = acc[ai][bj][m][n]; ss += (v[0] * v[0] + v[1] * v[1]) + (v[2] * v[2] + v[3] * v[3]); }
                        ss += __shfl_xor(ss, 16); ss += __shfl_xor(ss, 32);
                        const float rstd = 1.0f / sqrtf(ss * (1.f / 64.f) + RMS_EPS);
                        bf16_t* rowp = isq ? (base + (size_t)(row0 + ai * 128 + m * 16) * ld + 64 * wc + 8 * fq) : (base + (size_t)ai * 2 * 4096 + (m * 16 + fr) * 64 + 8 * fq);
#pragma unroll
                        for (int bj = 0; bj < 2; ++bj) { const f32x4 v0 = acc[ai][bj][m][0] * rstd * gv[bj][0], v1 = acc[ai][bj][m][1] * rstd * gv[bj][1];
                            u32x4 w; w.x = pk2(v0[0], v0[1]); w.y = pk2(v0[2], v0[3]); w.z = pk2(v1[0], v1[1]); w.w = pk2(v1[2], v1[3]);
                            *(u32x4*)(rowp + 32 * bj) = w; }
                    }
            }
        } else {
            const int wt = u.pm - 64;
            if (wt < 24) {
                const int bb = u.pn >> 5, cbase = (u.pn & 31) * 4 + (wc >> 1), ksb = (wc & 1) * 2;
                bf16_t* lp = VGT + ((fq & 1) * 32 + fr) * 8 + (fq >> 1) * 512;
#pragma unroll
                for (int ai = 0; ai < 2; ++ai)
#pragma unroll
                    for (int m = 0; m < 4; ++m)
#pragma unroll
                        for (int bj = 0; bj < 2; ++bj) { const f32x4 v0 = acc[ai][bj][m][0], v1 = acc[ai][bj][m][1];
                            u32x4 w; w.x = pk2(v0[0], v0[1]); w.y = pk2(v0[2], v0[3]); w.z = pk2(v1[0], v1[1]); w.w = pk2(v1[2], v1[3]);
                            const int frag = (((bb * 4 + (wt - 20)) * 128 + cbase + 2 * bj) * 8 + wr * 2 + ai * 4 + (m >> 1)) * 4 + ksb;
                            *(u32x4*)(lp + (size_t)frag * 512 + (m & 1) * 128) = w; }
            } else {
                const int vb_ = u.pn >> 5, vgrow_ = (u.pn & 31) * 4 + (wc >> 1);
                bf16_t* lp = NVT + fr * 64 + (wc & 1) * 32 + 8 * fq;
#pragma unroll
                for (int ai = 0; ai < 2; ++ai)
#pragma unroll
                    for (int m = 0; m < 4; ++m)
#pragma unroll
                        for (int bj = 0; bj < 2; ++bj) { const f32x4 v0 = acc[ai][bj][m][0], v1 = acc[ai][bj][m][1];
                            u32x4 w; w.x = pk2(v0[0], v0[1]); w.y = pk2(v0[2], v0[3]); w.z = pk2(v1[0], v1[1]); w.w = pk2(v1[2], v1[3]);
                            const int slab = (vb_ * 16 + 4 * (wt - 24) + 2 * ai + wr) * 128 + vgrow_ + 2 * bj;
                            *(u32x4*)(lp + (size_t)slab * 4096 + m * 16 * 64) = w; }
            }
        }
    }
};

struct EpiOut {
    static constexpr bool PERM = false, AFTER_DRAIN = false;
    const float* x; float* out;
    DI void operator()(const f32x4 (&acc)[2][2][4][2], const pg8::Unit& u, int wr, int wc, int fr, int fq) const {
        const int row0 = u.pm * 256 + wr * 64 + fr, col0 = u.pn * 256 + wc * 32 + 4 * fq;
#pragma unroll
        for (int ai = 0; ai < 2; ++ai)
#pragma unroll
            for (int m = 0; m < 4; ++m) { const size_t off = (size_t)(row0 + ai * 128 + m * 16) * DM + col0;
#pragma unroll
                for (int bj = 0; bj < 2; ++bj)
#pragma unroll
                    for (int n = 0; n < 2; ++n) { const f32x4 xs = *(const f32x4*)(x + off + bj * 128 + n * 16); *(f32x4*)(out + off + bj * 128 + n * 16) = xs + acc[ai][bj][m][n]; } }
    }
};

constexpr int NA_SLOT = 16384, NA_NSLOT = 9, NA_KM = NA_NSLOT * NA_SLOT, NA_VM = NA_KM + 2048, NA_RPB = NA_VM + 2048, NA_MB = NA_RPB + 1920;
#define NA_BAR() do { asm volatile("s_waitcnt lgkmcnt(0)" ::: "memory"); __builtin_amdgcn_s_barrier(); asm volatile("" ::: "memory"); } while (0)
DI void na_stage_row(const bf16_t* kslab, const bf16_t* vslab, unsigned char* slot, int lw, int lane) {
#pragma unroll
    for (int i = 0; i < 2; ++i) { const int piece = 2 * lw + i, P = 64 * piece + lane, line = P >> 4, pos = P & 15;
        { const int b0 = ((pos >> 3) & 1) ^ (line & 1), uu = (pos & 7) ^ (4 * b0 + ((line >> 2) & 3)), key = 2 * line + b0;
          __builtin_amdgcn_global_load_lds((const unsigned*)(kslab + key * 64 + uu * 8), (PG8_LAS unsigned*)(slot + piece * 1024), 16, 0, 0); }
        { const int x = pos ^ (line & 7), d = 2 * line + (x >> 3), uk = x & 7;
          __builtin_amdgcn_global_load_lds((const unsigned*)(vslab + d * 64 + uk * 8), (PG8_LAS unsigned*)(slot + 8192 + piece * 1024), 16, 0, 0); } }
}
DI int na_rs(int r) { int rs = r - 4; return rs < 0 ? 0 : (rs > 120 ? 120 : rs); }
DI void na_phase(const Args& a, unsigned char* lds, int vcu, int G, int wave, int lane) {
    unsigned char* ws = a.ws;
    const float* ZM = (const float*)(ws + WS_ZM);
    bf16_t* AO = (bf16_t*)(ws + WS_AO); const bf16_t* NKP = (const bf16_t*)(ws + WS_NK); const bf16_t* NVP = (const bf16_t*)(ws + WS_NVT);
    const bf16_t* NGt = (const bf16_t*)a.out + (size_t)NTOK * 1024;
    bf16_t* KM = (bf16_t*)(lds + NA_KM); bf16_t* VM = (bf16_t*)(lds + NA_VM); float* RPB = (float*)(lds + NA_RPB); float* MB = (float*)(lds + NA_MB);
    const int tid = wave * 64 + lane;
    for (int task = vcu; task < 256; task += G) {
        const int b = task >> 7, h = (task >> 3) & 15, r0 = (task & 7) * 16;
        const bf16_t* kbase = NKP + (size_t)((b * 16 + h) * 128) * 4096; const bf16_t* vbase = NVP + (size_t)((b * 16 + h) * 128) * 4096;
        for (int m = wave; m < 16; m += NWAVES) { const int d = lane;
            const float v = ZM[(size_t)m * NIN + 256 * (12 + (h >> 2)) + 128 * (d >> 5) + 32 * (h & 3) + (d & 31)];
            const float rstd = 1.0f / sqrtf(wave_sum(v * v) * (1.f / 64.f) + RMS_EPS);
            KM[m * 64 + d] = (bf16_t)(pk2(v * rstd * a.kn_g[d], 0.f) & 0xffffu); }
        for (int e = tid; e < 1024; e += 512) { const int m = e & 15, d = e >> 4;
            VM[e] = (bf16_t)(pk2(ZM[(size_t)m * NIN + 256 * (24 + (h >> 2)) + 64 * (h & 3) + d], 0.f) & 0xffffu); }
        if (tid < 465) RPB[tid] = a.rpb[h * 465 + tid] * LOG2E;
        if (tid < 16) MB[tid] = a.meta_bias[h * 16 + tid] * LOG2E;
        const int lo = na_rs(r0);
        if (wave >= 4) {
            const int lw = wave - 4;
            for (int x = lo; x < lo + 8; ++x) na_stage_row(kbase + (size_t)x * 4096, vbase + (size_t)x * 4096, lds + (x % NA_NSLOT) * NA_SLOT, lw, lane);
            asm volatile("s_waitcnt vmcnt(0)" ::: "memory");
            NA_BAR();
            for (int r = r0; r < r0 + 16; ++r) {
                if (r + 1 < r0 + 16 && na_rs(r + 1) > na_rs(r)) { const int x = na_rs(r + 1) + 7;
                    na_stage_row(kbase + (size_t)x * 4096, vbase + (size_t)x * 4096, lds + (x % NA_NSLOT) * NA_SLOT, lw, lane); }
                asm volatile("s_waitcnt vmcnt(0)" ::: "memory");
                NA_BAR();
            }
            continue;
        }
        const int n = lane & 15, q4 = lane >> 4, qt = wave;
        const int c0 = (qt == 0) ? 0 : (qt == 1) ? 8 : (qt == 2) ? 24 : 32;
        const int qc = 16 * qt + n;
        int cs = qc - 8; cs = cs < 0 ? 0 : (cs > 48 ? 48 : cs);
        bf16x8 qf[2], qn[2];
        { const size_t qtok = (size_t)b * SEQ + r0 * 64 + qc;
#pragma unroll
          for (int ks = 0; ks < 2; ++ks) qf[ks] = *(const bf16x8*)(AO + qtok * 2048 + 1024 + h * 64 + 32 * ks + 8 * q4); }
        int koff[2][2];
#pragma unroll
        for (int t = 0; t < 2; ++t) { const int key = c0 + 8 * (n >> 2) + 4 * t + (n & 3); const int f = ((key & 3) << 2) | ((key >> 3) & 3);
#pragma unroll
            for (int ks = 0; ks < 2; ++ks) koff[t][ks] = ((key >> 1) * 16 + ((((key & 1) * 8) + 4 * ks + q4) ^ f)) * 16; }
        int voff[4];
#pragma unroll
        for (int dt = 0; dt < 4; ++dt) { const int d = 16 * dt + n, uk = (c0 >> 3) + q4; voff[dt] = 8192 + ((d >> 1) * 16 + ((((d & 1) * 8) + uk) ^ ((d >> 1) & 7))) * 16; }
        NA_BAR();
        for (int r = r0; r < r0 + 16; ++r) {
            const int rs = na_rs(r);
            const size_t qtok = (size_t)b * SEQ + r * 64 + qc;
            if (r + 1 < r0 + 16) {
#pragma unroll
                for (int ks = 0; ks < 2; ++ks) qn[ks] = *(const bf16x8*)(AO + (qtok + 64) * 2048 + 1024 + h * 64 + 32 * ks + 8 * q4);
            }
            u32x2 gw[4];
#pragma unroll
            for (int dt = 0; dt < 4; ++dt) gw[dt] = *(const u32x2*)(NGt + qtok * 1024 + h * 64 + 16 * dt + 4 * q4);
            f32x4 sc[17];
#pragma unroll
            for (int kr = 0; kr < 8; ++kr) {
                const unsigned char* slot = lds + ((rs + kr) % NA_NSLOT) * NA_SLOT;
#pragma unroll
                for (int t = 0; t < 2; ++t) {
                    const bf16x8 k0 = *(const bf16x8*)(slot + koff[t][0]);
                    const bf16x8 k1 = *(const bf16x8*)(slot + koff[t][1]);
                    f32x4 z = {0.f, 0.f, 0.f, 0.f};
                    z = MFMA16(k0, qf[0], z); z = MFMA16(k1, qf[1], z);
                    sc[2 * kr + t] = z;
                }
            }
            {
                const bf16x8 k0 = *(const bf16x8*)(KM + n * 64 + 8 * q4);
                const bf16x8 k1 = *(const bf16x8*)(KM + n * 64 + 32 + 8 * q4);
                f32x4 z = {0.f, 0.f, 0.f, 0.f};
                z = MFMA16(k0, qf[0], z); z = MFMA16(k1, qf[1], z);
                sc[16] = z;
            }
            float mx = -1e30f;
#pragma unroll
            for (int kr = 0; kr < 8; ++kr) {
                const int drow = rs + kr - r + 7;
#pragma unroll
                for (int t = 0; t < 2; ++t)
#pragma unroll
                    for (int i = 0; i < 4; ++i) {
                        const int kc = c0 + 8 * q4 + 4 * t + i;
                        const bool valid = (kc >= cs) && (kc < cs + 16);
                        int dcol = kc - qc + 15; dcol = dcol < 0 ? 0 : (dcol > 30 ? 30 : dcol);
                        const float bias = RPB[drow * 31 + dcol];
                        const float sv = valid ? (sc[2 * kr + t][i] + bias) : -1e30f;
                        sc[2 * kr + t][i] = sv; mx = fmaxf(mx, sv);
                    }
            }
#pragma unroll
            for (int i = 0; i < 4; ++i) { const float sv = sc[16][i] + MB[4 * q4 + i]; sc[16][i] = sv; mx = fmaxf(mx, sv); }
            mx = fmaxf(mx, __shfl_xor(mx, 16)); mx = fmaxf(mx, __shfl_xor(mx, 32));
            float sum = 0.f;
#pragma unroll
            for (int j = 0; j < 17; ++j)
#pragma unroll
                for (int i = 0; i < 4; ++i) { const float pp = __builtin_amdgcn_exp2f(sc[j][i] - mx); sc[j][i] = pp; sum += pp; }
            sum += __shfl_xor(sum, 16); sum += __shfl_xor(sum, 32);
            const float inv = 1.0f / sum;
            f32x4 o[4];
#pragma unroll
            for (int dt = 0; dt < 4; ++dt) o[dt] = (f32x4){0.f, 0.f, 0.f, 0.f};
#pragma unroll
            for (int kr = 0; kr < 8; ++kr) {
                const unsigned char* slot = lds + ((rs + kr) % NA_NSLOT) * NA_SLOT;
                u32x4 pw; pw.x = pk2(sc[2 * kr][0], sc[2 * kr][1]); pw.y = pk2(sc[2 * kr][2], sc[2 * kr][3]); pw.z = pk2(sc[2 * kr + 1][0], sc[2 * kr + 1][1]); pw.w = pk2(sc[2 * kr + 1][2], sc[2 * kr + 1][3]);
                const bf16x8 pf = __builtin_bit_cast(bf16x8, pw);
#pragma unroll
                for (int dt = 0; dt < 4; ++dt) { const bf16x8 vf = *(const bf16x8*)(slot + voff[dt]); o[dt] = MFMA16(vf, pf, o[dt]); }
            }
            {
                u32x4 pw; pw.x = pk2(sc[16][0], sc[16][1]); pw.y = pk2(sc[16][2], sc[16][3]); pw.z = 0u; pw.w = 0u;
                const bf16x8 pf = __builtin_bit_cast(bf16x8, pw);
#pragma unroll
                for (int dt = 0; dt < 4; ++dt) {
                    const u32x2 lo2 = *(const u32x2*)(VM + ((16 * dt + n) * 16 + 4 * q4));
                    u32x4 vw; vw.x = lo2.x; vw.y = lo2.y; vw.z = 0u; vw.w = 0u;
                    o[dt] = MFMA16(__builtin_bit_cast(bf16x8, vw), pf, o[dt]);
                }
            }
#pragma unroll
            for (int dt = 0; dt < 4; ++dt) {
                const int d0 = h * 64 + 16 * dt + 4 * q4;
                const float g0 = __uint_as_float(gw[dt].x << 16), g1 = __uint_as_float(gw[dt].x & 0xffff0000u), g2 = __uint_as_float(gw[dt].y << 16), g3 = __uint_as_float(gw[dt].y & 0xffff0000u);
                u32x2 w; w.x = pk2(o[dt][0] * inv * g0, o[dt][1] * inv * g1); w.y = pk2(o[dt][2] * inv * g2, o[dt][3] * inv * g3);
                *(u32x2*)(AO + qtok * 2048 + 1024 + d0) = w;
            }
            qf[0] = qn[0]; qf[1] = qn[1];
            NA_BAR();
        }
    }
}

constexpr int PREP_LD = 136;
constexpr int PREP_TILE = 64 * PREP_LD * 2;
constexpr int PREP_R = 4 * PREP_TILE, PREP_PART = PREP_R + 8192;
DI float logsig16(float x) { return (fminf(x, 0.f) - __logf(1.f + __expf(-fabsf(x)))) * (1.f / 16.f); }
DI int phys_gk(int c) { return phys_norm(2 + (c >> 8), c & 255); }
DI void prep_phase(const Args& a, unsigned char* lds, int vcu, int G, int wave, int lane) {
    unsigned char* ws = a.ws;
    const float* ZM = (const float*)(ws + WS_ZM); const float* R = (const float*)(ws + WS_R);
    const bf16_t* QG = (const bf16_t*)(ws + WS_QG); const bf16_t* KG = (const bf16_t*)(ws + WS_KG);
    unsigned char* PKF = ws + WS_PKF; unsigned char* PKB = ws + WS_PKB; bf16_t* VMT = (bf16_t*)(ws + WS_VMT);
    const int tid = wave * 64 + lane;
    bf16_t* T_QF = (bf16_t*)(lds); bf16_t* T_KF = (bf16_t*)(lds + PREP_TILE); bf16_t* T_QB = (bf16_t*)(lds + 2 * PREP_TILE); bf16_t* T_KB = (bf16_t*)(lds + 3 * PREP_TILE);
    float* RS = (float*)(lds + PREP_R); float* PART = (float*)(lds + PREP_PART);
    for (int task = vcu; task < 1024 + 8; task += G) {
        if (task >= 1024) {
            const int mt = task - 1024, b = mt >> 2, h = mt & 3;
            unsigned char* pk = PKF + (size_t)((b * 4 + h) * 129) * PK_BYTES;
            for (int p = tid; p < PK_BYTES / 16; p += 512) *(u32x4*)(pk + p * 16) = (u32x4){0u, 0u, 0u, 0u};
            __syncthreads();
            if (tid < 128) { const int d = tid;
                float wd[16];
#pragma unroll
                for (int k = 0; k < 16; ++k) wd[k] = a.wd_f[k * 512 + h * 128 + d];
                const float bd = a.bd_f[h * 128 + d];
                float G_[16]; float run = 0.f;
#pragma unroll
                for (int m = 0; m < 16; ++m) { float dot = bd;
#pragma unroll
                    for (int k = 0; k < 16; ++k) dot += ZM[(size_t)m * NIN + 7168 + k] * wd[k];
                    run += logsig16(dot); G_[m] = run; }
                unsigned kw[8];
#pragma unroll
                for (int m = 0; m < 16; m += 2) { const float k0 = ZM[(size_t)m * NIN + phys_gk(h * 128 + d)] * __expf(run - G_[m]);
                    const float k1 = ZM[(size_t)(m + 1) * NIN + phys_gk(h * 128 + d)] * __expf(run - G_[m + 1]); kw[m >> 1] = pk2(k0, k1); }
                const int dt = d >> 5, r = d & 31;
                *(u32x4*)(pk + (dt * 4 + 3) * 1024 + (0 * 32 + r) * 16) = (u32x4){kw[0], kw[1], kw[2], kw[3]};
                *(u32x4*)(pk + (dt * 4 + 3) * 1024 + (1 * 32 + r) * 16) = (u32x4){kw[4], kw[5], kw[6], kw[7]};
                *(float*)(pk + PK_A_OFF + d * 4) = 1.0f;
            }
            if (b == 0 && tid < 256) { const int v = tid; const int c = h * 256 + v; bf16_t* row = VMT + (size_t)c * 64;
                for (int j = 0; j < 48; j += 8) *(u32x4*)(row + j) = (u32x4){0u, 0u, 0u, 0u};
                unsigned vw[8];
#pragma unroll
                for (int m = 0; m < 16; m += 2) vw[m >> 1] = pk2(ZM[(size_t)m * NIN + 256 * (20 + (c >> 8)) + (c & 255)], ZM[(size_t)(m + 1) * NIN + 256 * (20 + (c >> 8)) + (c & 255)]);
                *(u32x4*)(row + 48) = (u32x4){vw[0], vw[1], vw[2], vw[3]}; *(u32x4*)(row + 56) = (u32x4){vw[4], vw[5], vw[6], vw[7]}; }
            __syncthreads();
            continue;
        }
        const int b = task >> 9, h = (task >> 7) & 3, c = task & 127;
        const size_t tok0 = (size_t)b * SEQ + c * 64;
        unsigned char* pkf = PKF + (size_t)((b * 4 + h) * 129 + 1 + c) * PK_BYTES;
        unsigned char* pkb = PKB + (size_t)((b * 4 + h) * 128 + c) * PK_BYTES;
        { const f32x4* src = (const f32x4*)(R + tok0 * 32); ((f32x4*)RS)[tid] = src[tid]; }
        const int d = tid & 127, tq = tid >> 7;
        bf16_t qv[16], kv[16];
#pragma unroll
        for (int jj = 0; jj < 16; ++jj) { qv[jj] = QG[(tok0 + 16 * tq + jj) * 512 + h * 128 + d]; kv[jj] = KG[(tok0 + 16 * tq + jj) * 512 + h * 128 + d]; }
        float wf[16], wb[16];
#pragma unroll
        for (int k = 0; k < 16; ++k) { wf[k] = a.wd_f[k * 512 + h * 128 + d]; wb[k] = a.wd_b[k * 512 + h * 128 + d]; }
        const float bf_ = a.bd_f[h * 128 + d], bb_ = a.bd_b[h * 128 + d];
        __syncthreads();
        float pf[16], pb[16];
        { float rf = 0.f, rb = 0.f;
#pragma unroll
          for (int jj = 0; jj < 16; ++jj) { const float* rr = RS + (16 * tq + jj) * 32; float df = bf_, db = bb_;
#pragma unroll
              for (int k4 = 0; k4 < 4; ++k4) { const f32x4 x0 = *(const f32x4*)(rr + 4 * k4), x1 = *(const f32x4*)(rr + 16 + 4 * k4);
                  df += x0[0] * wf[4 * k4] + x0[1] * wf[4 * k4 + 1] + x0[2] * wf[4 * k4 + 2] + x0[3] * wf[4 * k4 + 3];
                  db += x1[0] * wb[4 * k4] + x1[1] * wb[4 * k4 + 1] + x1[2] * wb[4 * k4 + 2] + x1[3] * wb[4 * k4 + 3]; }
              rf += logsig16(df); rb += logsig16(db); pf[jj] = rf; pb[jj] = rb; }
          PART[(0 * 4 + tq) * 128 + d] = rf; PART[(1 * 4 + tq) * 128 + d] = rb; }
        __syncthreads();
        float offf = 0.f, totf = 0.f, offb = 0.f, totb = 0.f;
#pragma unroll
        for (int q = 0; q < 4; ++q) { const float tf = PART[(0 * 4 + q) * 128 + d], tb = PART[(1 * 4 + q) * 128 + d]; totf += tf; totb += tb; if (q < tq) offf += tf; if (q > tq) offb += tb; }
        const float mytb = pb[15];
        unsigned ksf[8], ksb[8];
#pragma unroll
        for (int jj = 0; jj < 16; jj += 2) {
            float kstf[2], kstb[2];
#pragma unroll
            for (int e = 0; e < 2; ++e) { const int j = 16 * tq + jj + e;
                const float q = bf2f(qv[jj + e]), k = bf2f(kv[jj + e]);
                const float Gf = offf + pf[jj + e];
                const float Gb = offb + (mytb - ((jj + e) ? pb[jj + e - 1] : 0.f));
                const float ef = __expf(Gf), eb = __expf(Gb);
                T_QF[j * PREP_LD + d] = (bf16_t)(pk2(q * ef, 0.f) & 0xffffu);
                T_KF[j * PREP_LD + d] = (bf16_t)(pk2(k * __expf(-Gf), 0.f) & 0xffffu);
                T_QB[j * PREP_LD + d] = (bf16_t)(pk2(q * eb, 0.f) & 0xffffu);
                T_KB[j * PREP_LD + d] = (bf16_t)(pk2(k * __expf(-Gb), 0.f) & 0xffffu);
                kstf[e] = k * __expf(totf - Gf); kstb[e] = k * __expf(totb - Gb); }
            ksf[jj >> 1] = pk2(kstf[0], kstf[1]); ksb[jj >> 1] = pk2(kstb[0], kstb[1]);
        }
        { const int dt = d >> 5, r = d & 31;
          *(u32x4*)(pkf + (dt * 4 + tq) * 1024 + (0 * 32 + r) * 16) = (u32x4){ksf[0], ksf[1], ksf[2], ksf[3]};
          *(u32x4*)(pkf + (dt * 4 + tq) * 1024 + (1 * 32 + r) * 16) = (u32x4){ksf[4], ksf[5], ksf[6], ksf[7]};
          *(u32x4*)(pkb + (dt * 4 + tq) * 1024 + (0 * 32 + r) * 16) = (u32x4){ksb[0], ksb[1], ksb[2], ksb[3]};
          *(u32x4*)(pkb + (dt * 4 + tq) * 1024 + (1 * 32 + r) * 16) = (u32x4){ksb[4], ksb[5], ksb[6], ksb[7]};
          if (tq == 0) { *(float*)(pkf + PK_A_OFF + d * 4) = __expf(totf); *(float*)(pkb + PK_A_OFF + d * 4) = __expf(totb); } }
        __syncthreads();
        {
            const int dir = wave >> 2, jt = (wave >> 1) & 1, it = wave & 1;
            const bf16_t* TQ = dir ? T_QB : T_QF; const bf16_t* TK = dir ? T_KB : T_KF; unsigned char* pk = dir ? pkb : pkf;
            const int rho = lane & 31, hh = lane >> 5;
            const int pj = (rho & ~12) | ((rho & 4) << 1) | ((rho & 8) >> 1);
            const int jrow = 32 * jt + pj, icol = 32 * it + rho;
            f32x16 acc;
#pragma unroll
            for (int i = 0; i < 16; ++i) acc[i] = 0.f;
#pragma unroll
            for (int kd = 0; kd < 8; ++kd) { const bf16x8 af = *(const bf16x8*)(TK + jrow * PREP_LD + 16 * kd + 8 * hh); const bf16x8 bfr = *(const bf16x8*)(TQ + icol * PREP_LD + 16 * kd + 8 * hh);
                acc = MFMA32(af, bfr, acc); }
#pragma unroll
            for (int s = 0; s < 2; ++s) {
                unsigned w[4];
#pragma unroll
                for (int e = 0; e < 8; e += 2) {
                    float v[2];
#pragma unroll
                    for (int x = 0; x < 2; ++x) { const int j = 32 * jt + 16 * s + 8 * hh + e + x; const bool keep = dir ? (j >= icol) : (j <= icol); v[x] = keep ? acc[8 * s + e + x] : 0.f; }
                    w[e >> 1] = pk2(v[0], v[1]);
                }
                *(u32x4*)(pk + (32 + it * 4 + 2 * jt + s) * 1024 + lane * 16) = (u32x4){w[0], w[1], w[2], w[3]};
            }
#pragma unroll
            for (int ff = 0; ff < 4; ++ff) { const int f = (wave & 3) * 4 + ff, it2 = f >> 3, kd = f & 7;
                const bf16_t* rowp = TQ + (32 * it2 + rho) * PREP_LD + 16 * kd + 4 * hh;
                const u32x2 lo = *(const u32x2*)(rowp), hi = *(const u32x2*)(rowp + 8);
                *(u32x4*)(pk + (16 + f) * 1024 + lane * 16) = (u32x4){lo.x, lo.y, hi.x, hi.y}; }
        }
        __syncthreads();
    }
}

constexpr int SCAN_BUF = 46080;
constexpr int SCAN_VT = 41984;
constexpr int SCAN_OST = 3 * SCAN_BUF;
DI bf16x8 pack8(const f32x16& x, int s) {
    u32x4 p; p.x = pk2(x[8 * s], x[8 * s + 1]); p.y = pk2(x[8 * s + 2], x[8 * s + 3]); p.z = pk2(x[8 * s + 4], x[8 * s + 5]); p.w = pk2(x[8 * s + 6], x[8 * s + 7]);
    return __builtin_bit_cast(bf16x8, p);
}
DI void scan_stage(const unsigned char* src, const bf16_t* vsrc, int vstride  , unsigned char* dst, int lw, int lane) {
#pragma unroll
    for (int i = 0; i < 12; ++i) { const int q = i * 4 + lw;
        if (q < 41) __builtin_amdgcn_global_load_lds((const unsigned*)(src + (size_t)q * 1024 + lane * 16), (PG8_LAS unsigned*)(dst + q * 1024), 16, 0, 0);
        else if (q < 45) __builtin_amdgcn_global_load_lds((const unsigned*)(vsrc + (size_t)(q - 41) * vstride), (PG8_LAS unsigned*)(dst + SCAN_VT + (q - 41) * 1024), 16, 0, 0); }
}
#define SCAN_BAR() do { asm volatile("s_waitcnt lgkmcnt(0)" ::: "memory"); __builtin_amdgcn_s_barrier(); asm volatile("" ::: "memory"); } while (0)
#define SCAN_LDF(f) (*(const bf16x8*)(buf + (f) * 1024 + lane * 16))
DI void scan_phase(const Args& a, unsigned char* lds, int wave, int lane) {
    const int sb = blockIdx.x; if (sb >= 128) return;
    unsigned char* ws = a.ws;
    const int stream = sb & 15, eighth = sb >> 4;
    const int b = stream >> 3, dir = (stream >> 2) & 1, h = stream & 3;
    const int nsteps = dir ? 128 : 129;
    const unsigned char* pkbase = dir ? (ws + WS_PKB + (size_t)((b * 4 + h) * 128) * PK_BYTES) : (ws + WS_PKF + (size_t)((b * 4 + h) * 129) * PK_BYTES);
    const bf16_t* VP = (const bf16_t*)(ws + WS_VGT); const bf16_t* VMT = (const bf16_t*)(ws + WS_VMT);
    const int vcol0 = h * 256 + eighth * 32;
#define SCAN_PKIDX(s_) (dir ? (127 - (s_)) : (s_))
#define SCAN_STAGE(s_) do { const int ss_ = (s_); \
        if (dir == 0 && ss_ == 0) scan_stage(pkbase, VMT + (size_t)(vcol0 + (lane & 31)) * 64 + 8 * (lane >> 5), 16, lds + (size_t)(ss_ % 3) * SCAN_BUF, lw, lane); \
        else { const int cc_ = dir ? (127 - ss_) : (ss_ - 1); \
            scan_stage(pkbase + (size_t)SCAN_PKIDX(ss_) * PK_BYTES, VP + ((size_t)((b * 4 + h) * 128 + cc_) * 8 + eighth) * 2048 + lane * 8, 512, lds + (size_t)(ss_ % 3) * SCAN_BUF, lw, lane); } } while (0)
    if (wave >= 4) {
        const int lw = wave - 4;
        SCAN_STAGE(0); SCAN_STAGE(1);
        if (lw == 0) asm volatile("s_waitcnt vmcnt(12)" ::: "memory"); else asm volatile("s_waitcnt vmcnt(11)" ::: "memory");
        SCAN_BAR();
        for (int n = 0; n < nsteps; ++n) {
            if (n + 2 < nsteps) { SCAN_STAGE(n + 2);
                if (lw == 0) asm volatile("s_waitcnt vmcnt(12)" ::: "memory"); else asm volatile("s_waitcnt vmcnt(11)" ::: "memory");
            } else asm volatile("s_waitcnt vmcnt(0)" ::: "memory");
            SCAN_BAR();
        }
        return;
    }
    if (wave >= 2) { SCAN_BAR(); for (int n = 0; n < nsteps; ++n) SCAN_BAR(); return; }
    bf16_t* OUT = dir ? (bf16_t*)(ws + WS_OB) : (bf16_t*)(ws + WS_AO); const int ldo = dir ? 1024 : 2048;
    const int r = lane & 31, hh = lane >> 5, ih = wave;
    bf16_t* ost = (bf16_t*)(lds + SCAN_OST + wave * 2048);
    f32x16 S[4];
#pragma unroll
    for (int dt = 0; dt < 4; ++dt)
#pragma unroll
        for (int i = 0; i < 16; ++i) S[dt][i] = 0.f;
    SCAN_BAR();
    int cprev = -1;
#ifdef SCAN_DBG
    unsigned long long tbar_ = 0; const unsigned long long tstart_ = wall_clock64();
#endif
    for (int n = 0; n < nsteps; ++n) {
        const unsigned char* buf = lds + (size_t)(n % 3) * SCAN_BUF;
        bf16x8 vt[4], qf[8], af[4], kf[8], kg[8];
#pragma unroll
        for (int kd = 0; kd < 8; ++kd) qf[kd] = SCAN_LDF(16 + ih * 8 + kd);
#pragma unroll
        for (int ks = 0; ks < 4; ++ks) { vt[ks] = *(const bf16x8*)(buf + SCAN_VT + ks * 1024 + lane * 16); af[ks] = SCAN_LDF(32 + ih * 4 + ks); }
#pragma unroll
        for (int ks = 0; ks < 2; ++ks)
#pragma unroll
            for (int dt = 0; dt < 4; ++dt) kf[dt * 2 + ks] = SCAN_LDF(dt * 4 + ks);
        if (cprev >= 0) {
            const size_t tokb = (size_t)b * SEQ + cprev * 64 + 32 * ih;
#pragma unroll
            for (int j = 0; j < 2; ++j) { const int row = 16 * j + (lane >> 2); const u32x4 v = *(const u32x4*)(ost + row * 32 + 8 * (lane & 3));
                *(u32x4*)(OUT + (tokb + row) * ldo + vcol0 + 8 * (lane & 3)) = v; }
        }
        if (!(dir == 0 && n == 0)) {
            f32x16 oa, ob;
#pragma unroll
            for (int i = 0; i < 16; ++i) { oa[i] = 0.f; ob[i] = 0.f; }
#pragma unroll
            for (int dt = 0; dt < 2; ++dt) {
                const bf16x8 a0 = pack8(S[dt], 0), a1 = pack8(S[dt], 1), b0 = pack8(S[dt + 2], 0), b1 = pack8(S[dt + 2], 1);
                oa = MFMA32(qf[2 * dt], a0, oa); ob = MFMA32(qf[4 + 2 * dt], b0, ob);
                oa = MFMA32(qf[2 * dt + 1], a1, oa); ob = MFMA32(qf[4 + 2 * dt + 1], b1, ob);
            }
            oa = MFMA32(af[0], vt[0], oa); ob = MFMA32(af[2], vt[2], ob);
            oa = MFMA32(af[1], vt[1], oa); ob = MFMA32(af[3], vt[3], ob);
#pragma unroll
            for (int dt = 0; dt < 4; ++dt) {
                f32x4 av[4];
#pragma unroll
                for (int g4 = 0; g4 < 4; ++g4) av[g4] = *(const f32x4*)(buf + PK_A_OFF + (32 * dt + 8 * g4 + 4 * hh) * 4);
#pragma unroll
                for (int g4 = 0; g4 < 4; ++g4) { S[dt][4 * g4] *= av[g4][0]; S[dt][4 * g4 + 1] *= av[g4][1]; S[dt][4 * g4 + 2] *= av[g4][2]; S[dt][4 * g4 + 3] *= av[g4][3]; }
            }
#pragma unroll
            for (int g = 0; g < 16; ++g) { ost[crow(g, hh) * 32 + r] = (bf16_t)(pk2(oa[g] + ob[g], 0.f) & 0xffffu); }
            cprev = dir ? (127 - n) : (n - 1);
        }
#pragma unroll
        for (int ks = 0; ks < 2; ++ks)
#pragma unroll
            for (int dt = 0; dt < 4; ++dt) kg[dt * 2 + ks] = SCAN_LDF(dt * 4 + 2 + ks);
#pragma unroll
        for (int ks = 0; ks < 2; ++ks)
#pragma unroll
            for (int dt = 0; dt < 4; ++dt) S[dt] = MFMA32(kf[dt * 2 + ks], vt[ks], S[dt]);
#pragma unroll
        for (int ks = 0; ks < 2; ++ks)
#pragma unroll
            for (int dt = 0; dt < 4; ++dt) S[dt] = MFMA32(kg[dt * 2 + ks], vt[2 + ks], S[dt]);
#ifdef SCAN_DBG
        { const unsigned long long t0_ = wall_clock64(); SCAN_BAR(); tbar_ += wall_clock64() - t0_; }
#else
        SCAN_BAR();
#endif
    }
#ifdef SCAN_DBG
    if (sb == 0 && wave == 0 && lane == 0) { const unsigned long long tt_ = wall_clock64() - tstart_; float* dbg = (float*)(ws + WS_ZM + 480 * 1024); dbg[0] = (float)tbar_; dbg[1] = (float)(tt_ ? tt_ : 1); }
#endif
    if (cprev >= 0) {
        const size_t tokb = (size_t)b * SEQ + cprev * 64 + 32 * ih;
#pragma unroll
        for (int j = 0; j < 2; ++j) { const int row = 16 * j + (lane >> 2); const u32x4 v = *(const u32x4*)(ost + row * 32 + 8 * (lane & 3));
            *(u32x4*)(OUT + (tokb + row) * ldo + vcol0 + 8 * (lane & 3)) = v; }
    }
}

DI void combine_phase(const Args& a, int vcu, int G, int wave, int lane) {
    unsigned char* ws = a.ws;
    bf16_t* AO = (bf16_t*)(ws + WS_AO); const bf16_t* OB = (const bf16_t*)(ws + WS_OB); const bf16_t* GG = (const bf16_t*)a.out;
    const int gw = vcu * NWAVES + wave, NGW = G * NWAVES;
    const f32x4 gn = *(const f32x4*)(a.gla_g + 4 * lane);
    for (int t = gw; t < NTOK * 4; t += NGW) {
        const size_t tok = t >> 2; const int h = t & 3;
        const u32x2 f = *(const u32x2*)(AO + tok * 2048 + h * 256 + 4 * lane);
        const u32x2 bq = *(const u32x2*)(OB + tok * 1024 + h * 256 + 4 * lane);
        const u32x2 gg = *(const u32x2*)(GG + tok * 1024 + h * 256 + 4 * lane);
        float o[4];
        o[0] = __uint_as_float(f.x << 16) + __uint_as_float(bq.x << 16); o[1] = __uint_as_float(f.x & 0xffff0000u) + __uint_as_float(bq.x & 0xffff0000u);
        o[2] = __uint_as_float(f.y << 16) + __uint_as_float(bq.y << 16); o[3] = __uint_as_float(f.y & 0xffff0000u) + __uint_as_float(bq.y & 0xffff0000u);
        const float ss = wave_sum((o[0] * o[0] + o[1] * o[1]) + (o[2] * o[2] + o[3] * o[3]));
        const float rstd = 1.0f / sqrtf(ss * (1.f / 256.f) + RMS_EPS);
        const float g0 = __uint_as_float(gg.x << 16), g1 = __uint_as_float(gg.x & 0xffff0000u), g2 = __uint_as_float(gg.y << 16), g3 = __uint_as_float(gg.y & 0xffff0000u);
        u32x2 w; w.x = pk2(o[0] * rstd * gn[0] * g0, o[1] * rstd * gn[1] * g1); w.y = pk2(o[2] * rstd * gn[2] * g2, o[3] * rstd * gn[3] * g3);
        *(u32x2*)(AO + tok * 2048 + h * 256 + 4 * lane) = w;
    }
}

#define LAS __attribute__((address_space(3)))
#define XB_TMO      128
#define XB_XCNT(j)  (256  + 64 * (j))
#define XB_XSUB(j)  (1280 + 64 * (j))
#define XB_XGEN(j)  (2304 + 64 * (j))
#define XB_TOP      3328
#define XB_TOPGEN   3392
#define XCD_BAR_WORDS 3456
#define XB_SPIN_CAP (1u << 18)

__device__ __forceinline__ unsigned xb_ld(unsigned* p)              { return __hip_atomic_load(p, __ATOMIC_RELAXED, __HIP_MEMORY_SCOPE_AGENT); }
__device__ __forceinline__ unsigned xb_add(unsigned* p, unsigned v) { return __hip_atomic_fetch_add(p, v, __ATOMIC_RELAXED, __HIP_MEMORY_SCOPE_AGENT); }
__device__ __forceinline__ unsigned xb_xcc_id() { return (unsigned)__builtin_amdgcn_s_getreg((3 << 11) | 20) & 0xFu; }
#define XB_SPIN(cond, bar) do { unsigned _sp = 0; while (cond) { __builtin_amdgcn_s_sleep(1); \
    if ((++_sp & 255u) == 0u) { if (xb_ld(&(bar)[XB_TMO])) break; if (_sp > XB_SPIN_CAP) { atomicAdd(&(bar)[XB_TMO], 1u); break; } } } } while (0)

struct XcdBarrier {
    unsigned* bar; unsigned x;
    volatile LAS unsigned* st;
};

__device__ __forceinline__ XcdBarrier xcd_barrier_post(unsigned* bar, volatile LAS unsigned* st) {
    XcdBarrier b; b.bar = bar; b.x = xb_xcc_id(); b.st = st;
    if (threadIdx.x == 0) (void)xb_add(&bar[XB_XCNT(b.x)], 1u);
    return b;
}
__device__ __forceinline__ void xcd_barrier_complete(unsigned* bar, unsigned x, unsigned& nloc, unsigned& nx) {
    const unsigned G = gridDim.x * gridDim.y * gridDim.z;
    unsigned sum, cnt, mine, sp = 0u;
    for (;;) {
        sum = 0u; cnt = 0u; mine = 0u;
#pragma unroll
        for (unsigned j = 0; j < 16; ++j) { const unsigned c = xb_ld(&bar[XB_XCNT(j)]); sum += c; cnt += (c > 0u) ? 1u : 0u; mine = (j == x) ? c : mine; }
        if (sum == G) break;
        __builtin_amdgcn_s_sleep(1);
        if ((++sp & 255u) == 0u) { if (xb_ld(&bar[XB_TMO])) break; if (sp > XB_SPIN_CAP) { atomicAdd(&bar[XB_TMO], 1u); break; } }
    }
    nloc = mine > 0u ? mine : 1u; nx = cnt > 0u ? cnt : 1u;
}

__device__ __forceinline__ void xcd_barrier(const XcdBarrier& b) {
    asm volatile("s_waitcnt vmcnt(0)" ::: "memory");
    __syncthreads();
    if (threadIdx.x == 0) {
        unsigned* bar = b.bar;
        __builtin_amdgcn_s_waitcnt(0);
        unsigned nloc = b.st[0], nx = b.st[1];
        if (nloc == 0u) { xcd_barrier_complete(bar, b.x, nloc, nx); b.st[0] = nloc; b.st[1] = nx; }
        const unsigned old = xb_add(&bar[XB_XSUB(b.x)], 1u);
        const unsigned gen = old / nloc;
        if (old + 1u == (gen + 1u) * nloc) {
            __builtin_amdgcn_fence(__ATOMIC_RELEASE, "agent");
            asm volatile("s_waitcnt vmcnt(0)" ::: "memory");
            const unsigned og = xb_add(&bar[XB_TOP], 1u);
            const unsigned tg = og / nx;
            if (og + 1u == (tg + 1u) * nx) xb_add(&bar[XB_TOPGEN], 1u);
            else XB_SPIN(xb_ld(&bar[XB_TOPGEN]) == tg, bar);
            __builtin_amdgcn_fence(__ATOMIC_ACQUIRE, "agent");
            xb_add(&bar[XB_XGEN(b.x)], 1u);
            asm volatile("s_waitcnt vmcnt(0)" ::: "memory");
        } else {
            XB_SPIN(xb_ld(&bar[XB_XGEN(b.x)]) == gen, bar);
            __builtin_amdgcn_fence(__ATOMIC_ACQUIRE, "agent");
            asm volatile("s_waitcnt vmcnt(0)" ::: "memory");
        }
    }
    __syncthreads();
}

__global__ void __launch_bounds__(NWAVES * 64, 2) hybrid_fwd(Args args, int ph_lo, int ph_hi) {
    extern __shared__ __attribute__((aligned(16))) unsigned char lds[];
    cg::grid_group grid = cg::this_grid();
    const int tid = threadIdx.x, lane = tid & 63, wave = __builtin_amdgcn_readfirstlane(tid >> 6);
    const int G = gridDim.x, bx = blockIdx.x;
    const int vcu = (G % 8 == 0) ? (bx % 8) * (G / 8) + bx / 8 : bx;
    unsigned char* ws = args.ws;
#ifndef REP_PHASE
#define REP_PHASE -1
#endif
#ifndef PHMASK
#define PHMASK 0x7f
#endif
#define IN(k) (ph_lo <= (k) && (k) < ph_hi && ((PHMASK >> (k)) & 1))
    volatile LAS unsigned* bst = (volatile LAS unsigned*)(lds + LDS_BYTES - 64);
    if (tid < 2) bst[tid] = 0u;
    __syncthreads();
    XcdBarrier bar = xcd_barrier_post((unsigned*)(ws + WS_CTL), bst);
    if (ph_lo < 0) grid.sync();
#define SEAM(k) do { if (IN(k) && IN((k) + 1)) xcd_barrier(bar); } while (0)
    if (IN(0)) { p0_phase(args, lds, vcu, G, wave, lane); if (REP_PHASE == 0 || REP_PHASE == 60) { xcd_barrier(bar); p0_phase(args, lds, vcu, G, wave, lane); } }
    SEAM(0);
    if (IN(1)) {
        p1_skinny(args, vcu, G, wave, lane);
        const bf16_t* XW = (const bf16_t*)(ws + WS_XW);
        pg8::Gemm g{XW, XW, NTOK, 7168, DM};
        OrderIn S{G, bx};
        EpiIn E{(bf16_t*)(ws + WS_QG), (bf16_t*)(ws + WS_KG), (bf16_t*)args.out, (bf16_t*)args.out + (size_t)NTOK * 1024, (bf16_t*)(ws + WS_AO), (bf16_t*)(ws + WS_NK),
                (bf16_t*)(ws + WS_VGT), (bf16_t*)(ws + WS_NVT), args.qn_g, args.kn_g};
        pg8::gemm_phase<EpiIn, OrderIn, true, true>((PG8_LAS unsigned char*)lds, g, S, E);
        }
#if REP_PHASE == 1
    if (IN(1)) { xcd_barrier(bar);
        p1_skinny(args, vcu, G, wave, lane);
        const bf16_t* XW = (const bf16_t*)(ws + WS_XW);
        pg8::Gemm g{XW, XW, NTOK, 7168, DM};
        OrderIn S{G, bx};
        EpiIn E{(bf16_t*)(ws + WS_QG), (bf16_t*)(ws + WS_KG), (bf16_t*)args.out, (bf16_t*)args.out + (size_t)NTOK * 1024, (bf16_t*)(ws + WS_AO), (bf16_t*)(ws + WS_NK),
                (bf16_t*)(ws + WS_VGT), (bf16_t*)(ws + WS_NVT), args.qn_g, args.kn_g};
        pg8::gemm_phase<EpiIn, OrderIn, true, true>((PG8_LAS unsigned char*)lds, g, S, E);
        }
#endif
    SEAM(1);
    if (IN(2)) { na_phase(args, lds, vcu, G, wave, lane); }
    SEAM(2);
    if (IN(3)) { prep_phase(args, lds, vcu, G, wave, lane); if (REP_PHASE == 3) { xcd_barrier(bar); prep_phase(args, lds, vcu, G, wave, lane); } }
    SEAM(3);
    if (IN(4)) { scan_phase(args, lds, wave, lane); if (REP_PHASE == 4) { xcd_barrier(bar); scan_phase(args, lds, wave, lane); } }
    SEAM(4);
#ifdef REP_SYNC
    for (int i_ = 0; i_ < REP_SYNC; ++i_) xcd_barrier(bar);
#endif
    if (IN(5)) { combine_phase(args, vcu, G, wave, lane); }
    SEAM(5);
    if (IN(6)) {
        pg8::Gemm g{(const bf16_t*)(ws + WS_AO), (const bf16_t*)(ws + WS_WO), NTOK, DM, 2048};
        pg8::StaticOrder S; S.init(NTOK, DM, G, bx);
        EpiOut E{args.x, args.out};
        pg8::gemm_phase<EpiOut, pg8::StaticOrder, false, true>((PG8_LAS unsigned char*)lds, g, S, E);
        }
#if REP_PHASE == 6 || REP_PHASE == 60
    if (IN(6)) { xcd_barrier(bar);
        pg8::Gemm g{(const bf16_t*)(ws + WS_AO), (const bf16_t*)(ws + WS_WO), NTOK, DM, 2048};
        pg8::StaticOrder S; S.init(NTOK, DM, G, bx);
        EpiOut E{args.x, args.out};
        pg8::gemm_phase<EpiOut, pg8::StaticOrder, false, true>((PG8_LAS unsigned char*)lds, g, S, E);
        }
#endif
#ifdef SCAN_DBG
    if (bx == 0 && tid == 0) { const float* dbg = (const float*)(ws + WS_ZM + 480 * 1024); const float ratio = dbg[0] / dbg[1];
        args.out[0] = (DBG_WHAT == 0) ? (ratio < 0.33f ? 100.f : (ratio < 0.66f ? 200.f : 300.f)) : (dbg[1] < 10000.f ? 100.f : (dbg[1] < 15000.f ? 200.f : (dbg[1] < 20000.f ? 300.f : 400.f))); }
#endif
#undef IN
#undef SEAM
}

#ifndef N_LAUNCHES
#define N_LAUNCHES 1
#endif
extern "C" void kernel_launch(void* const* d_in, const int* in_sizes, int n_in, void* d_out, int out_size, void* d_ws, size_t ws_size, hipStream_t stream) {
    static int grid = 0;
    if (grid == 0) {
        if (n_in != 14 || out_size != NTOK * DM || ws_size < WS_END) { fprintf(stderr, "kernel_launch: unexpected problem (n_in %d out %d ws %zu)\n", n_in, out_size, ws_size); grid = -1; return; }
        int dev = 0, cus = 0, per_cu = 0;
        hipGetDevice(&dev); hipDeviceGetAttribute(&cus, hipDeviceAttributeMultiprocessorCount, dev);
        if (hipFuncSetAttribute((const void*)hybrid_fwd, hipFuncAttributeMaxDynamicSharedMemorySize, LDS_BYTES) != hipSuccess) { fprintf(stderr, "kernel_launch: hipFuncSetAttribute failed\n"); grid = -1; return; }
        if (hipOccupancyMaxActiveBlocksPerMultiprocessor(&per_cu, (const void*)hybrid_fwd, NWAVES * 64, LDS_BYTES) != hipSuccess || per_cu < 1) { fprintf(stderr, "kernel_launch: occupancy query gave %d\n", per_cu); per_cu = 1; }
        (void)hipGetLastError();
        grid = cus * per_cu;
        if (grid > 256) grid = 256;
    }
    if (grid < 0) return;
    Args a{};
    a.x = (const float*)d_in[0]; a.meta = (const float*)d_in[1]; a.norm_g = (const float*)d_in[2]; a.w_in = (const float*)d_in[3];
    a.wd_f = (const float*)d_in[4]; a.bd_f = (const float*)d_in[5]; a.wd_b = (const float*)d_in[6]; a.bd_b = (const float*)d_in[7];
    a.gla_g = (const float*)d_in[8]; a.qn_g = (const float*)d_in[9]; a.kn_g = (const float*)d_in[10]; a.rpb = (const float*)d_in[11];
    a.meta_bias = (const float*)d_in[12]; a.w_out = (const float*)d_in[13];
    a.out = (float*)d_out; a.ws = (unsigned char*)d_ws;
    if (hipMemsetAsync((char*)d_ws + WS_CTL, 0, 16384, stream) != hipSuccess) { fprintf(stderr, "kernel_launch: memset of the barrier words failed\n"); return; }
#if N_LAUNCHES == 1
    int lo = 0, hi = 7;
    void* kargs[] = {&a, &lo, &hi};
    hipError_t e = hipLaunchCooperativeKernel((const void*)hybrid_fwd, dim3(grid), dim3(NWAVES * 64), kargs, LDS_BYTES, stream);
    if (e != hipSuccess) fprintf(stderr, "kernel_launch: cooperative launch failed: %s (grid %d)\n", hipGetErrorString(e), grid);
#else
    for (int p = 0; p < 7; ++p) hipLaunchKernelGGL(hybrid_fwd, dim3(grid), dim3(NWAVES * 64), LDS_BYTES, stream, a, p, p + 1);
#endif
}
```

```cpp
#include <hip/hip_runtime.h>
#include <hip/hip_cooperative_groups.h>
#include <cstdio>
#include <cstdint>
namespace cg = cooperative_groups;
namespace pg8 {
#define PG8_LAS __attribute__((address_space(3)))
typedef unsigned short bf16_t;
typedef short bf16x8 __attribute__((ext_vector_type(8)));
typedef float f32x4 __attribute__((ext_vector_type(4)));
typedef unsigned u32x4 __attribute__((ext_vector_type(4)));
constexpr int BM = 256, BK = 64, HALF = 128, HTB = HALF * BK * 2  , STAGE_BYTES = 8 * HTB, NXCD = 8, WGM = 8;

__host__ __device__ __forceinline__ int lds_byte(int r, int c) { const int st = (r >> 4) * 2 + (c >> 5), rr = r & 15, cc = c & 31, ob = rr * 64 + cc * 2; return st * 1024 + (ob ^ (((ob >> 9) & 1) << 5)); }
__host__ __device__ __forceinline__ void stage_rc(int b, int& R, int& C) { const int st = b / 1024, sb = b % 1024, swz = sb ^ (((sb >> 9) & 1) << 5); R = (st >> 1) * 16 + swz / 64; C = (st & 1) * 32 + (swz % 64) / 2; }
__host__ __device__ __forceinline__ int perm32(int rho) { const int n = rho >> 4, i = rho & 15; return 8 * (i >> 2) + 4 * n + (i & 3); }

struct Unit { int pm, pn; };
struct Gemm { const bf16_t* A; const bf16_t* Bt; int M, N, K; };

struct StaticOrder {
    int nM, nN, nwg, G, c;
    __host__ __device__ void init(int M, int N, int G_, int c_) { nM = M / BM; nN = N / BM; nwg = nM * nN; G = G_; c = c_; }
    __host__ __device__ bool next(int i, Unit& u) const {
        const long L = (long)i * G + c; if (L >= nwg) return false;
        int wgid = (int)L; { const int q = nwg / NXCD, r = nwg % NXCD, xcd = wgid % NXCD, off = wgid / NXCD; wgid = (xcd < r ? xcd * (q + 1) : r * (q + 1) + (xcd - r) * q) + off; }
        const int nig = WGM * nN, gid = wgid / nig, fm = gid * WGM, gsz = (nM - fm) < WGM ? (nM - fm) : WGM;
        u.pm = fm + ((wgid % nig) % gsz); u.pn = (wgid % nig) / gsz; return true;
    }
    __device__ __forceinline__ void a_ready(const Unit&) const {}
    __device__ __forceinline__ void done(const Unit&) const {}
};

__device__ __forceinline__ unsigned cvt_pk_bf16(float lo, float hi) { unsigned r; asm volatile("v_cvt_pk_bf16_f32 %0, %1, %2" : "=v"(r) : "v"(lo), "v"(hi)); return r; }
template <class Epi, class Sched, bool ALIGN_EPI = false, bool SP2 = false>
__device__ __forceinline__ void gemm_phase(PG8_LAS unsigned char* lds, const Gemm g, const Sched& S, const Epi& E) {
    const int tid = threadIdx.x, wid = __builtin_amdgcn_readfirstlane(tid >> 6), lane = tid & 63, wr = wid >> 2, wc = wid & 3, fr = lane & 15, fq = lane >> 4;
    const int K = g.K, nt = K / BK;
    unsigned voffA[2], voffB[2];
#pragma unroll
    for (int i = 0; i < 2; ++i) { int R, C; stage_rc(tid * 16 + i * 8192, R, C); const int Rb = Epi::PERM ? ((R & ~31) + perm32(R & 31)) : R;
        voffA[i] = (unsigned)(R * K + C) * 2u; voffB[i] = (unsigned)(Rb * K + C) * 2u; }
    const size_t kstep = (size_t)(BK * 2);
    const size_t hstep = (size_t)HALF * K * 2;
    const size_t tstep = 2 * hstep;
    const unsigned ldsw = (unsigned)wid * 1024u;
    const int aoff = lds_byte(wr * 64 + fr, fq * 8), boff = lds_byte(wc * 32 + fr, fq * 8);
#define PG8_SA(b, h) (((b) * 2 + (h)) * HTB)
#define PG8_SB(b, h) ((4 + (b) * 2 + (h)) * HTB)
#define PG8_STAGE(bufoff, gbase, voff) do { _Pragma("unroll") for (int _i = 0; _i < 2; ++_i) \
        __builtin_amdgcn_global_load_lds((const unsigned*)((const char*)(gbase) + (voff)[_i]), (PG8_LAS unsigned*)(lds + (bufoff) + ldsw + _i * 8192), 16, 0, 0); } while (0)
#define PG8_LDA(dst, b, h) do { _Pragma("unroll") for (int m = 0; m < 4; ++m) _Pragma("unroll") for (int k = 0; k < 2; ++k) dst[m][k] = *(const PG8_LAS bf16x8*)(lds + PG8_SA(b, h) + aoff + m * 2048 + k * 1024); } while (0)
#define PG8_LDB(dst, b, h) do { _Pragma("unroll") for (int n = 0; n < 2; ++n) _Pragma("unroll") for (int k = 0; k < 2; ++k) dst[n][k] = *(const PG8_LAS bf16x8*)(lds + PG8_SB(b, h) + boff + n * 2048 + k * 1024); } while (0)
#define PG8_MMA(ai, bj, At, Bt) do { __builtin_amdgcn_s_setprio(1); _Pragma("unroll") for (int m = 0; m < 4; ++m) _Pragma("unroll") for (int n = 0; n < 2; ++n) _Pragma("unroll") for (int k = 0; k < 2; ++k) \
        acc[ai][bj][m][n] = __builtin_amdgcn_mfma_f32_16x16x32_bf16(Bt[n][k], At[m][k], acc[ai][bj][m][n], 0, 0, 0); __builtin_amdgcn_s_setprio(0); } while (0)
#define PG8_WAIT_V(n) asm volatile("s_waitcnt vmcnt(" #n ")" ::: "memory")
#define PG8_WAIT_L(n) asm volatile("s_waitcnt lgkmcnt(" #n ")" ::: "memory")
#define PG8_BAR __builtin_amdgcn_s_barrier()
#define PG8_SCHED __builtin_amdgcn_sched_barrier(0)
    Unit cur, nxt; int ui = 0;
    if (!S.next(0, cur)) return;
    f32x4 acc[2][2][4][2];
#pragma unroll
    for (int a = 0; a < 2; ++a)
#pragma unroll
        for (int b = 0; b < 2; ++b)
#pragma unroll
            for (int m = 0; m < 4; ++m)
#pragma unroll
                for (int n = 0; n < 2; ++n) acc[a][b][m][n] = (f32x4){0.f, 0.f, 0.f, 0.f};
    bf16x8 At[4][2], B0[2][2], B1[2][2];
    const char* cA = (const char*)g.A + (size_t)cur.pm * tstep; const char* cB = (const char*)g.Bt + (size_t)cur.pn * tstep;
    S.a_ready(cur);
    if constexpr (SP2) {
        PG8_STAGE(PG8_SB(0, 0), cB, voffB); PG8_STAGE(PG8_SB(0, 1), cB + hstep, voffB); PG8_STAGE(PG8_SA(0, 0), cA, voffA); PG8_STAGE(PG8_SA(0, 1), cA + hstep, voffA);
        if (wr == 1) PG8_BAR;
        PG8_WAIT_V(2); PG8_BAR;
        PG8_STAGE(PG8_SB(1, 0), cB + kstep, voffB); PG8_STAGE(PG8_SA(1, 0), cA + kstep, voffA); PG8_STAGE(PG8_SB(1, 1), cB + hstep + kstep, voffB);
        PG8_WAIT_V(6); PG8_BAR;
    } else {
        PG8_STAGE(PG8_SB(0, 0), cB, voffB); PG8_STAGE(PG8_SA(0, 0), cA, voffA); PG8_STAGE(PG8_SB(0, 1), cB + hstep, voffB); PG8_STAGE(PG8_SA(0, 1), cA + hstep, voffA);
        if (wr == 1) PG8_BAR;
        PG8_WAIT_V(4); PG8_BAR;
        PG8_STAGE(PG8_SB(1, 0), cB + kstep, voffB); PG8_STAGE(PG8_SA(1, 0), cA + kstep, voffA); PG8_STAGE(PG8_SB(1, 1), cB + hstep + kstep, voffB);
        PG8_WAIT_V(6); PG8_BAR;
    }
    for (;;) {
        const bool has_next = S.next(ui + 1, nxt);
        const char* nA = has_next ? (const char*)g.A + (size_t)nxt.pm * tstep : cA; const char* nB = has_next ? (const char*)g.Bt + (size_t)nxt.pn * tstep : cB;
        for (int t = 0; t < nt; t += 2) {
            const bool last = (t == nt - 2);
            const char* a1 = cA + (size_t)(t + 1) * kstep;
            const char* a2 = last ? nA : cA + (size_t)(t + 2) * kstep; const char* b2 = last ? nB : cB + (size_t)(t + 2) * kstep;
            const char* a3 = a2 + kstep; const char* b3 = b2 + kstep;
            if (last && has_next) S.a_ready(nxt);
            if constexpr (SP2) {
            PG8_LDB(B0, 0, 0); PG8_LDB(B1, 0, 1); PG8_SCHED; PG8_LDA(At, 0, 0); PG8_STAGE(PG8_SA(1, 1), a1 + hstep, voffA);
            PG8_WAIT_V(8); PG8_WAIT_L(0); PG8_BAR; PG8_MMA(0, 0, At, B0); PG8_MMA(0, 1, At, B1); PG8_BAR; PG8_SCHED;
            PG8_LDA(At, 0, 1); PG8_STAGE(PG8_SB(0, 0), b2, voffB); PG8_STAGE(PG8_SB(0, 1), b2 + hstep, voffB); PG8_STAGE(PG8_SA(0, 0), a2, voffA);
            PG8_WAIT_V(8); PG8_WAIT_L(0); PG8_BAR; PG8_MMA(1, 0, At, B0); PG8_MMA(1, 1, At, B1); PG8_BAR; PG8_SCHED;
            PG8_LDB(B0, 1, 0); PG8_LDB(B1, 1, 1); PG8_SCHED; PG8_LDA(At, 1, 0); PG8_STAGE(PG8_SA(0, 1), a2 + hstep, voffA);
            PG8_WAIT_V(8); PG8_WAIT_L(0); PG8_BAR; PG8_MMA(0, 0, At, B0); PG8_MMA(0, 1, At, B1); PG8_BAR; PG8_SCHED;
            PG8_LDA(At, 1, 1); PG8_STAGE(PG8_SB(1, 0), b3, voffB); PG8_STAGE(PG8_SB(1, 1), b3 + hstep, voffB); PG8_STAGE(PG8_SA(1, 0), a3, voffA);
            PG8_WAIT_V(8); PG8_WAIT_L(0); PG8_BAR; PG8_MMA(1, 0, At, B0); PG8_MMA(1, 1, At, B1); PG8_BAR; PG8_SCHED;
            } else {
            PG8_LDB(B0, 0, 0); PG8_SCHED; PG8_LDA(At, 0, 0); PG8_STAGE(PG8_SA(1, 1), a1 + hstep, voffA);
            PG8_WAIT_L(8); PG8_BAR; PG8_WAIT_L(0); PG8_MMA(0, 0, At, B0); PG8_BAR; PG8_SCHED;
            PG8_LDB(B1, 0, 1); PG8_STAGE(PG8_SB(0, 0), b2, voffB);
            PG8_BAR; PG8_WAIT_L(0); PG8_MMA(0, 1, At, B1); PG8_BAR;
            PG8_LDA(At, 0, 1); PG8_STAGE(PG8_SA(0, 0), a2, voffA);
            PG8_BAR; PG8_WAIT_L(0); PG8_MMA(1, 0, At, B0); PG8_BAR; PG8_SCHED;
            PG8_STAGE(PG8_SB(0, 1), b2 + hstep, voffB);
            PG8_WAIT_V(6); PG8_BAR; PG8_MMA(1, 1, At, B1); PG8_BAR;
            PG8_LDB(B0, 1, 0); PG8_SCHED; PG8_LDA(At, 1, 0); PG8_STAGE(PG8_SA(0, 1), a2 + hstep, voffA);
            PG8_WAIT_L(8); PG8_BAR; PG8_WAIT_L(0); PG8_MMA(0, 0, At, B0); PG8_BAR; PG8_SCHED;
            PG8_LDB(B1, 1, 1); PG8_STAGE(PG8_SB(1, 0), b3, voffB);
            PG8_BAR; PG8_WAIT_L(0); PG8_MMA(0, 1, At, B1); PG8_BAR;
            PG8_LDA(At, 1, 1); PG8_STAGE(PG8_SA(1, 0), a3, voffA);
            PG8_BAR; PG8_WAIT_L(0); PG8_MMA(1, 0, At, B0); PG8_BAR; PG8_SCHED;
            PG8_STAGE(PG8_SB(1, 1), b3 + hstep, voffB);
            PG8_WAIT_V(6); PG8_BAR; PG8_MMA(1, 1, At, B1); PG8_BAR;
            }
        }
        if constexpr (ALIGN_EPI) { if (wr == 0) PG8_BAR; }
        if constexpr (!Epi::AFTER_DRAIN) { E(acc, cur, wr, wc, fr, fq); S.done(cur); }
        if (!has_next) break;
#pragma unroll
        for (int a = 0; a < 2; ++a)
#pragma unroll
            for (int b = 0; b < 2; ++b)
#pragma unroll
                for (int m = 0; m < 4; ++m)
#pragma unroll
                    for (int n = 0; n < 2; ++n) acc[a][b][m][n] = (f32x4){0.f, 0.f, 0.f, 0.f};
        cur = nxt; cA = nA; cB = nB; ++ui;
        if constexpr (ALIGN_EPI) { if (wr == 1) PG8_BAR; }
    }
    PG8_WAIT_V(0);
    if constexpr (!ALIGN_EPI) { if (wr == 0) PG8_BAR; }
    PG8_BAR;
    if constexpr (Epi::AFTER_DRAIN) { E.fused(acc, cur, wr, wc, fr, fq, lds, wid, lane); S.done(cur); }
#undef PG8_SA
#undef PG8_SB
#undef PG8_STAGE
#undef PG8_LDA
#undef PG8_LDB
#undef PG8_MMA
#undef PG8_WAIT_V
#undef PG8_WAIT_L
#undef PG8_BAR
#undef PG8_SCHED
}
}

#define DI __device__ __forceinline__
typedef unsigned short bf16_t;
typedef short bf16x8 __attribute__((ext_vector_type(8)));
typedef float f32x4 __attribute__((ext_vector_type(4)));
typedef float f32x2 __attribute__((ext_vector_type(2)));
typedef float f32x16 __attribute__((ext_vector_type(16)));
typedef unsigned u32x4 __attribute__((ext_vector_type(4)));
typedef unsigned u32x2 __attribute__((ext_vector_type(2)));
typedef __bf16 bf2_t __attribute__((ext_vector_type(2)));

constexpr int NTOK = 16384, SEQ = 8192, DM = 1024, NIN = 7200, NWAVES = 8;
constexpr float RMS_EPS = 1e-6f;
constexpr float LOG2E = 1.4426950408889634f;
constexpr size_t MiB = (size_t)1 << 20;
constexpr size_t WS_ZM = 0, WS_VMT = 512 * 1024, WS_UM = 640 * 1024, WS_WS = 704 * 1024, WS_R = 1 * MiB, WS_WO = 3 * MiB, WS_XW = 8 * MiB,
                 WS_AO = 54 * MiB, WS_NK = 118 * MiB, WS_NVT = 150 * MiB, WS_VGT = 182 * MiB, WS_QG = 214 * MiB, WS_KG = 230 * MiB, WS_OB = 214 * MiB,
                 WS_PKF = WS_XW, WS_PKB = WS_NK, WS_CTL = 246 * MiB, WS_END = 247 * MiB;
constexpr int PK_BYTES = 41472;
constexpr int PK_A_OFF = 40960;
constexpr int LDS_BYTES = 163840;

DI unsigned pk2(float lo, float hi) { f32x2 v = {lo, hi}; bf2_t b = __builtin_convertvector(v, bf2_t); return __builtin_bit_cast(unsigned, b); }
DI float bf2f(bf16_t u) { return __uint_as_float(((unsigned)u) << 16); }
DI float wave_sum(float v) {
#pragma unroll
    for (int o = 1; o < 64; o <<= 1) v += __shfl_xor(v, o);
    return v;
}
DI float silu_f(float x) { return x * __builtin_amdgcn_rcpf(1.f + __expf(-x)); }
DI int crow(int reg, int h) { return (reg & 3) + 8 * (reg >> 2) + 4 * h; }
#define MFMA32(a, b, c) __builtin_amdgcn_mfma_f32_32x32x16_bf16((a), (b), (c), 0, 0, 0)
#define MFMA16(a, b, c) __builtin_amdgcn_mfma_f32_16x16x32_bf16((a), (b), (c), 0, 0, 0)

struct Args {
    const float *x, *meta, *norm_g, *w_in, *wd_f, *bd_f, *wd_b, *bd_b, *gla_g, *qn_g, *kn_g, *rpb, *meta_bias, *w_out;
    float* out; unsigned char* ws;
};

DI int phys_norm(int wt, int lc) { return 256 * wt + 128 * ((lc >> 5) & 1) + 32 * (lc >> 6) + (lc & 31); }

DI void p0_transpose_item(const float* W, int ldw, int k0, int n0, bf16_t* WT, int ldwt, int row0, float* scr, int lane) {
#pragma unroll 8
    for (int i = 0; i < 32; ++i) { const int kk = 2 * i + (lane >> 5); scr[kk * 33 + (lane & 31)] = W[(size_t)(k0 + kk) * ldw + n0 + (lane & 31)]; }
    asm volatile("s_waitcnt lgkmcnt(0)" ::: "memory");
    const int c = lane & 7;
#pragma unroll
    for (int j = 0; j < 4; ++j) { const int n = (lane >> 3) + 8 * j; const float* s = scr + (8 * c) * 33 + n;
        u32x4 o; o.x = pk2(s[0 * 33], s[1 * 33]); o.y = pk2(s[2 * 33], s[3 * 33]); o.z = pk2(s[4 * 33], s[5 * 33]); o.w = pk2(s[6 * 33], s[7 * 33]);
        *(u32x4*)(WT + (size_t)(row0 + n) * ldwt + k0 + 8 * c) = o; }
    asm volatile("s_waitcnt lgkmcnt(0)" ::: "memory");
}
DI int wt_base(int wt) {
    if (wt < 2) return 0 + 256 * wt;
    if (wt < 4) return 512 + 256 * (wt - 2);
    if (wt < 8) return 2080 + 256 * (wt - 4);
    if (wt < 12) return 3104 + 256 * (wt - 8);
    if (wt < 16) return 4128 + 256 * (wt - 12);
    if (wt < 20) return 6176 + 256 * (wt - 16);
    if (wt < 24) return 1024 + 256 * (wt - 20);
    return 5152 + 256 * (wt - 24);
}
DI void rms_row_to_bf16(const float* xrow, const float* g, bf16_t* orow, int lane) {
    const f32x4* xr = (const f32x4*)xrow + lane; const f32x4* gr = (const f32x4*)g + lane;
    f32x4 v[4]; float s = 0.f;
#pragma unroll
    for (int j = 0; j < 4; ++j) { v[j] = xr[64 * j]; s += (v[j].x * v[j].x + v[j].y * v[j].y) + (v[j].z * v[j].z + v[j].w * v[j].w); }
    const float rstd = 1.0f / sqrtf(wave_sum(s) * (1.f / DM) + RMS_EPS);
    unsigned long long* o8 = (unsigned long long*)orow + lane;
#pragma unroll
    for (int j = 0; j < 4; ++j) { const f32x4 gg = gr[64 * j];
        o8[64 * j] = (unsigned long long)pk2(v[j].x * rstd * gg.x, v[j].y * rstd * gg.y) | ((unsigned long long)pk2(v[j].z * rstd * gg.z, v[j].w * rstd * gg.w) << 32); }
}
DI void p0_block_item(const float* W, int ldw, int k0, int n0, bool perm, bf16_t* WT, int ldwt, int row0, float* T  , int tid) {
    f32x4 v[8];
#pragma unroll
    for (int i = 0; i < 8; ++i) { const int e = tid + 512 * i, kk = e >> 6, c4 = e & 63; v[i] = *(const f32x4*)(W + (size_t)(k0 + kk) * ldw + n0 + 4 * c4); }
#pragma unroll
    for (int i = 0; i < 8; ++i) { const int e = tid + 512 * i, kk = e >> 6, c4 = e & 63; float* t = T + kk * 257 + 4 * c4; t[0] = v[i][0]; t[1] = v[i][1]; t[2] = v[i][2]; t[3] = v[i][3]; }
    __syncthreads();
    { const int pp = tid >> 1, kh = tid & 1; const int lc = perm ? (64 * ((pp >> 5) & 3) + 32 * (pp >> 7) + (pp & 31)) : pp;
      const float* t = T + (32 * kh) * 257 + lc;
      unsigned w[16];
#pragma unroll
      for (int j = 0; j < 16; ++j) w[j] = pk2(t[(2 * j) * 257], t[(2 * j + 1) * 257]);
      u32x4* dst = (u32x4*)(WT + (size_t)(row0 + pp) * ldwt + k0 + 32 * kh);
#pragma unroll
      for (int j = 0; j < 4; ++j) dst[j] = (u32x4){w[4 * j], w[4 * j + 1], w[4 * j + 2], w[4 * j + 3]}; }
    __syncthreads();
}
DI void rms_rows2_to_bf16(const float* x0, const float* x1, const float* g, bf16_t* o0, bf16_t* o1, int lane) {
    const f32x4* xa = (const f32x4*)x0 + lane; const f32x4* xb = (const f32x4*)x1 + lane; const f32x4* gr = (const f32x4*)g + lane;
    f32x4 va[4], vb[4]; float sa = 0.f, sb2 = 0.f;
#pragma unroll
    for (int j = 0; j < 4; ++j) { va[j] = xa[64 * j]; vb[j] = xb[64 * j]; }
#pragma unroll
    for (int j = 0; j < 4; ++j) { sa += (va[j].x * va[j].x + va[j].y * va[j].y) + (va[j].z * va[j].z + va[j].w * va[j].w); sb2 += (vb[j].x * vb[j].x + vb[j].y * vb[j].y) + (vb[j].z * vb[j].z + vb[j].w * vb[j].w); }
    const float ra = 1.0f / sqrtf(wave_sum(sa) * (1.f / DM) + RMS_EPS), rb = 1.0f / sqrtf(wave_sum(sb2) * (1.f / DM) + RMS_EPS);
    unsigned long long* oa = (unsigned long long*)o0 + lane; unsigned long long* ob = (unsigned long long*)o1 + lane;
#pragma unroll
    for (int j = 0; j < 4; ++j) { const f32x4 gg = gr[64 * j];
        oa[64 * j] = (unsigned long long)pk2(va[j].x * ra * gg.x, va[j].y * ra * gg.y) | ((unsigned long long)pk2(va[j].z * ra * gg.z, va[j].w * ra * gg.w) << 32);
        ob[64 * j] = (unsigned long long)pk2(vb[j].x * rb * gg.x, vb[j].y * rb * gg.y) | ((unsigned long long)pk2(vb[j].z * rb * gg.z, vb[j].w * rb * gg.w) << 32); }
}
DI void p0_phase(const Args& a, unsigned char* lds, int vcu, int G, int wave, int lane) {
    unsigned char* ws = a.ws;
    bf16_t* XW = (bf16_t*)(ws + WS_XW); bf16_t* WSs = (bf16_t*)(ws + WS_WS); bf16_t* WO = (bf16_t*)(ws + WS_WO); bf16_t* UM = (bf16_t*)(ws + WS_UM);
    const int gw = vcu * NWAVES + wave, NGW = G * NWAVES, tid = wave * 64 + lane;
    for (int it = vcu; it < 448 + 128; it += G) {
        if (it < 448) { const int kb = it / 28, wt = it % 28; p0_block_item(a.w_in, NIN, 64 * kb, wt_base(wt), wt < 20, XW, DM, NTOK + 256 * wt, (float*)lds, tid); }
        else { const int r = it - 448, kb = r >> 2, nb = r & 3; p0_block_item(a.w_out, DM, 64 * kb, 256 * nb, false, WO, 2048, 256 * nb, (float*)lds, tid); }
    }
    { float* scr = (float*)(lds + wave * 16384);
      for (int it = gw; it < 16; it += NGW) p0_transpose_item(a.w_in, NIN, 64 * it, 2048, WSs, DM, 0, scr, lane); }
    for (int m = 2 * gw; m < NTOK; m += 2 * NGW) rms_rows2_to_bf16(a.x + (size_t)m * DM, a.x + (size_t)(m + 1) * DM, a.norm_g, XW + (size_t)m * DM, XW + (size_t)(m + 1) * DM, lane);
    for (int m = gw; m < 16; m += NGW) rms_row_to_bf16(a.meta + (size_t)m * DM, a.norm_g, UM + (size_t)m * DM, lane);
}

DI void skinny_task(const bf16_t* A, const bf16_t* B, float* O, int ldo, int lane) {
    const int r = lane & 15, q = lane >> 4;
    const bf16x8* ap = (const bf16x8*)(A + (size_t)r * DM + 8 * q);
    const bf16x8* b0 = (const bf16x8*)(B + (size_t)r * DM + 8 * q);
    const bf16x8* b1 = (const bf16x8*)(B + (size_t)(16 + r) * DM + 8 * q);
    f32x4 acc0 = {0.f, 0.f, 0.f, 0.f}, acc1 = {0.f, 0.f, 0.f, 0.f};
#pragma unroll
    for (int kh = 0; kh < 2; ++kh) {
        bf16x8 av[16], bv0[16], bv1[16];
#pragma unroll
        for (int ks = 0; ks < 16; ++ks) { av[ks] = ap[4 * (16 * kh + ks)]; bv0[ks] = b0[4 * (16 * kh + ks)]; bv1[ks] = b1[4 * (16 * kh + ks)]; }
#pragma unroll
        for (int ks = 0; ks < 16; ++ks) { acc0 = MFMA16(av[ks], bv0[ks], acc0); acc1 = MFMA16(av[ks], bv1[ks], acc1); }
    }
#pragma unroll
    for (int i = 0; i < 4; ++i) { O[(size_t)(4 * q + i) * ldo + r] = acc0[i]; O[(size_t)(4 * q + i) * ldo + 16 + r] = acc1[i]; }
}
DI void p1_skinny(const Args& a, int vcu, int G, int wave, int lane) {
    unsigned char* ws = a.ws;
    const bf16_t* XW = (const bf16_t*)(ws + WS_XW); const bf16_t* WSs = (const bf16_t*)(ws + WS_WS); const bf16_t* UM = (const bf16_t*)(ws + WS_UM);
    float* R = (float*)(ws + WS_R); float* ZM = (float*)(ws + WS_ZM);
    const int gw = vcu * NWAVES + wave, NGW = G * NWAVES;
    for (int t = gw; t < 1024 + 225; t += NGW) {
        if (t < 1024) skinny_task(XW + (size_t)t * 16 * DM, WSs, R + (size_t)t * 16 * 32, 32, lane);
        else { const int c = t - 1024;
            if (c < 224) skinny_task(UM, XW + (size_t)(NTOK + 32 * c) * DM, ZM + 32 * c, NIN, lane);
            else skinny_task(UM, WSs, ZM + 7168, NIN, lane); }
    }
}

struct OrderIn {
    int G, c;
    DI bool next(int i, pg8::Unit& u) const {
        const long L = (long)i * G + c; if (L >= 1792) return false;
        const int ii = (int)(L >> 8), cc = (int)(L & 255), xcd = cc & 7, j = cc >> 3, tok = 8 * xcd + (j & 7), w4 = j >> 3;
        if (ii < 5) { u.pm = tok; u.pn = 64 + 4 * ii + w4; } else { u.pm = 64 + 20 + 4 * (ii - 5) + w4; u.pn = tok; }
        return true;
    }
    DI void a_ready(const pg8::Unit&) const {}
    DI void done(const pg8::Unit&) const {}
};

struct EpiIn {
    static constexpr bool PERM = true, AFTER_DRAIN = false;
    bf16_t *QG, *KG, *GG, *NGt, *AO, *NK, *VGT, *NVT; const float *qn_g, *kn_g;
    DI void operator()(const f32x4 (&acc)[2][2][4][2], const pg8::Unit& u, int wr, int wc, int fr, int fq) const {
        if (u.pm < 64) {
            const int wt = u.pn - 64;
            const int row0 = u.pm * 256 + wr * 64 + fr;
            if (wt < 8 || wt >= 16) {
                bf16_t* base; int ld; float sc = 1.f; bool act = false;
                if (wt < 2) { base = QG + 256 * wt; ld = 512; sc = 0.08838834764831845f; }
                else if (wt < 4) { base = KG + 256 * (wt - 2); ld = 512; }
                else if (wt < 8) { base = GG + 256 * (wt - 4); ld = 1024; act = true; }
                else { base = NGt + 256 * (wt - 16); ld = 1024; act = true; }
#pragma unroll
                for (int ai = 0; ai < 2; ++ai)
#pragma unroll
                    for (int m = 0; m < 4; ++m) { bf16_t* rowp = base + (size_t)(row0 + ai * 128 + m * 16) * ld + 64 * wc + 8 * fq;
#pragma unroll
                        for (int bj = 0; bj < 2; ++bj) { f32x4 v0 = acc[ai][bj][m][0], v1 = acc[ai][bj][m][1];
                            if (act) { v0 = (f32x4){silu_f(v0[0]), silu_f(v0[1]), silu_f(v0[2]), silu_f(v0[3])}; v1 = (f32x4){silu_f(v1[0]), silu_f(v1[1]), silu_f(v1[2]), silu_f(v1[3])}; }
                            v0 = v0 * sc; v1 = v1 * sc;
                            u32x4 w; w.x = pk2(v0[0], v0[1]); w.y = pk2(v0[2], v0[3]); w.z = pk2(v1[0], v1[1]); w.w = pk2(v1[2], v1[3]);
                            *(u32x4*)(rowp + 32 * bj) = w; } }
            } else {
                const bool isq = wt < 12; const float* g = isq ? qn_g : kn_g; const float gs = isq ? (0.125f * LOG2E) : 1.0f;
                const int kb_ = u.pm >> 5, kgrow_ = (u.pm & 31) * 4 + wr;
                bf16_t* base = isq ? (AO + 1024 + 256 * (wt - 8)) : (NK + ((size_t)((kb_ * 16 + 4 * (wt - 12) + wc) * 128 + kgrow_) * 4096)); const int ld = isq ? 2048 : 1024;
                f32x4 gv[2][2];
#pragma unroll
                for (int bj = 0; bj < 2; ++bj)
#pragma unroll
                    for (int n = 0; n < 2; ++n) gv[bj][n] = *(const f32x4*)(g + 32 * bj + 8 * fq + 4 * n) * gs;
#pragma unroll
                for (int ai = 0; ai < 2; ++ai)
#pragma unroll
                    for (int m = 0; m < 4; ++m) {
                        float ss = 0.f;
#pragma unroll
                        for (int bj = 0; bj < 2; ++bj)
#pragma unroll
                            for (int n = 0; n < 2; ++n) { const f32x4 v = acc[ai][bj][m][n]; ss += (v[0] * v[0] + v[1] * v[1]) + (v[2] * v[2] + v[3] * v[3]); }
                        ss += __shfl_xor(ss, 16); ss += __shfl_xor(ss, 32);
                        const float rstd = 1.0f / sqrtf(ss * (1.f / 64.f) + RMS_EPS);
                        bf16_t* rowp = isq ? (base + (size_t)(row0 + ai * 128 + m * 16) * ld + 64 * wc + 8 * fq) : (base + (size_t)ai * 2 * 4096 + (m * 16 + fr) * 64 + 8 * fq);
#pragma unroll
                        for (int bj = 0; bj < 2; ++bj) { const f32x4 v0 = acc[ai][bj][m][0] * rstd * gv[bj][0], v1 = acc[ai][bj][m][1] * rstd * gv[bj][1];
                            u32x4 w; w.x = pk2(v0[0], v0[1]); w.y = pk2(v0[2], v0[3]); w.z = pk2(v1[0], v1[1]); w.w = pk2(v1[2], v1[3]);
                            *(u32x4*)(rowp + 32 * bj) = w; }
                    }
            }
        } else {
            const int wt = u.pm - 64;
            if (wt < 24) {
                const int bb = u.pn >> 5, cbase = (u.pn & 31) * 4 + (wc >> 1), ksb = (wc & 1) * 2;
                bf16_t* lp = VGT + ((fq & 1) * 32 + fr) * 8 + (fq >> 1) * 512;
#pragma unroll
                for (int ai = 0; ai < 2; ++ai)
#pragma unroll
                    for (int m = 0; m < 4; ++m)
#pragma unroll
                        for (int bj = 0; bj < 2; ++bj) { const f32x4 v0 = acc[ai][bj][m][0], v1 = acc[ai][bj][m][1];
                            u32x4 w; w.x = pk2(v0[0], v0[1]); w.y = pk2(v0[2], v0[3]); w.z = pk2(v1[0], v1[1]); w.w = pk2(v1[2], v1[3]);
                            const int frag = (((bb * 4 + (wt - 20)) * 128 + cbase + 2 * bj) * 8 + wr * 2 + ai * 4 + (m >> 1)) * 4 + ksb;
                            *(u32x4*)(lp + (size_t)frag * 512 + (m & 1) * 128) = w; }
            } else {
                const int vb_ = u.pn >> 5, vgrow_ = (u.pn & 31) * 4 + (wc >> 1);
                bf16_t* lp = NVT + fr * 64 + (wc & 1) * 32 + 8 * fq;
#pragma unroll
                for (int ai = 0; ai < 2; ++ai)
#pragma unroll
                    for (int m = 0; m < 4; ++m)
#pragma unroll
                        for (int bj = 0; bj < 2; ++bj) { const f32x4 v0 = acc[ai][bj][m][0], v1 = acc[ai][bj][m][1];
                            u32x4 w; w.x = pk2(v0[0], v0[1]); w.y = pk2(v0[2], v0[3]); w.z = pk2(v1[0], v1[1]); w.w = pk2(v1[2], v1[3]);
                            const int slab = (vb_ * 16 + 4 * (wt - 24) + 2 * ai + wr) * 128 + vgrow_ + 2 * bj;
                            *(u32x4*)(lp + (size_t)slab * 4096 + m * 16 * 64) = w; }
            }
        }
    }
};

struct EpiOut {
    static constexpr bool PERM = false, AFTER_DRAIN = false;
    const float* x; float* out;
    DI void operator()(const f32x4 (&acc)[2][2][4][2], const pg8::Unit& u, int wr, int wc, int fr, int fq) const {
        const int row0 = u.pm * 256 + wr * 64 + fr, col0 = u.pn * 256 + wc * 32 + 4 * fq;
#pragma unroll
        for (int ai = 0; ai < 2; ++ai)
#pragma unroll
            for (int m = 0; m < 4; ++m) { const size_t off = (size_t)(row0 + ai * 128 + m * 16) * DM + col0;
#pragma unroll
                for (int bj = 0; bj < 2; ++bj)
#pragma unroll
                    for (int n = 0; n < 2; ++n) { const f32x4 xs = *(const f32x4*)(x + off + bj * 128 + n * 16); *(f32x4*)(out + off + bj * 128 + n * 16) = xs + acc[ai][bj][m][n]; } }
    }
};

constexpr int NA_SLOT = 16384, NA_NSLOT = 9, NA_KM = NA_NSLOT * NA_SLOT, NA_VM = NA_KM + 2048, NA_RPB = NA_VM + 2048, NA_MB = NA_RPB + 1920;
#define NA_BAR() do { asm volatile("s_waitcnt lgkmcnt(0)" ::: "memory"); __builtin_amdgcn_s_barrier(); asm volatile("" ::: "memory"); } while (0)
DI void na_stage_row(const bf16_t* kslab, const bf16_t* vslab, unsigned char* slot, int lw, int lane) {
#pragma unroll
    for (int i = 0; i < 2; ++i) { const int piece = 2 * lw + i, P = 64 * piece + lane, line = P >> 4, pos = P & 15;
        { const int b0 = ((pos >> 3) & 1) ^ (line & 1), uu = (pos & 7) ^ (4 * b0 + ((line >> 2) & 3)), key = 2 * line + b0;
          __builtin_amdgcn_global_load_lds((const unsigned*)(kslab + key * 64 + uu * 8), (PG8_LAS unsigned*)(slot + piece * 1024), 16, 0, 0); }
        { const int x = pos ^ (line & 7), d = 2 * line + (x >> 3), uk = x & 7;
          __builtin_amdgcn_global_load_lds((const unsigned*)(vslab + d * 64 + uk * 8), (PG8_LAS unsigned*)(slot + 8192 + piece * 1024), 16, 0, 0); } }
}
DI int na_rs(int r) { int rs = r - 4; return rs < 0 ? 0 : (rs > 120 ? 120 : rs); }
DI void na_phase(const Args& a, unsigned char* lds, int vcu, int G, int wave, int lane, bf16_t* ODST, int ostride) {
    unsigned char* ws = a.ws;
    const float* ZM = (const float*)(ws + WS_ZM);
    bf16_t* AO = (bf16_t*)(ws + WS_AO); const bf16_t* NKP = (const bf16_t*)(ws + WS_NK); const bf16_t* NVP = (const bf16_t*)(ws + WS_NVT);
    const bf16_t* NGt = (const bf16_t*)a.out + (size_t)NTOK * 1024;
    bf16_t* KM = (bf16_t*)(lds + NA_KM); bf16_t* VM = (bf16_t*)(lds + NA_VM); float* RPB = (float*)(lds + NA_RPB); float* MB = (float*)(lds + NA_MB);
    const int tid = wave * 64 + lane;
    for (int task = vcu; task < 256; task += G) {
        const int b = task >> 7, h = (task >> 3) & 15, r0 = (task & 7) * 16;
        const bf16_t* kbase = NKP + (size_t)((b * 16 + h) * 128) * 4096; const bf16_t* vbase = NVP + (size_t)((b * 16 + h) * 128) * 4096;
        for (int m = wave; m < 16; m += NWAVES) { const int d = lane;
            const float v = ZM[(size_t)m * NIN + 256 * (12 + (h >> 2)) + 128 * (d >> 5) + 32 * (h & 3) + (d & 31)];
            const float rstd = 1.0f / sqrtf(wave_sum(v * v) * (1.f / 64.f) + RMS_EPS);
            KM[m * 64 + d] = (bf16_t)(pk2(v * rstd * a.kn_g[d], 0.f) & 0xffffu); }
        for (int e = tid; e < 1024; e += 512) { const int m = e & 15, d = e >> 4;
            VM[e] = (bf16_t)(pk2(ZM[(size_t)m * NIN + 256 * (24 + (h >> 2)) + 64 * (h & 3) + d], 0.f) & 0xffffu); }
        if (tid < 465) RPB[tid] = a.rpb[h * 465 + tid] * LOG2E;
        if (tid < 16) MB[tid] = a.meta_bias[h * 16 + tid] * LOG2E;
        const int lo = na_rs(r0);
        if (wave >= 4) {
            const int lw = wave - 4;
            for (int x = lo; x < lo + 8; ++x) na_stage_row(kbase + (size_t)x * 4096, vbase + (size_t)x * 4096, lds + (x % NA_NSLOT) * NA_SLOT, lw, lane);
            asm volatile("s_waitcnt vmcnt(0)" ::: "memory");
            NA_BAR();
            for (int r = r0; r < r0 + 16; ++r) {
                if (r + 1 < r0 + 16 && na_rs(r + 1) > na_rs(r)) { const int x = na_rs(r + 1) + 7;
                    na_stage_row(kbase + (size_t)x * 4096, vbase + (size_t)x * 4096, lds + (x % NA_NSLOT) * NA_SLOT, lw, lane); }
                asm volatile("s_waitcnt vmcnt(0)" ::: "memory");
                NA_BAR();
            }
            continue;
        }
        const int n = lane & 15, q4 = lane >> 4, qt = wave;
        const int c0 = (qt == 0) ? 0 : (qt == 1) ? 8 : (qt == 2) ? 24 : 32;
        const int qc = 16 * qt + n;
        int cs = qc - 8; cs = cs < 0 ? 0 : (cs > 48 ? 48 : cs);
        bf16x8 qf[2], qn[2];
        { const size_t qtok = (size_t)b * SEQ + r0 * 64 + qc;
#pragma unroll
          for (int ks = 0; ks < 2; ++ks) qf[ks] = *(const bf16x8*)(AO + qtok * 2048 + 1024 + h * 64 + 32 * ks + 8 * q4); }
        int koff[2][2];
#pragma unroll
        for (int t = 0; t < 2; ++t) { const int key = c0 + 8 * (n >> 2) + 4 * t + (n & 3); const int f = ((key & 3) << 2) | ((key >> 3) & 3);
#pragma unroll
            for (int ks = 0; ks < 2; ++ks) koff[t][ks] = ((key >> 1) * 16 + ((((key & 1) * 8) + 4 * ks + q4) ^ f)) * 16; }
        int voff[4];
#pragma unroll
        for (int dt = 0; dt < 4; ++dt) { const int d = 16 * dt + n, uk = (c0 >> 3) + q4; voff[dt] = 8192 + ((d >> 1) * 16 + ((((d & 1) * 8) + uk) ^ ((d >> 1) & 7))) * 16; }
        float madd[2][4]; int boff[2][4];
#pragma unroll
        for (int t = 0; t < 2; ++t)
#pragma unroll
            for (int i = 0; i < 4; ++i) { const int kc = c0 + 8 * q4 + 4 * t + i; const bool valid = (kc >= cs) && (kc < cs + 16);
                int dcol = kc - qc + 15; dcol = dcol < 0 ? 0 : (dcol > 30 ? 30 : dcol); madd[t][i] = valid ? 0.f : -1e30f; boff[t][i] = dcol * 4; }
        NA_BAR();
        for (int r = r0; r < r0 + 16; ++r) {
            const int rs = na_rs(r);
            const size_t qtok = (size_t)b * SEQ + r * 64 + qc;
            if (r + 1 < r0 + 16) {
#pragma unroll
                for (int ks = 0; ks < 2; ++ks) qn[ks] = *(const bf16x8*)(AO + (qtok + 64) * 2048 + 1024 + h * 64 + 32 * ks + 8 * q4);
            }
            u32x2 gw[4];
#pragma unroll
            for (int dt = 0; dt < 4; ++dt) gw[dt] = *(const u32x2*)(NGt + qtok * 1024 + h * 64 + 16 * dt + 4 * q4);
            f32x4 sc[17];
#pragma unroll
            for (int kr = 0; kr < 8; ++kr) {
                const unsigned char* slot = lds + ((rs + kr) % NA_NSLOT) * NA_SLOT;
#pragma unroll
                for (int t = 0; t < 2; ++t) {
                    const bf16x8 k0 = *(const bf16x8*)(slot + koff[t][0]);
                    const bf16x8 k1 = *(const bf16x8*)(slot + koff[t][1]);
                    f32x4 z = {0.f, 0.f, 0.f, 0.f};
                    z = MFMA16(k0, qf[0], z); z = MFMA16(k1, qf[1], z);
                    sc[2 * kr + t] = z;
                }
            }
            {
                const bf16x8 k0 = *(const bf16x8*)(KM + n * 64 + 8 * q4);
                const bf16x8 k1 = *(const bf16x8*)(KM + n * 64 + 32 + 8 * q4);
                f32x4 z = {0.f, 0.f, 0.f, 0.f};
                z = MFMA16(k0, qf[0], z); z = MFMA16(k1, qf[1], z);
                sc[16] = z;
            }
            float mx = -1e30f;
            const unsigned char* rpb0 = (const unsigned char*)RPB + (rs - r + 7) * 124;
#pragma unroll
            for (int kr = 0; kr < 8; ++kr) {
#pragma unroll
                for (int t = 0; t < 2; ++t)
#pragma unroll
                    for (int i = 0; i < 4; ++i) {
                        const float bias = *(const float*)(rpb0 + kr * 124 + boff[t][i]);
                        const float sv = sc[2 * kr + t][i] + (bias + madd[t][i]);
                        sc[2 * kr + t][i] = sv; mx = fmaxf(mx, sv);
                    }
            }
#pragma unroll
            for (int i = 0; i < 4; ++i) { const float sv = sc[16][i] + MB[4 * q4 + i]; sc[16][i] = sv; mx = fmaxf(mx, sv); }
            mx = fmaxf(mx, __shfl_xor(mx, 16)); mx = fmaxf(mx, __shfl_xor(mx, 32));
            float sum = 0.f;
#pragma unroll
            for (int j = 0; j < 17; ++j)
#pragma unroll
                for (int i = 0; i < 4; ++i) { const float pp = __builtin_amdgcn_exp2f(sc[j][i] - mx); sc[j][i] = pp; sum += pp; }
            sum += __shfl_xor(sum, 16); sum += __shfl_xor(sum, 32);
            const float inv = 1.0f / sum;
            f32x4 o[4];
#pragma unroll
            for (int dt = 0; dt < 4; ++dt) o[dt] = (f32x4){0.f, 0.f, 0.f, 0.f};
#pragma unroll
            for (int kr = 0; kr < 8; ++kr) {
                const unsigned char* slot = lds + ((rs + kr) % NA_NSLOT) * NA_SLOT;
                u32x4 pw; pw.x = pk2(sc[2 * kr][0], sc[2 * kr][1]); pw.y = pk2(sc[2 * kr][2], sc[2 * kr][3]); pw.z = pk2(sc[2 * kr + 1][0], sc[2 * kr + 1][1]); pw.w = pk2(sc[2 * kr + 1][2], sc[2 * kr + 1][3]);
                const bf16x8 pf = __builtin_bit_cast(bf16x8, pw);
#pragma unroll
                for (int dt = 0; dt < 4; ++dt) { const bf16x8 vf = *(const bf16x8*)(slot + voff[dt]); o[dt] = MFMA16(vf, pf, o[dt]); }
            }
            {
                u32x4 pw; pw.x = pk2(sc[16][0], sc[16][1]); pw.y = pk2(sc[16][2], sc[16][3]); pw.z = 0u; pw.w = 0u;
                const bf16x8 pf = __builtin_bit_cast(bf16x8, pw);
#pragma unroll
                for (int dt = 0; dt < 4; ++dt) {
                    const u32x2 lo2 = *(const u32x2*)(VM + ((16 * dt + n) * 16 + 4 * q4));
                    u32x4 vw; vw.x = lo2.x; vw.y = lo2.y; vw.z = 0u; vw.w = 0u;
                    o[dt] = MFMA16(__builtin_bit_cast(bf16x8, vw), pf, o[dt]);
                }
            }
#pragma unroll
            for (int dt = 0; dt < 4; ++dt) {
                const int d0 = h * 64 + 16 * dt + 4 * q4;
                const float g0 = __uint_as_float(gw[dt].x << 16), g1 = __uint_as_float(gw[dt].x & 0xffff0000u), g2 = __uint_as_float(gw[dt].y << 16), g3 = __uint_as_float(gw[dt].y & 0xffff0000u);
                u32x2 w; w.x = pk2(o[dt][0] * inv * g0, o[dt][1] * inv * g1); w.y = pk2(o[dt][2] * inv * g2, o[dt][3] * inv * g3);
                *(u32x2*)(ODST + qtok * ostride + d0) = w;
            }
            qf[0] = qn[0]; qf[1] = qn[1];
            NA_BAR();
        }
    }
}

constexpr int PREP_LD = 136;
constexpr int PREP_TILE = 64 * PREP_LD * 2;
constexpr int PREP_R = 4 * PREP_TILE, PREP_PART = PREP_R + 8192;
DI float logsig16(float x) { return (fminf(x, 0.f) - __logf(1.f + __expf(-fabsf(x)))) * (1.f / 16.f); }
DI int phys_gk(int c) { return phys_norm(2 + (c >> 8), c & 255); }
DI void prep_phase(const Args& a, unsigned char* lds, int vcu, int G, int wave, int lane) {
    unsigned char* ws = a.ws;
    const float* ZM = (const float*)(ws + WS_ZM); const float* R = (const float*)(ws + WS_R);
    const bf16_t* QG = (const bf16_t*)(ws + WS_QG); const bf16_t* KG = (const bf16_t*)(ws + WS_KG);
    unsigned char* PKF = ws + WS_PKF; unsigned char* PKB = ws + WS_PKB; bf16_t* VMT = (bf16_t*)(ws + WS_VMT);
    const int tid = wave * 64 + lane;
    bf16_t* T_QF = (bf16_t*)(lds); bf16_t* T_KF = (bf16_t*)(lds + PREP_TILE); bf16_t* T_QB = (bf16_t*)(lds + 2 * PREP_TILE); bf16_t* T_KB = (bf16_t*)(lds + 3 * PREP_TILE);
    float* RS = (float*)(lds + PREP_R); float* PART = (float*)(lds + PREP_PART);
    for (int task = vcu; task < 1024 + 8; task += G) {
        if (task >= 1024) {
            const int mt = task - 1024, b = mt >> 2, h = mt & 3;
            unsigned char* pk = PKF + (size_t)((b * 4 + h) * 129) * PK_BYTES;
            for (int p = tid; p < PK_BYTES / 16; p += 512) *(u32x4*)(pk + p * 16) = (u32x4){0u, 0u, 0u, 0u};
            __syncthreads();
            if (tid < 128) { const int d = tid;
                float wd[16];
#pragma unroll
                for (int k = 0; k < 16; ++k) wd[k] = a.wd_f[k * 512 + h * 128 + d];
                const float bd = a.bd_f[h * 128 + d];
                float G_[16]; float run = 0.f;
#pragma unroll
                for (int m = 0; m < 16; ++m) { float dot = bd;
#pragma unroll
                    for (int k = 0; k < 16; ++k) dot += ZM[(size_t)m * NIN + 7168 + k] * wd[k];
                    run += logsig16(dot); G_[m] = run; }
                unsigned kw[8];
#pragma unroll
                for (int m = 0; m < 16; m += 2) { const float k0 = ZM[(size_t)m * NIN + phys_gk(h * 128 + d)] * __expf(run - G_[m]);
                    const float k1 = ZM[(size_t)(m + 1) * NIN + phys_gk(h * 128 + d)] * __expf(run - G_[m + 1]); kw[m >> 1] = pk2(k0, k1); }
                const int dt = d >> 5, r = d & 31;
                *(u32x4*)(pk + (dt * 4 + 3) * 1024 + (0 * 32 + r) * 16) = (u32x4){kw[0], kw[1], kw[2], kw[3]};
                *(u32x4*)(pk + (dt * 4 + 3) * 1024 + (1 * 32 + r) * 16) = (u32x4){kw[4], kw[5], kw[6], kw[7]};
                *(float*)(pk + PK_A_OFF + d * 4) = 1.0f;
            }
            if (b == 0 && tid < 256) { const int v = tid; const int c = h * 256 + v; bf16_t* row = VMT + (size_t)c * 64;
                for (int j = 0; j < 48; j += 8) *(u32x4*)(row + j) = (u32x4){0u, 0u, 0u, 0u};
                unsigned vw[8];
#pragma unroll
                for (int m = 0; m < 16; m += 2) vw[m >> 1] = pk2(ZM[(size_t)m * NIN + 256 * (20 + (c >> 8)) + (c & 255)], ZM[(size_t)(m + 1) * NIN + 256 * (20 + (c >> 8)) + (c & 255)]);
                *(u32x4*)(row + 48) = (u32x4){vw[0], vw[1], vw[2], vw[3]}; *(u32x4*)(row + 56) = (u32x4){vw[4], vw[5], vw[6], vw[7]}; }
            __syncthreads();
            continue;
        }
        const int b = task >> 9, h = (task >> 7) & 3, c = task & 127;
        const size_t tok0 = (size_t)b * SEQ + c * 64;
        unsigned char* pkf = PKF + (size_t)((b * 4 + h) * 129 + 1 + c) * PK_BYTES;
        unsigned char* pkb = PKB + (size_t)((b * 4 + h) * 128 + c) * PK_BYTES;
        { const f32x4* src = (const f32x4*)(R + tok0 * 32); ((f32x4*)RS)[tid] = src[tid]; }
        const int d = tid & 127, tq = tid >> 7;
        bf16_t qv[16], kv[16];
#pragma unroll
        for (int jj = 0; jj < 16; ++jj) { qv[jj] = QG[(tok0 + 16 * tq + jj) * 512 + h * 128 + d]; kv[jj] = KG[(tok0 + 16 * tq + jj) * 512 + h * 128 + d]; }
        float wf[16], wb[16];
#pragma unroll
        for (int k = 0; k < 16; ++k) { wf[k] = a.wd_f[k * 512 + h * 128 + d]; wb[k] = a.wd_b[k * 512 + h * 128 + d]; }
        const float bf_ = a.bd_f[h * 128 + d], bb_ = a.bd_b[h * 128 + d];
        __syncthreads();
        float pf[16], pb[16];
        { float rf = 0.f, rb = 0.f;
#pragma unroll
          for (int jj = 0; jj < 16; ++jj) { const float* rr = RS + (16 * tq + jj) * 32; float df = bf_, db = bb_;
#pragma unroll
              for (int k4 = 0; k4 < 4; ++k4) { const f32x4 x0 = *(const f32x4*)(rr + 4 * k4), x1 = *(const f32x4*)(rr + 16 + 4 * k4);
                  df += x0[0] * wf[4 * k4] + x0[1] * wf[4 * k4 + 1] + x0[2] * wf[4 * k4 + 2] + x0[3] * wf[4 * k4 + 3];
                  db += x1[0] * wb[4 * k4] + x1[1] * wb[4 * k4 + 1] + x1[2] * wb[4 * k4 + 2] + x1[3] * wb[4 * k4 + 3]; }
              rf += logsig16(df); rb += logsig16(db); pf[jj] = rf; pb[jj] = rb; }
          PART[(0 * 4 + tq) * 128 + d] = rf; PART[(1 * 4 + tq) * 128 + d] = rb; }
        __syncthreads();
        float offf = 0.f, totf = 0.f, offb = 0.f, totb = 0.f;
#pragma unroll
        for (int q = 0; q < 4; ++q) { const float tf = PART[(0 * 4 + q) * 128 + d], tb = PART[(1 * 4 + q) * 128 + d]; totf += tf; totb += tb; if (q < tq) offf += tf; if (q > tq) offb += tb; }
        const float mytb = pb[15];
        unsigned ksf[8], ksb[8];
#pragma unroll
        for (int jj = 0; jj < 16; jj += 2) {
            float kstf[2], kstb[2];
#pragma unroll
            for (int e = 0; e < 2; ++e) { const int j = 16 * tq + jj + e;
                const float q = bf2f(qv[jj + e]), k = bf2f(kv[jj + e]);
                const float Gf = offf + pf[jj + e];
                const float Gb = offb + (mytb - ((jj + e) ? pb[jj + e - 1] : 0.f));
                const float ef = __expf(Gf), eb = __expf(Gb);
                T_QF[j * PREP_LD + d] = (bf16_t)(pk2(q * ef, 0.f) & 0xffffu);
                T_KF[j * PREP_LD + d] = (bf16_t)(pk2(k * __expf(-Gf), 0.f) & 0xffffu);
                T_QB[j * PREP_LD + d] = (bf16_t)(pk2(q * eb, 0.f) & 0xffffu);
                T_KB[j * PREP_LD + d] = (bf16_t)(pk2(k * __expf(-Gb), 0.f) & 0xffffu);
                kstf[e] = k * __expf(totf - Gf); kstb[e] = k * __expf(totb - Gb); }
            ksf[jj >> 1] = pk2(kstf[0], kstf[1]); ksb[jj >> 1] = pk2(kstb[0], kstb[1]);
        }
        { const int dt = d >> 5, r = d & 31;
          *(u32x4*)(pkf + (dt * 4 + tq) * 1024 + (0 * 32 + r) * 16) = (u32x4){ksf[0], ksf[1], ksf[2], ksf[3]};
          *(u32x4*)(pkf + (dt * 4 + tq) * 1024 + (1 * 32 + r) * 16) = (u32x4){ksf[4], ksf[5], ksf[6], ksf[7]};
          *(u32x4*)(pkb + (dt * 4 + tq) * 1024 + (0 * 32 + r) * 16) = (u32x4){ksb[0], ksb[1], ksb[2], ksb[3]};
          *(u32x4*)(pkb + (dt * 4 + tq) * 1024 + (1 * 32 + r) * 16) = (u32x4){ksb[4], ksb[5], ksb[6], ksb[7]};
          if (tq == 0) { *(float*)(pkf + PK_A_OFF + d * 4) = __expf(totf); *(float*)(pkb + PK_A_OFF + d * 4) = __expf(totb); } }
        __syncthreads();
        {
            const int dir = wave >> 2, jt = (wave >> 1) & 1, it = wave & 1;
            const bf16_t* TQ = dir ? T_QB : T_QF; const bf16_t* TK = dir ? T_KB : T_KF; unsigned char* pk = dir ? pkb : pkf;
            const int rho = lane & 31, hh = lane >> 5;
            const int pj = (rho & ~12) | ((rho & 4) << 1) | ((rho & 8) >> 1);
            const int jrow = 32 * jt + pj, icol = 32 * it + rho;
            f32x16 acc;
#pragma unroll
            for (int i = 0; i < 16; ++i) acc[i] = 0.f;
#pragma unroll
            for (int kd = 0; kd < 8; ++kd) { const bf16x8 af = *(const bf16x8*)(TK + jrow * PREP_LD + 16 * kd + 8 * hh); const bf16x8 bfr = *(const bf16x8*)(TQ + icol * PREP_LD + 16 * kd + 8 * hh);
                acc = MFMA32(af, bfr, acc); }
#pragma unroll
            for (int s = 0; s < 2; ++s) {
                unsigned w[4];
#pragma unroll
                for (int e = 0; e < 8; e += 2) {
                    float v[2];
#pragma unroll
                    for (int x = 0; x < 2; ++x) { const int j = 32 * jt + 16 * s + 8 * hh + e + x; const bool keep = dir ? (j >= icol) : (j <= icol); v[x] = keep ? acc[8 * s + e + x] : 0.f; }
                    w[e >> 1] = pk2(v[0], v[1]);
                }
                *(u32x4*)(pk + (32 + it * 4 + 2 * jt + s) * 1024 + lane * 16) = (u32x4){w[0], w[1], w[2], w[3]};
            }
#pragma unroll
            for (int ff = 0; ff < 4; ++ff) { const int f = (wave & 3) * 4 + ff, it2 = f >> 3, kd = f & 7;
                const bf16_t* rowp = TQ + (32 * it2 + rho) * PREP_LD + 16 * kd + 4 * hh;
                const u32x2 lo = *(const u32x2*)(rowp), hi = *(const u32x2*)(rowp + 8);
                *(u32x4*)(pk + (16 + f) * 1024 + lane * 16) = (u32x4){lo.x, lo.y, hi.x, hi.y}; }
        }
        __syncthreads();
    }
}

constexpr int SCAN_BUF = 46080;
constexpr int SCAN_VT = 41984;
constexpr int SCAN_OST = 3 * SCAN_BUF;
DI bf16x8 pack8(const f32x16& x, int s) {
    u32x4 p; p.x = pk2(x[8 * s], x[8 * s + 1]); p.y = pk2(x[8 * s + 2], x[8 * s + 3]); p.z = pk2(x[8 * s + 4], x[8 * s + 5]); p.w = pk2(x[8 * s + 6], x[8 * s + 7]);
    return __builtin_bit_cast(bf16x8, p);
}
DI void scan_stage(const unsigned char* src, const bf16_t* vsrc, int vstride  , unsigned char* dst, int lw, int lane, int i0, int i1) {
#pragma unroll
    for (int i = 0; i < 12; ++i) { const int q = i * 4 + lw; if (i < i0 || i >= i1) continue;
        if (q < 41) __builtin_amdgcn_global_load_lds((const unsigned*)(src + (size_t)q * 1024 + lane * 16), (PG8_LAS unsigned*)(dst + q * 1024), 16, 0, 0);
        else if (q < 45) __builtin_amdgcn_global_load_lds((const unsigned*)(vsrc + (size_t)(q - 41) * vstride), (PG8_LAS unsigned*)(dst + SCAN_VT + (q - 41) * 1024), 16, 0, 0); }
}
#define SCAN_BAR() do { asm volatile("s_waitcnt lgkmcnt(0)" ::: "memory"); __builtin_amdgcn_s_barrier(); asm volatile("" ::: "memory"); } while (0)
#define SCAN_LDF(f) (*(const bf16x8*)(buf + (f) * 1024 + lane * 16))
constexpr int SCAN_UB = 3 * SCAN_BUF, SCAN_SF = SCAN_UB + 16384;
DI void scan_phase(const Args& a, unsigned char* lds, int wave, int lane) {
    const int sb = blockIdx.x; if (sb >= 128) return;
#ifdef SCAN_DBG
    unsigned long long tb_ = 0, tv_ = 0; const unsigned long long ts_ = clock64();
#define SCAN_TB(x) do { const unsigned long long t0_ = clock64(); x; tb_ += clock64() - t0_; } while (0)
#define SCAN_TV(x) do { const unsigned long long t0_ = clock64(); x; tv_ += clock64() - t0_; } while (0)
#define SCAN_FIN() do { if (sb == 0 && wave == SCAN_DBG && lane == 0) { float* dbg = (float*)(a.ws + WS_ZM + 480 * 1024); const unsigned long long tt_ = clock64() - ts_; dbg[0] = (float)tb_; dbg[1] = (float)(tt_ ? tt_ : 1); dbg[2] = (float)tv_; } } while (0)
#else
#define SCAN_TB(x) x
#define SCAN_TV(x) x
#define SCAN_FIN() do {} while (0)
#endif
    unsigned char* ws = a.ws;
    const int stream = sb & 15, eighth = sb >> 4;
    const int b = stream >> 3, dir = (stream >> 2) & 1, h = stream & 3;
    const int nsteps = dir ? 128 : 129;
    const unsigned char* pkbase = dir ? (ws + WS_PKB + (size_t)((b * 4 + h) * 128) * PK_BYTES) : (ws + WS_PKF + (size_t)((b * 4 + h) * 129) * PK_BYTES);
    const bf16_t* VP = (const bf16_t*)(ws + WS_VGT); const bf16_t* VMT = (const bf16_t*)(ws + WS_VMT);
    const int vcol0 = h * 256 + eighth * 32;
#define SCAN_PKIDX(s_) (dir ? (127 - (s_)) : (s_))
#define SCAN_STAGE(s_, i0_, i1_) do { const int ss_ = (s_); \
        if (dir == 0 && ss_ == 0) scan_stage(pkbase, VMT + (size_t)(vcol0 + (lane & 31)) * 64 + 8 * (lane >> 5), 16, lds + (size_t)(ss_ % 3) * SCAN_BUF, lw, lane, i0_, i1_); \
        else { const int cc_ = dir ? (127 - ss_) : (ss_ - 1); \
            scan_stage(pkbase + (size_t)SCAN_PKIDX(ss_) * PK_BYTES, VP + ((size_t)((b * 4 + h) * 128 + cc_) * 8 + eighth) * 2048 + lane * 8, 512, lds + (size_t)(ss_ % 3) * SCAN_BUF, lw, lane, i0_, i1_); } } while (0)
    if (wave >= 4) {
        const int lw = wave - 4;
        SCAN_STAGE(0, 0, 12); SCAN_STAGE(1, 0, 12);
        if (lw == 0) asm volatile("s_waitcnt vmcnt(12)" ::: "memory"); else asm volatile("s_waitcnt vmcnt(11)" ::: "memory");
        SCAN_BAR();
        for (int n = 0; n < nsteps; ++n) {
            if (n + 2 < nsteps) SCAN_STAGE(n + 2, 0, 12);
            SCAN_TV(if (n + 2 < nsteps) { if (lw == 0) asm volatile("s_waitcnt vmcnt(12)" ::: "memory"); else asm volatile("s_waitcnt vmcnt(11)" ::: "memory"); }
            else asm volatile("s_waitcnt vmcnt(0)" ::: "memory"););
            SCAN_TB(SCAN_BAR());
        }
        SCAN_FIN(); return;
    }
    unsigned char* SF = lds + SCAN_UB;
    const int r = lane & 31, hh = lane >> 5;
    if (wave == 0) {
        f32x16 S[4];
#pragma unroll
        for (int dt = 0; dt < 4; ++dt)
#pragma unroll
            for (int i = 0; i < 16; ++i) S[dt][i] = 0.f;
#pragma unroll
        for (int f = 0; f < 16; ++f) *(u32x4*)(SF + f * 1024 + lane * 16) = (u32x4){0u, 0u, 0u, 0u};
        SCAN_BAR();
        for (int n = 0; n < nsteps; ++n) {
            const unsigned char* buf = lds + (size_t)(n % 3) * SCAN_BUF;
            bf16x8 vt[4], kf[16];
#pragma unroll
            for (int ks = 0; ks < 4; ++ks) vt[ks] = *(const bf16x8*)(buf + SCAN_VT + ks * 1024 + lane * 16);
#pragma unroll
            for (int ks = 0; ks < 4; ++ks)
#pragma unroll
                for (int dt = 0; dt < 4; ++dt) kf[dt * 4 + ks] = SCAN_LDF(dt * 4 + ks);
#pragma unroll
            for (int dt = 0; dt < 4; ++dt) {
                f32x4 av[4];
#pragma unroll
                for (int g4 = 0; g4 < 4; ++g4) av[g4] = *(const f32x4*)(buf + PK_A_OFF + (32 * dt + 8 * g4 + 4 * hh) * 4);
#pragma unroll
                for (int g4 = 0; g4 < 4; ++g4) { S[dt][4 * g4] *= av[g4][0]; S[dt][4 * g4 + 1] *= av[g4][1]; S[dt][4 * g4 + 2] *= av[g4][2]; S[dt][4 * g4 + 3] *= av[g4][3]; }
            }
#pragma unroll
            for (int ks = 0; ks < 4; ++ks)
#pragma unroll
                for (int dt = 0; dt < 4; ++dt) S[dt] = MFMA32(kf[dt * 4 + ks], vt[ks], S[dt]);
            unsigned char* sfo = SF + (n & 1) * 8192;
#pragma unroll
            for (int dt = 0; dt < 4; ++dt) { const bf16x8 s0 = pack8(S[dt], 0), s1 = pack8(S[dt], 1);
                *(bf16x8*)(sfo + (2 * dt) * 1024 + lane * 16) = s0; *(bf16x8*)(sfo + (2 * dt + 1) * 1024 + lane * 16) = s1; }
            SCAN_TB(SCAN_BAR());
        }
        SCAN_FIN(); return;
    }
    if (wave == 1) { SCAN_BAR(); for (int n = 0; n < nsteps; ++n) SCAN_BAR(); return; }
    bf16_t* OUT = dir ? (bf16_t*)(ws + WS_OB) : (bf16_t*)(ws + WS_AO); const int ldo = dir ? 1024 : 2048;
    const int ih = wave - 2;
    SCAN_BAR();
    for (int n = 0; n < nsteps; ++n) {
        unsigned char* buf = lds + (size_t)(n % 3) * SCAN_BUF;
        if (dir == 0 && n == 0) { SCAN_BAR(); continue; }
        bf16x8 vt[4], qf[8], af[4], sf[8];
#pragma unroll
        for (int kd = 0; kd < 8; ++kd) { qf[kd] = SCAN_LDF(16 + ih * 8 + kd); sf[kd] = *(const bf16x8*)(SF + ((n + 1) & 1) * 8192 + kd * 1024 + lane * 16); }
#pragma unroll
        for (int ks = 0; ks < 4; ++ks) { vt[ks] = *(const bf16x8*)(buf + SCAN_VT + ks * 1024 + lane * 16); af[ks] = SCAN_LDF(32 + ih * 4 + ks); }
        f32x16 oa, ob;
#pragma unroll
        for (int i = 0; i < 16; ++i) { oa[i] = 0.f; ob[i] = 0.f; }
#pragma unroll
        for (int kd = 0; kd < 4; ++kd) { oa = MFMA32(sf[kd], qf[kd], oa); ob = MFMA32(sf[4 + kd], qf[4 + kd], ob); }
        oa = MFMA32(vt[0], af[0], oa); ob = MFMA32(vt[2], af[2], ob);
        oa = MFMA32(vt[1], af[1], oa); ob = MFMA32(vt[3], af[3], ob);
        { const int c = dir ? (127 - n) : (n - 1);
          bf16_t* op = OUT + ((size_t)b * SEQ + c * 64 + 32 * ih + r) * ldo + vcol0 + 4 * hh;
#pragma unroll
          for (int g4 = 0; g4 < 4; ++g4) { u32x2 w; w.x = pk2(oa[4 * g4] + ob[4 * g4], oa[4 * g4 + 1] + ob[4 * g4 + 1]); w.y = pk2(oa[4 * g4 + 2] + ob[4 * g4 + 2], oa[4 * g4 + 3] + ob[4 * g4 + 3]);
              *(u32x2*)(op + 8 * g4) = w; } }
        SCAN_TB(SCAN_BAR());
    }
    SCAN_FIN();
}

DI void combine_phase(const Args& a, int vcu, int G, int wave, int lane, bf16_t* CDST, int cstride) {
    unsigned char* ws = a.ws;
    bf16_t* AO = (bf16_t*)(ws + WS_AO); const bf16_t* OB = (const bf16_t*)(ws + WS_OB); const bf16_t* GG = (const bf16_t*)a.out;
    const int gw = vcu * NWAVES + wave, NGW = G * NWAVES;
    const f32x4 gn = *(const f32x4*)(a.gla_g + 4 * lane);
    for (int tok = gw; tok < NTOK; tok += NGW) {
        u32x2 f[4], bq[4], gg[4];
#pragma unroll
        for (int h = 0; h < 4; ++h) { f[h] = *(const u32x2*)(AO + (size_t)tok * 2048 + h * 256 + 4 * lane);
            bq[h] = *(const u32x2*)(OB + (size_t)tok * 1024 + h * 256 + 4 * lane); gg[h] = *(const u32x2*)(GG + (size_t)tok * 1024 + h * 256 + 4 * lane); }
#pragma unroll
        for (int h = 0; h < 4; ++h) {
            float o[4];
            o[0] = __uint_as_float(f[h].x << 16) + __uint_as_float(bq[h].x << 16); o[1] = __uint_as_float(f[h].x & 0xffff0000u) + __uint_as_float(bq[h].x & 0xffff0000u);
            o[2] = __uint_as_float(f[h].y << 16) + __uint_as_float(bq[h].y << 16); o[3] = __uint_as_float(f[h].y & 0xffff0000u) + __uint_as_float(bq[h].y & 0xffff0000u);
            const float ss = wave_sum((o[0] * o[0] + o[1] * o[1]) + (o[2] * o[2] + o[3] * o[3]));
            const float rstd = 1.0f / sqrtf(ss * (1.f / 256.f) + RMS_EPS);
            const float g0 = __uint_as_float(gg[h].x << 16), g1 = __uint_as_float(gg[h].x & 0xffff0000u), g2 = __uint_as_float(gg[h].y << 16), g3 = __uint_as_float(gg[h].y & 0xffff0000u);
            u32x2 w; w.x = pk2(o[0] * rstd * gn[0] * g0, o[1] * rstd * gn[1] * g1); w.y = pk2(o[2] * rstd * gn[2] * g2, o[3] * rstd * gn[3] * g3);
            *(u32x2*)(CDST + (size_t)tok * cstride + h * 256 + 4 * lane) = w;
        }
    }
}

#define LAS __attribute__((address_space(3)))
#define XB_TMO      128
#define XB_XCNT(j)  (256  + 64 * (j))
#define XB_XSUB(j)  (1280 + 64 * (j))
#define XB_XGEN(j)  (2304 + 64 * (j))
#define XB_TOP      3328
#define XB_TOPGEN   3392
#define XCD_BAR_WORDS 3456
#define XB_SPIN_CAP (1u << 18)

__device__ __forceinline__ unsigned xb_ld(unsigned* p)              { return __hip_atomic_load(p, __ATOMIC_RELAXED, __HIP_MEMORY_SCOPE_AGENT); }
__device__ __forceinline__ unsigned xb_add(unsigned* p, unsigned v) { return __hip_atomic_fetch_add(p, v, __ATOMIC_RELAXED, __HIP_MEMORY_SCOPE_AGENT); }
__device__ __forceinline__ unsigned xb_xcc_id() { return (unsigned)__builtin_amdgcn_s_getreg((3 << 11) | 20) & 0xFu; }
#define XB_SPIN(cond, bar) do { unsigned _sp = 0; while (cond) { __builtin_amdgcn_s_sleep(1); \
    if ((++_sp & 255u) == 0u) { if (xb_ld(&(bar)[XB_TMO])) break; if (_sp > XB_SPIN_CAP) { atomicAdd(&(bar)[XB_TMO], 1u); break; } } } } while (0)

struct XcdBarrier {
    unsigned* bar; unsigned x;
    volatile LAS unsigned* st;
};

__device__ __forceinline__ XcdBarrier xcd_barrier_post(unsigned* bar, volatile LAS unsigned* st) {
    XcdBarrier b; b.bar = bar; b.x = xb_xcc_id(); b.st = st;
    if (threadIdx.x == 0) (void)xb_add(&bar[XB_XCNT(b.x)], 1u);
    return b;
}
__device__ __forceinline__ void xcd_barrier_complete(unsigned* bar, unsigned x, unsigned& nloc, unsigned& nx) {
    const unsigned G = gridDim.x * gridDim.y * gridDim.z;
    unsigned sum, cnt, mine, sp = 0u;
    for (;;) {
        sum = 0u; cnt = 0u; mine = 0u;
#pragma unroll
        for (unsigned j = 0; j < 16; ++j) { const unsigned c = xb_ld(&bar[XB_XCNT(j)]); sum += c; cnt += (c > 0u) ? 1u : 0u; mine = (j == x) ? c : mine; }
        if (sum == G) break;
        __builtin_amdgcn_s_sleep(1);
        if ((++sp & 255u) == 0u) { if (xb_ld(&bar[XB_TMO])) break; if (sp > XB_SPIN_CAP) { atomicAdd(&bar[XB_TMO], 1u); break; } }
    }
    nloc = mine > 0u ? mine : 1u; nx = cnt > 0u ? cnt : 1u;
}

__device__ __forceinline__ void xcd_barrier(const XcdBarrier& b) {
    asm volatile("s_waitcnt vmcnt(0)" ::: "memory");
    __syncthreads();
    if (threadIdx.x == 0) {
        unsigned* bar = b.bar;
        __builtin_amdgcn_s_waitcnt(0);
        unsigned nloc = b.st[0], nx = b.st[1];
        if (nloc == 0u) { xcd_barrier_complete(bar, b.x, nloc, nx); b.st[0] = nloc; b.st[1] = nx; }
        const unsigned old = xb_add(&bar[XB_XSUB(b.x)], 1u);
        const unsigned gen = old / nloc;
        if (old + 1u == (gen + 1u) * nloc) {
            __builtin_amdgcn_fence(__ATOMIC_RELEASE, "agent");
            asm volatile("s_waitcnt vmcnt(0)" ::: "memory");
            const unsigned og = xb_add(&bar[XB_TOP], 1u);
            const unsigned tg = og / nx;
            if (og + 1u == (tg + 1u) * nx) xb_add(&bar[XB_TOPGEN], 1u);
            else XB_SPIN(xb_ld(&bar[XB_TOPGEN]) == tg, bar);
            __builtin_amdgcn_fence(__ATOMIC_ACQUIRE, "agent");
            xb_add(&bar[XB_XGEN(b.x)], 1u);
            asm volatile("s_waitcnt vmcnt(0)" ::: "memory");
        } else {
            XB_SPIN(xb_ld(&bar[XB_XGEN(b.x)]) == gen, bar);
            __builtin_amdgcn_fence(__ATOMIC_ACQUIRE, "agent");
            asm volatile("s_waitcnt vmcnt(0)" ::: "memory");
        }
    }
    __syncthreads();
}

__global__ void __launch_bounds__(NWAVES * 64, 2) hybrid_fwd(Args args, int ph_lo, int ph_hi) {
    extern __shared__ __attribute__((aligned(16))) unsigned char lds[];
    cg::grid_group grid = cg::this_grid();
    const int tid = threadIdx.x, lane = tid & 63, wave = __builtin_amdgcn_readfirstlane(tid >> 6);
    const int G = gridDim.x, bx = blockIdx.x;
    const int vcu = (G % 8 == 0) ? (bx % 8) * (G / 8) + bx / 8 : bx;
    unsigned char* ws = args.ws;
#ifndef REP_PHASE
#define REP_PHASE -1
#endif
#ifndef PHMASK
#define PHMASK 0x7f
#endif
#define IN(k) (ph_lo <= (k) && (k) < ph_hi && ((PHMASK >> (k)) & 1))
    volatile LAS unsigned* bst = (volatile LAS unsigned*)(lds + LDS_BYTES - 64);
    if (tid < 2) bst[tid] = 0u;
    __syncthreads();
    XcdBarrier bar = xcd_barrier_post((unsigned*)(ws + WS_CTL), bst);
    if (ph_lo < 0) grid.sync();
#define SEAM(k) do { if (IN(k) && IN((k) + 1)) xcd_barrier(bar); } while (0)
    if (IN(0)) { p0_phase(args, lds, vcu, G, wave, lane); if (REP_PHASE == 0 || REP_PHASE == 60) { xcd_barrier(bar); p0_phase(args, lds, vcu, G, wave, lane); } }
    SEAM(0);
    if (IN(1)) {
        p1_skinny(args, vcu, G, wave, lane);
        const bf16_t* XW = (const bf16_t*)(ws + WS_XW);
        pg8::Gemm g{XW, XW, NTOK, 7168, DM};
        OrderIn S{G, bx};
        EpiIn E{(bf16_t*)(ws + WS_QG), (bf16_t*)(ws + WS_KG), (bf16_t*)args.out, (bf16_t*)args.out + (size_t)NTOK * 1024, (bf16_t*)(ws + WS_AO), (bf16_t*)(ws + WS_NK),
                (bf16_t*)(ws + WS_VGT), (bf16_t*)(ws + WS_NVT), args.qn_g, args.kn_g};
        pg8::gemm_phase<EpiIn, OrderIn, true, true>((PG8_LAS unsigned char*)lds, g, S, E);
        }
#if REP_PHASE == 1
    if (IN(1)) { xcd_barrier(bar);
        p1_skinny(args, vcu, G, wave, lane);
        const bf16_t* XW = (const bf16_t*)(ws + WS_XW);
        pg8::Gemm g{XW, XW, NTOK, 7168, DM};
        OrderIn S{G, bx};
        EpiIn E{(bf16_t*)(ws + WS_QG), (bf16_t*)(ws + WS_KG), (bf16_t*)args.out, (bf16_t*)args.out + (size_t)NTOK * 1024, (bf16_t*)(ws + WS_AO), (bf16_t*)(ws + WS_NK),
                (bf16_t*)(ws + WS_VGT), (bf16_t*)(ws + WS_NVT), args.qn_g, args.kn_g};
        pg8::gemm_phase<EpiIn, OrderIn, true, true>((PG8_LAS unsigned char*)lds, g, S, E);
        }
#endif
    SEAM(1);
    if (IN(2)) {
#if REP_PHASE == 2
        na_phase(args, lds, vcu, G, wave, lane, (bf16_t*)(ws + WS_XW), 1024); xcd_barrier(bar);
#endif
        na_phase(args, lds, vcu, G, wave, lane, (bf16_t*)(ws + WS_AO) + 1024, 2048); }
    SEAM(2);
    if (IN(3)) { prep_phase(args, lds, vcu, G, wave, lane); if (REP_PHASE == 3) { xcd_barrier(bar); prep_phase(args, lds, vcu, G, wave, lane); } }
    SEAM(3);
    if (IN(4)) { scan_phase(args, lds, wave, lane); if (REP_PHASE == 4) { xcd_barrier(bar); scan_phase(args, lds, wave, lane); } }
    SEAM(4);
#ifdef REP_SYNC
    for (int i_ = 0; i_ < REP_SYNC; ++i_) xcd_barrier(bar);
#endif
    if (IN(5)) {
#if REP_PHASE == 5
        combine_phase(args, vcu, G, wave, lane, (bf16_t*)(ws + WS_XW), 1024); xcd_barrier(bar);
#endif
        combine_phase(args, vcu, G, wave, lane, (bf16_t*)(ws + WS_AO), 2048); }
    SEAM(5);
    if (IN(6)) {
        pg8::Gemm g{(const bf16_t*)(ws + WS_AO), (const bf16_t*)(ws + WS_WO), NTOK, DM, 2048};
        pg8::StaticOrder S; S.init(NTOK, DM, G, bx);
        EpiOut E{args.x, args.out};
        pg8::gemm_phase<EpiOut, pg8::StaticOrder, false, true>((PG8_LAS unsigned char*)lds, g, S, E);
        }
#if REP_PHASE == 6 || REP_PHASE == 60
    if (IN(6)) { xcd_barrier(bar);
        pg8::Gemm g{(const bf16_t*)(ws + WS_AO), (const bf16_t*)(ws + WS_WO), NTOK, DM, 2048};
        pg8::StaticOrder S; S.init(NTOK, DM, G, bx);
        EpiOut E{args.x, args.out};
        pg8::gemm_phase<EpiOut, pg8::StaticOrder, false, true>((PG8_LAS unsigned char*)lds, g, S, E);
        }
#endif
#ifdef SCAN_DBG
    if (bx == 0 && tid == 0) { const float* dbg = (const float*)(ws + WS_ZM + 480 * 1024); const float ratio = dbg[0] / dbg[1];
        args.out[0] = (DBG_WHAT == 0) ? (ratio < 0.33f ? 100.f : (ratio < 0.66f ? 200.f : 300.f)) : (dbg[1] < 10000.f ? 100.f : (dbg[1] < 15000.f ? 200.f : (dbg[1] < 20000.f ? 300.f : 400.f))); }
#endif
#ifdef SCAN_DBG
    if (bx == 0 && tid == 0) { const float* dbg = (const float*)(ws + WS_ZM + 480 * 1024);
        const float ratio = (DBG_WHAT == 0 ? dbg[0] : dbg[2]) / dbg[1];
        args.out[0] = (DBG_WHAT == 2) ? 100.f * floorf(dbg[1] * (1.f / 100000.f) + 1.f) : 100.f * (1.f + floorf(ratio * 5.f)); }
#endif
#undef IN
#undef SEAM
}

#ifndef N_LAUNCHES
#define N_LAUNCHES 1
#endif
extern "C" void kernel_launch(void* const* d_in, const int* in_sizes, int n_in, void* d_out, int out_size, void* d_ws, size_t ws_size, hipStream_t stream) {
    static int grid = 0;
    if (grid == 0) {
        if (n_in != 14 || out_size != NTOK * DM || ws_size < WS_END) { fprintf(stderr, "kernel_launch: unexpected problem (n_in %d out %d ws %zu)\n", n_in, out_size, ws_size); grid = -1; return; }
        int dev = 0, cus = 0, per_cu = 0;
        hipGetDevice(&dev); hipDeviceGetAttribute(&cus, hipDeviceAttributeMultiprocessorCount, dev);
        if (hipFuncSetAttribute((const void*)hybrid_fwd, hipFuncAttributeMaxDynamicSharedMemorySize, LDS_BYTES) != hipSuccess) { fprintf(stderr, "kernel_launch: hipFuncSetAttribute failed\n"); grid = -1; return; }
        if (hipOccupancyMaxActiveBlocksPerMultiprocessor(&per_cu, (const void*)hybrid_fwd, NWAVES * 64, LDS_BYTES) != hipSuccess || per_cu < 1) { fprintf(stderr, "kernel_launch: occupancy query gave %d\n", per_cu); per_cu = 1; }
        (void)hipGetLastError();
        grid = cus * per_cu;
        if (grid > 256) grid = 256;
    }
    if (grid < 0) return;
    Args a{};
    a.x = (const float*)d_in[0]; a.meta = (const float*)d_in[1]; a.norm_g = (const float*)d_in[2]; a.w_in = (const float*)d_in[3];
    a.wd_f = (const float*)d_in[4]; a.bd_f = (const float*)d_in[5]; a.wd_b = (const float*)d_in[6]; a.bd_b = (const float*)d_in[7];
    a.gla_g = (const float*)d_in[8]; a.qn_g = (const float*)d_in[9]; a.kn_g = (const float*)d_in[10]; a.rpb = (const float*)d_in[11];
    a.meta_bias = (const float*)d_in[12]; a.w_out = (const float*)d_in[13];
    a.out = (float*)d_out; a.ws = (unsigned char*)d_ws;
    if (hipMemsetAsync((char*)d_ws + WS_CTL, 0, 16384, stream) != hipSuccess) { fprintf(stderr, "kernel_launch: memset of the barrier words failed\n"); return; }
#if N_LAUNCHES == 1
    int lo = 0, hi = 7;
    void* kargs[] = {&a, &lo, &hi};
    hipError_t e = hipLaunchCooperativeKernel((const void*)hybrid_fwd, dim3(grid), dim3(NWAVES * 64), kargs, LDS_BYTES, stream);
    if (e != hipSuccess) fprintf(stderr, "kernel_launch: cooperative launch failed: %s (grid %d)\n", hipGetErrorString(e), grid);
#else
    for (int p = 0; p < 7; ++p) hipLaunchKernelGGL(hybrid_fwd, dim3(grid), dim3(NWAVES * 64), LDS_BYTES, stream, a, p, p + 1);
#endif
}
```

```cpp
#include <hip/hip_runtime.h>
#include <hip/hip_cooperative_groups.h>
#include <cstdio>
#include <cstdint>
namespace cg = cooperative_groups;
namespace pg8 {
#define PG8_LAS __attribute__((address_space(3)))
typedef unsigned short bf16_t;
typedef short bf16x8 __attribute__((ext_vector_type(8)));
typedef float f32x4 __attribute__((ext_vector_type(4)));
typedef unsigned u32x4 __attribute__((ext_vector_type(4)));
constexpr int BM = 256, BK = 64, HALF = 128, HTB = HALF * BK * 2  , STAGE_BYTES = 8 * HTB, NXCD = 8, WGM = 8;

__host__ __device__ __forceinline__ int lds_byte(int r, int c) { const int st = (r >> 4) * 2 + (c >> 5), rr = r & 15, cc = c & 31, ob = rr * 64 + cc * 2; return st * 1024 + (ob ^ (((ob >> 9) & 1) << 5)); }
__host__ __device__ __forceinline__ void stage_rc(int b, int& R, int& C) { const int st = b / 1024, sb = b % 1024, swz = sb ^ (((sb >> 9) & 1) << 5); R = (st >> 1) * 16 + swz / 64; C = (st & 1) * 32 + (swz % 64) / 2; }
__host__ __device__ __forceinline__ int perm32(int rho) { const int n = rho >> 4, i = rho & 15; return 8 * (i >> 2) + 4 * n + (i & 3); }

struct Unit { int pm, pn; };
struct Gemm { const bf16_t* A; const bf16_t* Bt; int M, N, K; };

struct StaticOrder {
    int nM, nN, nwg, G, c;
    __host__ __device__ void init(int M, int N, int G_, int c_) { nM = M / BM; nN = N / BM; nwg = nM * nN; G = G_; c = c_; }
    __host__ __device__ bool next(int i, Unit& u) const {
        const long L = (long)i * G + c; if (L >= nwg) return false;
        int wgid = (int)L; { const int q = nwg / NXCD, r = nwg % NXCD, xcd = wgid % NXCD, off = wgid / NXCD; wgid = (xcd < r ? xcd * (q + 1) : r * (q + 1) + (xcd - r) * q) + off; }
        const int nig = WGM * nN, gid = wgid / nig, fm = gid * WGM, gsz = (nM - fm) < WGM ? (nM - fm) : WGM;
        u.pm = fm + ((wgid % nig) % gsz); u.pn = (wgid % nig) / gsz; return true;
    }
    __device__ __forceinline__ void a_ready(const Unit&) const {}
    __device__ __forceinline__ void done(const Unit&) const {}
};

__device__ __forceinline__ unsigned cvt_pk_bf16(float lo, float hi) { unsigned r; asm volatile("v_cvt_pk_bf16_f32 %0, %1, %2" : "=v"(r) : "v"(lo), "v"(hi)); return r; }
template <class Epi, class Sched, bool ALIGN_EPI = false, bool SP2 = false>
__device__ __forceinline__ void gemm_phase(PG8_LAS unsigned char* lds, const Gemm g, const Sched& S, const Epi& E) {
    const int tid = threadIdx.x, wid = __builtin_amdgcn_readfirstlane(tid >> 6), lane = tid & 63, wr = wid >> 2, wc = wid & 3, fr = lane & 15, fq = lane >> 4;
    const int K = g.K, nt = K / BK;
    unsigned voffA[2], voffB[2];
#pragma unroll
    for (int i = 0; i < 2; ++i) { int R, C; stage_rc(tid * 16 + i * 8192, R, C); const int Rb = Epi::PERM ? ((R & ~31) + perm32(R & 31)) : R;
        voffA[i] = (unsigned)(R * K + C) * 2u; voffB[i] = (unsigned)(Rb * K + C) * 2u; }
    const size_t kstep = (size_t)(BK * 2);
    const size_t hstep = (size_t)HALF * K * 2;
    const size_t tstep = 2 * hstep;
    const unsigned ldsw = (unsigned)wid * 1024u;
    const int aoff = lds_byte(wr * 64 + fr, fq * 8), boff = lds_byte(wc * 32 + fr, fq * 8);
#define PG8_SA(b, h) (((b) * 2 + (h)) * HTB)
#define PG8_SB(b, h) ((4 + (b) * 2 + (h)) * HTB)
#define PG8_STAGE(bufoff, gbase, voff) do { _Pragma("unroll") for (int _i = 0; _i < 2; ++_i) \
        __builtin_amdgcn_global_load_lds((const unsigned*)((const char*)(gbase) + (voff)[_i]), (PG8_LAS unsigned*)(lds + (bufoff) + ldsw + _i * 8192), 16, 0, 0); } while (0)
#define PG8_LDA(dst, b, h) do { _Pragma("unroll") for (int m = 0; m < 4; ++m) _Pragma("unroll") for (int k = 0; k < 2; ++k) dst[m][k] = *(const PG8_LAS bf16x8*)(lds + PG8_SA(b, h) + aoff + m * 2048 + k * 1024); } while (0)
#define PG8_LDB(dst, b, h) do { _Pragma("unroll") for (int n = 0; n < 2; ++n) _Pragma("unroll") for (int k = 0; k < 2; ++k) dst[n][k] = *(const PG8_LAS bf16x8*)(lds + PG8_SB(b, h) + boff + n * 2048 + k * 1024); } while (0)
#define PG8_MMA(ai, bj, At, Bt) do { __builtin_amdgcn_s_setprio(1); _Pragma("unroll") for (int m = 0; m < 4; ++m) _Pragma("unroll") for (int n = 0; n < 2; ++n) _Pragma("unroll") for (int k = 0; k < 2; ++k) \
        acc[ai][bj][m][n] = __builtin_amdgcn_mfma_f32_16x16x32_bf16(Bt[n][k], At[m][k], acc[ai][bj][m][n], 0, 0, 0); __builtin_amdgcn_s_setprio(0); } while (0)
#define PG8_WAIT_V(n) asm volatile("s_waitcnt vmcnt(" #n ")" ::: "memory")
#define PG8_WAIT_L(n) asm volatile("s_waitcnt lgkmcnt(" #n ")" ::: "memory")
#define PG8_BAR __builtin_amdgcn_s_barrier()
#define PG8_SCHED __builtin_amdgcn_sched_barrier(0)
    Unit cur, nxt; int ui = 0;
    if (!S.next(0, cur)) return;
    f32x4 acc[2][2][4][2];
#pragma unroll
    for (int a = 0; a < 2; ++a)
#pragma unroll
        for (int b = 0; b < 2; ++b)
#pragma unroll
            for (int m = 0; m < 4; ++m)
#pragma unroll
                for (int n = 0; n < 2; ++n) acc[a][b][m][n] = (f32x4){0.f, 0.f, 0.f, 0.f};
    bf16x8 At[4][2], B0[2][2], B1[2][2];
    const char* cA = (const char*)g.A + (size_t)cur.pm * tstep; const char* cB = (const char*)g.Bt + (size_t)cur.pn * tstep;
    S.a_ready(cur);
    if constexpr (SP2) {
        PG8_STAGE(PG8_SB(0, 0), cB, voffB); PG8_STAGE(PG8_SB(0, 1), cB + hstep, voffB); PG8_STAGE(PG8_SA(0, 0), cA, voffA); PG8_STAGE(PG8_SA(0, 1), cA + hstep, voffA);
        if (wr == 1) PG8_BAR;
        PG8_WAIT_V(2); PG8_BAR;
        PG8_STAGE(PG8_SB(1, 0), cB + kstep, voffB); PG8_STAGE(PG8_SA(1, 0), cA + kstep, voffA); PG8_STAGE(PG8_SB(1, 1), cB + hstep + kstep, voffB);
        PG8_WAIT_V(6); PG8_BAR;
    } else {
        PG8_STAGE(PG8_SB(0, 0), cB, voffB); PG8_STAGE(PG8_SA(0, 0), cA, voffA); PG8_STAGE(PG8_SB(0, 1), cB + hstep, voffB); PG8_STAGE(PG8_SA(0, 1), cA + hstep, voffA);
        if (wr == 1) PG8_BAR;
        PG8_WAIT_V(4); PG8_BAR;
        PG8_STAGE(PG8_SB(1, 0), cB + kstep, voffB); PG8_STAGE(PG8_SA(1, 0), cA + kstep, voffA); PG8_STAGE(PG8_SB(1, 1), cB + hstep + kstep, voffB);
        PG8_WAIT_V(6); PG8_BAR;
    }
    for (;;) {
        const bool has_next = S.next(ui + 1, nxt);
        const char* nA = has_next ? (const char*)g.A + (size_t)nxt.pm * tstep : cA; const char* nB = has_next ? (const char*)g.Bt + (size_t)nxt.pn * tstep : cB;
        for (int t = 0; t < nt; t += 2) {
            const bool last = (t == nt - 2);
            const char* a1 = cA + (size_t)(t + 1) * kstep;
            const char* a2 = last ? nA : cA + (size_t)(t + 2) * kstep; const char* b2 = last ? nB : cB + (size_t)(t + 2) * kstep;
            const char* a3 = a2 + kstep; const char* b3 = b2 + kstep;
            if (last && has_next) S.a_ready(nxt);
            if constexpr (SP2) {
            PG8_LDB(B0, 0, 0); PG8_LDB(B1, 0, 1); PG8_SCHED; PG8_LDA(At, 0, 0); PG8_STAGE(PG8_SA(1, 1), a1 + hstep, voffA);
            PG8_WAIT_V(8); PG8_WAIT_L(0); PG8_BAR; PG8_MMA(0, 0, At, B0); PG8_MMA(0, 1, At, B1); PG8_BAR; PG8_SCHED;
            PG8_LDA(At, 0, 1); PG8_STAGE(PG8_SB(0, 0), b2, voffB); PG8_STAGE(PG8_SB(0, 1), b2 + hstep, voffB); PG8_STAGE(PG8_SA(0, 0), a2, voffA);
            PG8_WAIT_V(8); PG8_WAIT_L(0); PG8_BAR; PG8_MMA(1, 0, At, B0); PG8_MMA(1, 1, At, B1); PG8_BAR; PG8_SCHED;
            PG8_LDB(B0, 1, 0); PG8_LDB(B1, 1, 1); PG8_SCHED; PG8_LDA(At, 1, 0); PG8_STAGE(PG8_SA(0, 1), a2 + hstep, voffA);
            PG8_WAIT_V(8); PG8_WAIT_L(0); PG8_BAR; PG8_MMA(0, 0, At, B0); PG8_MMA(0, 1, At, B1); PG8_BAR; PG8_SCHED;
            PG8_LDA(At, 1, 1); PG8_STAGE(PG8_SB(1, 0), b3, voffB); PG8_STAGE(PG8_SB(1, 1), b3 + hstep, voffB); PG8_STAGE(PG8_SA(1, 0), a3, voffA);
            PG8_WAIT_V(8); PG8_WAIT_L(0); PG8_BAR; PG8_MMA(1, 0, At, B0); PG8_MMA(1, 1, At, B1); PG8_BAR; PG8_SCHED;
            } else {
            PG8_LDB(B0, 0, 0); PG8_SCHED; PG8_LDA(At, 0, 0); PG8_STAGE(PG8_SA(1, 1), a1 + hstep, voffA);
            PG8_WAIT_L(8); PG8_BAR; PG8_WAIT_L(0); PG8_MMA(0, 0, At, B0); PG8_BAR; PG8_SCHED;
            PG8_LDB(B1, 0, 1); PG8_STAGE(PG8_SB(0, 0), b2, voffB);
            PG8_BAR; PG8_WAIT_L(0); PG8_MMA(0, 1, At, B1); PG8_BAR;
            PG8_LDA(At, 0, 1); PG8_STAGE(PG8_SA(0, 0), a2, voffA);
            PG8_BAR; PG8_WAIT_L(0); PG8_MMA(1, 0, At, B0); PG8_BAR; PG8_SCHED;
            PG8_STAGE(PG8_SB(0, 1), b2 + hstep, voffB);
            PG8_WAIT_V(6); PG8_BAR; PG8_MMA(1, 1, At, B1); PG8_BAR;
            PG8_LDB(B0, 1, 0); PG8_SCHED; PG8_LDA(At, 1, 0); PG8_STAGE(PG8_SA(0, 1), a2 + hstep, voffA);
            PG8_WAIT_L(8); PG8_BAR; PG8_WAIT_L(0); PG8_MMA(0, 0, At, B0); PG8_BAR; PG8_SCHED;
            PG8_LDB(B1, 1, 1); PG8_STAGE(PG8_SB(1, 0), b3, voffB);
            PG8_BAR; PG8_WAIT_L(0); PG8_MMA(0, 1, At, B1); PG8_BAR;
            PG8_LDA(At, 1, 1); PG8_STAGE(PG8_SA(1, 0), a3, voffA);
            PG8_BAR; PG8_WAIT_L(0); PG8_MMA(1, 0, At, B0); PG8_BAR; PG8_SCHED;
            PG8_STAGE(PG8_SB(1, 1), b3 + hstep, voffB);
            PG8_WAIT_V(6); PG8_BAR; PG8_MMA(1, 1, At, B1); PG8_BAR;
            }
        }
        if constexpr (ALIGN_EPI) { if (wr == 0) PG8_BAR; }
        if constexpr (!Epi::AFTER_DRAIN) { E(acc, cur, wr, wc, fr, fq); S.done(cur); }
        if (!has_next) break;
#pragma unroll
        for (int a = 0; a < 2; ++a)
#pragma unroll
            for (int b = 0; b < 2; ++b)
#pragma unroll
                for (int m = 0; m < 4; ++m)
#pragma unroll
                    for (int n = 0; n < 2; ++n) acc[a][b][m][n] = (f32x4){0.f, 0.f, 0.f, 0.f};
        cur = nxt; cA = nA; cB = nB; ++ui;
        if constexpr (ALIGN_EPI) { if (wr == 1) PG8_BAR; }
    }
    PG8_WAIT_V(0);
    if constexpr (!ALIGN_EPI) { if (wr == 0) PG8_BAR; }
    PG8_BAR;
    if constexpr (Epi::AFTER_DRAIN) { E.fused(acc, cur, wr, wc, fr, fq, lds, wid, lane); S.done(cur); }
#undef PG8_SA
#undef PG8_SB
#undef PG8_STAGE
#undef PG8_LDA
#undef PG8_LDB
#undef PG8_MMA
#undef PG8_WAIT_V
#undef PG8_WAIT_L
#undef PG8_BAR
#undef PG8_SCHED
}
}

#define DI __device__ __forceinline__
typedef unsigned short bf16_t;
typedef short bf16x8 __attribute__((ext_vector_type(8)));
typedef float f32x4 __attribute__((ext_vector_type(4)));
typedef float f32x2 __attribute__((ext_vector_type(2)));
typedef float f32x16 __attribute__((ext_vector_type(16)));
typedef unsigned u32x4 __attribute__((ext_vector_type(4)));
typedef unsigned u32x2 __attribute__((ext_vector_type(2)));
typedef __bf16 bf2_t __attribute__((ext_vector_type(2)));

constexpr int NTOK = 16384, SEQ = 8192, DM = 1024, NIN = 7200, NWAVES = 8;
constexpr float RMS_EPS = 1e-6f;
constexpr float LOG2E = 1.4426950408889634f;
constexpr size_t MiB = (size_t)1 << 20;
constexpr size_t WS_ZM = 0, WS_VMT = 512 * 1024, WS_UM = 640 * 1024, WS_WS = 704 * 1024, WS_R = 1 * MiB, WS_WO = 3 * MiB, WS_XW = 8 * MiB,
                 WS_AO = 54 * MiB, WS_NK = 118 * MiB, WS_NVT = 150 * MiB, WS_VGT = 182 * MiB, WS_QG = 214 * MiB, WS_KG = 230 * MiB, WS_OB = 214 * MiB,
                 WS_PKF = WS_XW, WS_PKB = WS_NK, WS_CTL = 246 * MiB, WS_END = 247 * MiB;
constexpr int PK_BYTES = 41472;
constexpr int PK_A_OFF = 40960;
constexpr int LDS_BYTES = 163840;

DI unsigned pk2(float lo, float hi) { f32x2 v = {lo, hi}; bf2_t b = __builtin_convertvector(v, bf2_t); return __builtin_bit_cast(unsigned, b); }
DI float bf2f(bf16_t u) { return __uint_as_float(((unsigned)u) << 16); }
DI float wave_sum(float v) {
#pragma unroll
    for (int o = 1; o < 64; o <<= 1) v += __shfl_xor(v, o);
    return v;
}
DI float silu_f(float x) { return x * __builtin_amdgcn_rcpf(1.f + __expf(-x)); }
DI int crow(int reg, int h) { return (reg & 3) + 8 * (reg >> 2) + 4 * h; }
#define MFMA32(a, b, c) __builtin_amdgcn_mfma_f32_32x32x16_bf16((a), (b), (c), 0, 0, 0)
#define MFMA16(a, b, c) __builtin_amdgcn_mfma_f32_16x16x32_bf16((a), (b), (c), 0, 0, 0)

struct Args {
    const float *x, *meta, *norm_g, *w_in, *wd_f, *bd_f, *wd_b, *bd_b, *gla_g, *qn_g, *kn_g, *rpb, *meta_bias, *w_out;
    float* out; unsigned char* ws;
};

DI int phys_norm(int wt, int lc) { return 256 * wt + 128 * ((lc >> 5) & 1) + 32 * (lc >> 6) + (lc & 31); }

DI void p0_transpose_item(const float* W, int ldw, int k0, int n0, bf16_t* WT, int ldwt, int row0, float* scr, int lane) {
#pragma unroll 8
    for (int i = 0; i < 32; ++i) { const int kk = 2 * i + (lane >> 5); scr[kk * 33 + (lane & 31)] = W[(size_t)(k0 + kk) * ldw + n0 + (lane & 31)]; }
    asm volatile("s_waitcnt lgkmcnt(0)" ::: "memory");
    const int c = lane & 7;
#pragma unroll
    for (int j = 0; j < 4; ++j) { const int n = (lane >> 3) + 8 * j; const float* s = scr + (8 * c) * 33 + n;
        u32x4 o; o.x = pk2(s[0 * 33], s[1 * 33]); o.y = pk2(s[2 * 33], s[3 * 33]); o.z = pk2(s[4 * 33], s[5 * 33]); o.w = pk2(s[6 * 33], s[7 * 33]);
        *(u32x4*)(WT + (size_t)(row0 + n) * ldwt + k0 + 8 * c) = o; }
    asm volatile("s_waitcnt lgkmcnt(0)" ::: "memory");
}
DI int wt_base(int wt) {
    if (wt < 2) return 0 + 256 * wt;
    if (wt < 4) return 512 + 256 * (wt - 2);
    if (wt < 8) return 2080 + 256 * (wt - 4);
    if (wt < 12) return 3104 + 256 * (wt - 8);
    if (wt < 16) return 4128 + 256 * (wt - 12);
    if (wt < 20) return 6176 + 256 * (wt - 16);
    if (wt < 24) return 1024 + 256 * (wt - 20);
    return 5152 + 256 * (wt - 24);
}
DI void rms_row_to_bf16(const float* xrow, const float* g, bf16_t* orow, int lane) {
    const f32x4* xr = (const f32x4*)xrow + lane; const f32x4* gr = (const f32x4*)g + lane;
    f32x4 v[4]; float s = 0.f;
#pragma unroll
    for (int j = 0; j < 4; ++j) { v[j] = xr[64 * j]; s += (v[j].x * v[j].x + v[j].y * v[j].y) + (v[j].z * v[j].z + v[j].w * v[j].w); }
    const float rstd = 1.0f / sqrtf(wave_sum(s) * (1.f / DM) + RMS_EPS);
    unsigned long long* o8 = (unsigned long long*)orow + lane;
#pragma unroll
    for (int j = 0; j < 4; ++j) { const f32x4 gg = gr[64 * j];
        o8[64 * j] = (unsigned long long)pk2(v[j].x * rstd * gg.x, v[j].y * rstd * gg.y) | ((unsigned long long)pk2(v[j].z * rstd * gg.z, v[j].w * rstd * gg.w) << 32); }
}
DI void p0_block_item(const float* W, int ldw, int k0, int n0, bool perm, bf16_t* WT, int ldwt, int row0, float* T  , int tid) {
    f32x4 v[8];
#pragma unroll
    for (int i = 0; i < 8; ++i) { const int e = tid + 512 * i, kk = e >> 6, c4 = e & 63; v[i] = *(const f32x4*)(W + (size_t)(k0 + kk) * ldw + n0 + 4 * c4); }
#pragma unroll
    for (int i = 0; i < 8; ++i) { const int e = tid + 512 * i, kk = e >> 6, c4 = e & 63; float* t = T + kk * 257 + 4 * c4; t[0] = v[i][0]; t[1] = v[i][1]; t[2] = v[i][2]; t[3] = v[i][3]; }
    __syncthreads();
    { const int pp = tid >> 1, kh = tid & 1; const int lc = perm ? (64 * ((pp >> 5) & 3) + 32 * (pp >> 7) + (pp & 31)) : pp;
      const float* t = T + (32 * kh) * 257 + lc;
      unsigned w[16];
#pragma unroll
      for (int j = 0; j < 16; ++j) w[j] = pk2(t[(2 * j) * 257], t[(2 * j + 1) * 257]);
      u32x4* dst = (u32x4*)(WT + (size_t)(row0 + pp) * ldwt + k0 + 32 * kh);
#pragma unroll
      for (int j = 0; j < 4; ++j) dst[j] = (u32x4){w[4 * j], w[4 * j + 1], w[4 * j + 2], w[4 * j + 3]}; }
    __syncthreads();
}
DI void rms_rows2_to_bf16(const float* x0, const float* x1, const float* g, bf16_t* o0, bf16_t* o1, int lane) {
    const f32x4* xa = (const f32x4*)x0 + lane; const f32x4* xb = (const f32x4*)x1 + lane; const f32x4* gr = (const f32x4*)g + lane;
    f32x4 va[4], vb[4]; float sa = 0.f, sb2 = 0.f;
#pragma unroll
    for (int j = 0; j < 4; ++j) { va[j] = xa[64 * j]; vb[j] = xb[64 * j]; }
#pragma unroll
    for (int j = 0; j < 4; ++j) { sa += (va[j].x * va[j].x + va[j].y * va[j].y) + (va[j].z * va[j].z + va[j].w * va[j].w); sb2 += (vb[j].x * vb[j].x + vb[j].y * vb[j].y) + (vb[j].z * vb[j].z + vb[j].w * vb[j].w); }
    const float ra = 1.0f / sqrtf(wave_sum(sa) * (1.f / DM) + RMS_EPS), rb = 1.0f / sqrtf(wave_sum(sb2) * (1.f / DM) + RMS_EPS);
    unsigned long long* oa = (unsigned long long*)o0 + lane; unsigned long long* ob = (unsigned long long*)o1 + lane;
#pragma unroll
    for (int j = 0; j < 4; ++j) { const f32x4 gg = gr[64 * j];
        oa[64 * j] = (unsigned long long)pk2(va[j].x * ra * gg.x, va[j].y * ra * gg.y) | ((unsigned long long)pk2(va[j].z * ra * gg.z, va[j].w * ra * gg.w) << 32);
        ob[64 * j] = (unsigned long long)pk2(vb[j].x * rb * gg.x, vb[j].y * rb * gg.y) | ((unsigned long long)pk2(vb[j].z * rb * gg.z, vb[j].w * rb * gg.w) << 32); }
}
DI void p0_phase(const Args& a, unsigned char* lds, int vcu, int G, int wave, int lane) {
    unsigned char* ws = a.ws;
    bf16_t* XW = (bf16_t*)(ws + WS_XW); bf16_t* WSs = (bf16_t*)(ws + WS_WS); bf16_t* WO = (bf16_t*)(ws + WS_WO); bf16_t* UM = (bf16_t*)(ws + WS_UM);
    const int gw = vcu * NWAVES + wave, NGW = G * NWAVES, tid = wave * 64 + lane;
    for (int it = vcu; it < 448 + 128; it += G) {
        if (it < 448) { const int kb = it / 28, wt = it % 28; p0_block_item(a.w_in, NIN, 64 * kb, wt_base(wt), wt < 20, XW, DM, NTOK + 256 * wt, (float*)lds, tid); }
        else { const int r = it - 448, kb = r >> 2, nb = r & 3; p0_block_item(a.w_out, DM, 64 * kb, 256 * nb, false, WO, 2048, 256 * nb, (float*)lds, tid); }
    }
    { float* scr = (float*)(lds + wave * 16384);
      for (int it = gw; it < 16; it += NGW) p0_transpose_item(a.w_in, NIN, 64 * it, 2048, WSs, DM, 0, scr, lane); }
    for (int m = 2 * gw; m < NTOK; m += 2 * NGW) rms_rows2_to_bf16(a.x + (size_t)m * DM, a.x + (size_t)(m + 1) * DM, a.norm_g, XW + (size_t)m * DM, XW + (size_t)(m + 1) * DM, lane);
    for (int m = gw; m < 16; m += NGW) rms_row_to_bf16(a.meta + (size_t)m * DM, a.norm_g, UM + (size_t)m * DM, lane);
}

DI void skinny_task(const bf16_t* A, const bf16_t* B, float* O, int ldo, int lane) {
    const int r = lane & 15, q = lane >> 4;
    const bf16x8* ap = (const bf16x8*)(A + (size_t)r * DM + 8 * q);
    const bf16x8* b0 = (const bf16x8*)(B + (size_t)r * DM + 8 * q);
    const bf16x8* b1 = (const bf16x8*)(B + (size_t)(16 + r) * DM + 8 * q);
    f32x4 acc0 = {0.f, 0.f, 0.f, 0.f}, acc1 = {0.f, 0.f, 0.f, 0.f};
#pragma unroll
    for (int kh = 0; kh < 2; ++kh) {
        bf16x8 av[16], bv0[16], bv1[16];
#pragma unroll
        for (int ks = 0; ks < 16; ++ks) { av[ks] = ap[4 * (16 * kh + ks)]; bv0[ks] = b0[4 * (16 * kh + ks)]; bv1[ks] = b1[4 * (16 * kh + ks)]; }
#pragma unroll
        for (int ks = 0; ks < 16; ++ks) { acc0 = MFMA16(av[ks], bv0[ks], acc0); acc1 = MFMA16(av[ks], bv1[ks], acc1); }
    }
#pragma unroll
    for (int i = 0; i < 4; ++i) { O[(size_t)(4 * q + i) * ldo + r] = acc0[i]; O[(size_t)(4 * q + i) * ldo + 16 + r] = acc1[i]; }
}
DI void p1_skinny(const Args& a, int vcu, int G, int wave, int lane) {
    unsigned char* ws = a.ws;
    const bf16_t* XW = (const bf16_t*)(ws + WS_XW); const bf16_t* WSs = (const bf16_t*)(ws + WS_WS); const bf16_t* UM = (const bf16_t*)(ws + WS_UM);
    float* R = (float*)(ws + WS_R); float* ZM = (float*)(ws + WS_ZM);
    const int gw = vcu * NWAVES + wave, NGW = G * NWAVES;
    for (int t = gw; t < 1024 + 225; t += NGW) {
        if (t < 1024) skinny_task(XW + (size_t)t * 16 * DM, WSs, R + (size_t)t * 16 * 32, 32, lane);
        else { const int c = t - 1024;
            if (c < 224) skinny_task(UM, XW + (size_t)(NTOK + 32 * c) * DM, ZM + 32 * c, NIN, lane);
            else skinny_task(UM, WSs, ZM + 7168, NIN, lane); }
    }
}

struct OrderIn {
    int G, c;
    DI bool next(int i, pg8::Unit& u) const {
        const long L = (long)i * G + c; if (L >= 1792) return false;
        const int ii = (int)(L >> 8), cc = (int)(L & 255), xcd = cc & 7, j = cc >> 3, tok = 8 * xcd + (j & 7), w4 = j >> 3;
        if (ii < 5) { u.pm = tok; u.pn = 64 + 4 * ii + w4; } else { u.pm = 64 + 20 + 4 * (ii - 5) + w4; u.pn = tok; }
        return true;
    }
    DI void a_ready(const pg8::Unit&) const {}
    DI void done(const pg8::Unit&) const {}
};

struct EpiIn {
    static constexpr bool PERM = true, AFTER_DRAIN = false;
    bf16_t *QG, *KG, *GG, *NGt, *AO, *NK, *VGT, *NVT; const float *qn_g, *kn_g;
    DI void operator()(const f32x4 (&acc)[2][2][4][2], const pg8::Unit& u, int wr, int wc, int fr, int fq) const {
        if (u.pm < 64) {
            const int wt = u.pn - 64;
            const int row0 = u.pm * 256 + wr * 64 + fr;
            if (wt < 8 || wt >= 16) {
                bf16_t* base; int ld; float sc = 1.f; bool act = false;
                if (wt < 2) { base = QG + 256 * wt; ld = 512; sc = 0.08838834764831845f; }
                else if (wt < 4) { base = KG + 256 * (wt - 2); ld = 512; }
                else if (wt < 8) { base = GG + 256 * (wt - 4); ld = 1024; act = true; }
                else { base = NGt + 256 * (wt - 16); ld = 1024; act = true; }
#pragma unroll
                for (int ai = 0; ai < 2; ++ai)
#pragma unroll
                    for (int m = 0; m < 4; ++m) { bf16_t* rowp = base + (size_t)(row0 + ai * 128 + m * 16) * ld + 64 * wc + 8 * fq;
#pragma unroll
                        for (int bj = 0; bj < 2; ++bj) { f32x4 v0 = acc[ai][bj][m][0], v1 = acc[ai][bj][m][1];
                            if (act) { v0 = (f32x4){silu_f(v0[0]), silu_f(v0[1]), silu_f(v0[2]), silu_f(v0[3])}; v1 = (f32x4){silu_f(v1[0]), silu_f(v1[1]), silu_f(v1[2]), silu_f(v1[3])}; }
                            v0 = v0 * sc; v1 = v1 * sc;
                            u32x4 w; w.x = pk2(v0[0], v0[1]); w.y = pk2(v0[2], v0[3]); w.z = pk2(v1[0], v1[1]); w.w = pk2(v1[2], v1[3]);
                            *(u32x4*)(rowp + 32 * bj) = w; } }
            } else {
                const bool isq = wt < 12; const float* g = isq ? qn_g : kn_g; const float gs = isq ? (0.125f * LOG2E) : 1.0f;
                const int kb_ = u.pm >> 5, kgrow_ = (u.pm & 31) * 4 + wr;
                bf16_t* base = isq ? (AO + 1024 + 256 * (wt - 8)) : (NK + ((size_t)((kb_ * 16 + 4 * (wt - 12) + wc) * 128 + kgrow_) * 4096)); const int ld = isq ? 2048 : 1024;
                f32x4 gv[2][2];
#pragma unroll
                for (int bj = 0; bj < 2; ++bj)
#pragma unroll
                    for (int n = 0; n < 2; ++n) gv[bj][n] = *(const f32x4*)(g + 32 * bj + 8 * fq + 4 * n) * gs;
#pragma unroll
                for (int ai = 0; ai < 2; ++ai)
#pragma unroll
                    for (int m = 0; m < 4; ++m) {
                        float ss = 0.f;
#pragma unroll
                        for (int bj = 0; bj < 2; ++bj)
#pragma unroll
                            for (int n = 0; n < 2; ++n) { const f32x4 v = acc[ai][bj][m][n]; ss += (v[0] * v[0] + v[1] * v[1]) + (v[2] * v[2] + v[3] * v[3]); }
                        ss += __shfl_xor(ss, 16); ss += __shfl_xor(ss, 32);
                        const float rstd = 1.0f / sqrtf(ss * (1.f / 64.f) + RMS_EPS);
                        bf16_t* rowp = isq ? (base + (size_t)(row0 + ai * 128 + m * 16) * ld + 64 * wc + 8 * fq) : (base + (size_t)ai * 2 * 4096 + (m * 16 + fr) * 64 + 8 * fq);
#pragma unroll
                        for (int bj = 0; bj < 2; ++bj) { const f32x4 v0 = acc[ai][bj][m][0] * rstd * gv[bj][0], v1 = acc[ai][bj][m][1] * rstd * gv[bj][1];
                            u32x4 w; w.x = pk2(v0[0], v0[1]); w.y = pk2(v0[2], v0[3]); w.z = pk2(v1[0], v1[1]); w.w = pk2(v1[2], v1[3]);
                            *(u32x4*)(rowp + 32 * bj) = w; }
                    }
            }
        } else {
            const int wt = u.pm - 64;
            if (wt < 24) {
                const int bb = u.pn >> 5, cbase = (u.pn & 31) * 4 + (wc >> 1), ksb = (wc & 1) * 2;
                bf16_t* lp = VGT + ((fq & 1) * 32 + fr) * 8 + (fq >> 1) * 512;
#pragma unroll
                for (int ai = 0; ai < 2; ++ai)
#pragma unroll
                    for (int m = 0; m < 4; ++m)
#pragma unroll
                        for (int bj = 0; bj < 2; ++bj) { const f32x4 v0 = acc[ai][bj][m][0], v1 = acc[ai][bj][m][1];
                            u32x4 w; w.x = pk2(v0[0], v0[1]); w.y = pk2(v0[2], v0[3]); w.z = pk2(v1[0], v1[1]); w.w = pk2(v1[2], v1[3]);
                            const int frag = (((bb * 4 + (wt - 20)) * 128 + cbase + 2 * bj) * 8 + wr * 2 + ai * 4 + (m >> 1)) * 4 + ksb;
                            *(u32x4*)(lp + (size_t)frag * 512 + (m & 1) * 128) = w; }
            } else {
                const int vb_ = u.pn >> 5, vgrow_ = (u.pn & 31) * 4 + (wc >> 1);
                bf16_t* lp = NVT + fr * 64 + (wc & 1) * 32 + 8 * fq;
#pragma unroll
                for (int ai = 0; ai < 2; ++ai)
#pragma unroll
                    for (int m = 0; m < 4; ++m)
#pragma unroll
                        for (int bj = 0; bj < 2; ++bj) { const f32x4 v0 = acc[ai][bj][m][0], v1 = acc[ai][bj][m][1];
                            u32x4 w; w.x = pk2(v0[0], v0[1]); w.y = pk2(v0[2], v0[3]); w.z = pk2(v1[0], v1[1]); w.w = pk2(v1[2], v1[3]);
                            const int slab = (vb_ * 16 + 4 * (wt - 24) + 2 * ai + wr) * 128 + vgrow_ + 2 * bj;
                            *(u32x4*)(lp + (size_t)slab * 4096 + m * 16 * 64) = w; }
            }
        }
    }
};

struct EpiOut {
    static constexpr bool PERM = false, AFTER_DRAIN = false;
    const float* x; float* out;
    DI void operator()(const f32x4 (&acc)[2][2][4][2], const pg8::Unit& u, int wr, int wc, int fr, int fq) const {
        const int row0 = u.pm * 256 + wr * 64 + fr, col0 = u.pn * 256 + wc * 32 + 4 * fq;
#pragma unroll
        for (int ai = 0; ai < 2; ++ai)
#pragma unroll
            for (int m = 0; m < 4; ++m) { const size_t off = (size_t)(row0 + ai * 128 + m * 16) * DM + col0;
#pragma unroll
                for (int bj = 0; bj < 2; ++bj)
#pragma unroll
                    for (int n = 0; n < 2; ++n) { const f32x4 xs = *(const f32x4*)(x + off + bj * 128 + n * 16); *(f32x4*)(out + off + bj * 128 + n * 16) = xs + acc[ai][bj][m][n]; } }
    }
};

constexpr int NA_SLOT = 16384, NA_NSLOT = 9, NA_KM = NA_NSLOT * NA_SLOT, NA_VM = NA_KM + 2048, NA_RPB = NA_VM + 2048, NA_MB = NA_RPB + 1920;
#define NA_BAR() do { asm volatile("s_waitcnt lgkmcnt(0)" ::: "memory"); __builtin_amdgcn_s_barrier(); asm volatile("" ::: "memory"); } while (0)
DI void na_stage_row(const bf16_t* kslab, const bf16_t* vslab, unsigned char* slot, int lw, int lane) {
#pragma unroll
    for (int i = 0; i < 2; ++i) { const int piece = 2 * lw + i, P = 64 * piece + lane, line = P >> 4, pos = P & 15;
        { const int b0 = ((pos >> 3) & 1) ^ (line & 1), uu = (pos & 7) ^ (4 * b0 + ((line >> 2) & 3)), key = 2 * line + b0;
          __builtin_amdgcn_global_load_lds((const unsigned*)(kslab + key * 64 + uu * 8), (PG8_LAS unsigned*)(slot + piece * 1024), 16, 0, 0); }
        { const int x = pos ^ (line & 7), d = 2 * line + (x >> 3), uk = x & 7;
          __builtin_amdgcn_global_load_lds((const unsigned*)(vslab + d * 64 + uk * 8), (PG8_LAS unsigned*)(slot + 8192 + piece * 1024), 16, 0, 0); } }
}
DI int na_rs(int r) { int rs = r - 4; return rs < 0 ? 0 : (rs > 120 ? 120 : rs); }
DI void na_phase(const Args& a, unsigned char* lds, int vcu, int G, int wave, int lane, bf16_t* ODST, int ostride) {
    unsigned char* ws = a.ws;
    const float* ZM = (const float*)(ws + WS_ZM);
    bf16_t* AO = (bf16_t*)(ws + WS_AO); const bf16_t* NKP = (const bf16_t*)(ws + WS_NK); const bf16_t* NVP = (const bf16_t*)(ws + WS_NVT);
    const bf16_t* NGt = (const bf16_t*)a.out + (size_t)NTOK * 1024;
    bf16_t* KM = (bf16_t*)(lds + NA_KM); bf16_t* VM = (bf16_t*)(lds + NA_VM); float* RPB = (float*)(lds + NA_RPB); float* MB = (float*)(lds + NA_MB);
    const int tid = wave * 64 + lane;
    for (int task = vcu; task < 256; task += G) {
        const int b = task >> 7, h = (task >> 3) & 15, r0 = (task & 7) * 16;
        const bf16_t* kbase = NKP + (size_t)((b * 16 + h) * 128) * 4096; const bf16_t* vbase = NVP + (size_t)((b * 16 + h) * 128) * 4096;
        for (int m = wave; m < 16; m += NWAVES) { const int d = lane;
            const float v = ZM[(size_t)m * NIN + 256 * (12 + (h >> 2)) + 128 * (d >> 5) + 32 * (h & 3) + (d & 31)];
            const float rstd = 1.0f / sqrtf(wave_sum(v * v) * (1.f / 64.f) + RMS_EPS);
            KM[m * 64 + d] = (bf16_t)(pk2(v * rstd * a.kn_g[d], 0.f) & 0xffffu); }
        for (int e = tid; e < 1024; e += 512) { const int m = e & 15, d = e >> 4;
            VM[e] = (bf16_t)(pk2(ZM[(size_t)m * NIN + 256 * (24 + (h >> 2)) + 64 * (h & 3) + d], 0.f) & 0xffffu); }
        if (tid < 465) RPB[tid] = a.rpb[h * 465 + tid] * LOG2E;
        if (tid < 16) MB[tid] = a.meta_bias[h * 16 + tid] * LOG2E;
        const int lo = na_rs(r0);
        if (wave >= 4) {
            const int lw = wave - 4;
            for (int x = lo; x < lo + 8; ++x) na_stage_row(kbase + (size_t)x * 4096, vbase + (size_t)x * 4096, lds + (x % NA_NSLOT) * NA_SLOT, lw, lane);
            asm volatile("s_waitcnt vmcnt(0)" ::: "memory");
            NA_BAR();
            for (int r = r0; r < r0 + 16; ++r) {
                if (r + 1 < r0 + 16 && na_rs(r + 1) > na_rs(r)) { const int x = na_rs(r + 1) + 7;
                    na_stage_row(kbase + (size_t)x * 4096, vbase + (size_t)x * 4096, lds + (x % NA_NSLOT) * NA_SLOT, lw, lane); }
                asm volatile("s_waitcnt vmcnt(0)" ::: "memory");
                NA_BAR();
            }
            continue;
        }
        const int n = lane & 15, q4 = lane >> 4, qt = wave;
        const int c0 = (qt == 0) ? 0 : (qt == 1) ? 8 : (qt == 2) ? 24 : 32;
        const int qc = 16 * qt + n;
        int cs = qc - 8; cs = cs < 0 ? 0 : (cs > 48 ? 48 : cs);
        bf16x8 qf[2], qn[2];
        { const size_t qtok = (size_t)b * SEQ + r0 * 64 + qc;
#pragma unroll
          for (int ks = 0; ks < 2; ++ks) qf[ks] = *(const bf16x8*)(AO + qtok * 2048 + 1024 + h * 64 + 32 * ks + 8 * q4); }
        int koff[2][2];
#pragma unroll
        for (int t = 0; t < 2; ++t) { const int key = c0 + 8 * (n >> 2) + 4 * t + (n & 3); const int f = ((key & 3) << 2) | ((key >> 3) & 3);
#pragma unroll
            for (int ks = 0; ks < 2; ++ks) koff[t][ks] = ((key >> 1) * 16 + ((((key & 1) * 8) + 4 * ks + q4) ^ f)) * 16; }
        int voff[4];
#pragma unroll
        for (int dt = 0; dt < 4; ++dt) { const int d = 16 * dt + n, uk = (c0 >> 3) + q4; voff[dt] = 8192 + ((d >> 1) * 16 + ((((d & 1) * 8) + uk) ^ ((d >> 1) & 7))) * 16; }
        float madd[2][4]; int boff[2][4];
#pragma unroll
        for (int t = 0; t < 2; ++t)
#pragma unroll
            for (int i = 0; i < 4; ++i) { const int kc = c0 + 8 * q4 + 4 * t + i; const bool valid = (kc >= cs) && (kc < cs + 16);
                int dcol = kc - qc + 15; dcol = dcol < 0 ? 0 : (dcol > 30 ? 30 : dcol); madd[t][i] = valid ? 0.f : -1e30f; boff[t][i] = dcol * 4; }
        NA_BAR();
        for (int r = r0; r < r0 + 16; ++r) {
            const int rs = na_rs(r);
            const size_t qtok = (size_t)b * SEQ + r * 64 + qc;
            if (r + 1 < r0 + 16) {
#pragma unroll
                for (int ks = 0; ks < 2; ++ks) qn[ks] = *(const bf16x8*)(AO + (qtok + 64) * 2048 + 1024 + h * 64 + 32 * ks + 8 * q4);
            }
            u32x2 gw[4];
#pragma unroll
            for (int dt = 0; dt < 4; ++dt) gw[dt] = *(const u32x2*)(NGt + qtok * 1024 + h * 64 + 16 * dt + 4 * q4);
            f32x4 sc[17];
#pragma unroll
            for (int kr = 0; kr < 8; ++kr) {
                const unsigned char* slot = lds + ((rs + kr) % NA_NSLOT) * NA_SLOT;
#pragma unroll
                for (int t = 0; t < 2; ++t) {
                    const bf16x8 k0 = *(const bf16x8*)(slot + koff[t][0]);
                    const bf16x8 k1 = *(const bf16x8*)(slot + koff[t][1]);
                    f32x4 z = {0.f, 0.f, 0.f, 0.f};
                    z = MFMA16(k0, qf[0], z); z = MFMA16(k1, qf[1], z);
                    sc[2 * kr + t] = z;
                }
            }
            {
                const bf16x8 k0 = *(const bf16x8*)(KM + n * 64 + 8 * q4);
                const bf16x8 k1 = *(const bf16x8*)(KM + n * 64 + 32 + 8 * q4);
                f32x4 z = {0.f, 0.f, 0.f, 0.f};
                z = MFMA16(k0, qf[0], z); z = MFMA16(k1, qf[1], z);
                sc[16] = z;
            }
            float mx = -1e30f;
            const unsigned char* rpb0 = (const unsigned char*)RPB + (rs - r + 7) * 124;
#pragma unroll
            for (int kr = 0; kr < 8; ++kr) {
#pragma unroll
                for (int t = 0; t < 2; ++t)
#pragma unroll
                    for (int i = 0; i < 4; ++i) {
                        const float bias = *(const float*)(rpb0 + kr * 124 + boff[t][i]);
                        const float sv = sc[2 * kr + t][i] + (bias + madd[t][i]);
                        sc[2 * kr + t][i] = sv; mx = fmaxf(mx, sv);
                    }
            }
#pragma unroll
            for (int i = 0; i < 4; ++i) { const float sv = sc[16][i] + MB[4 * q4 + i]; sc[16][i] = sv; mx = fmaxf(mx, sv); }
            mx = fmaxf(mx, __shfl_xor(mx, 16)); mx = fmaxf(mx, __shfl_xor(mx, 32));
            float sum = 0.f;
#pragma unroll
            for (int j = 0; j < 17; ++j)
#pragma unroll
                for (int i = 0; i < 4; ++i) { const float pp = __builtin_amdgcn_exp2f(sc[j][i] - mx); sc[j][i] = pp; sum += pp; }
            sum += __shfl_xor(sum, 16); sum += __shfl_xor(sum, 32);
            const float inv = 1.0f / sum;
            f32x4 o[4];
#pragma unroll
            for (int dt = 0; dt < 4; ++dt) o[dt] = (f32x4){0.f, 0.f, 0.f, 0.f};
#pragma unroll
            for (int kr = 0; kr < 8; ++kr) {
                const unsigned char* slot = lds + ((rs + kr) % NA_NSLOT) * NA_SLOT;
                u32x4 pw; pw.x = pk2(sc[2 * kr][0], sc[2 * kr][1]); pw.y = pk2(sc[2 * kr][2], sc[2 * kr][3]); pw.z = pk2(sc[2 * kr + 1][0], sc[2 * kr + 1][1]); pw.w = pk2(sc[2 * kr + 1][2], sc[2 * kr + 1][3]);
                const bf16x8 pf = __builtin_bit_cast(bf16x8, pw);
#pragma unroll
                for (int dt = 0; dt < 4; ++dt) { const bf16x8 vf = *(const bf16x8*)(slot + voff[dt]); o[dt] = MFMA16(vf, pf, o[dt]); }
            }
            {
                u32x4 pw; pw.x = pk2(sc[16][0], sc[16][1]); pw.y = pk2(sc[16][2], sc[16][3]); pw.z = 0u; pw.w = 0u;
                const bf16x8 pf = __builtin_bit_cast(bf16x8, pw);
#pragma unroll
                for (int dt = 0; dt < 4; ++dt) {
                    const u32x2 lo2 = *(const u32x2*)(VM + ((16 * dt + n) * 16 + 4 * q4));
                    u32x4 vw; vw.x = lo2.x; vw.y = lo2.y; vw.z = 0u; vw.w = 0u;
                    o[dt] = MFMA16(__builtin_bit_cast(bf16x8, vw), pf, o[dt]);
                }
            }
#pragma unroll
            for (int dt = 0; dt < 4; ++dt) {
                const int d0 = h * 64 + 16 * dt + 4 * q4;
                const float g0 = __uint_as_float(gw[dt].x << 16), g1 = __uint_as_float(gw[dt].x & 0xffff0000u), g2 = __uint_as_float(gw[dt].y << 16), g3 = __uint_as_float(gw[dt].y & 0xffff0000u);
                u32x2 w; w.x = pk2(o[dt][0] * inv * g0, o[dt][1] * inv * g1); w.y = pk2(o[dt][2] * inv * g2, o[dt][3] * inv * g3);
                *(u32x2*)(ODST + qtok * ostride + d0) = w;
            }
            qf[0] = qn[0]; qf[1] = qn[1];
            NA_BAR();
        }
    }
}

constexpr int PREP_LD = 136;
constexpr int PREP_TILE = 64 * PREP_LD * 2;
constexpr int PREP_R = 4 * PREP_TILE, PREP_PART = PREP_R + 8192;
DI float logsig16(float x) { return (fminf(x, 0.f) - __logf(1.f + __expf(-fabsf(x)))) * (1.f / 16.f); }
DI int phys_gk(int c) { return phys_norm(2 + (c >> 8), c & 255); }
DI void prep_phase(const Args& a, unsigned char* lds, int vcu, int G, int wave, int lane) {
    unsigned char* ws = a.ws;
    const float* ZM = (const float*)(ws + WS_ZM); const float* R = (const float*)(ws + WS_R);
    const bf16_t* QG = (const bf16_t*)(ws + WS_QG); const bf16_t* KG = (const bf16_t*)(ws + WS_KG);
    unsigned char* PKF = ws + WS_PKF; unsigned char* PKB = ws + WS_PKB; bf16_t* VMT = (bf16_t*)(ws + WS_VMT);
    const int tid = wave * 64 + lane;
    bf16_t* T_QF = (bf16_t*)(lds); bf16_t* T_KF = (bf16_t*)(lds + PREP_TILE); bf16_t* T_QB = (bf16_t*)(lds + 2 * PREP_TILE); bf16_t* T_KB = (bf16_t*)(lds + 3 * PREP_TILE);
    float* RS = (float*)(lds + PREP_R); float* PART = (float*)(lds + PREP_PART);
    for (int task = vcu; task < 1024 + 8; task += G) {
        if (task >= 1024) {
            const int mt = task - 1024, b = mt >> 2, h = mt & 3;
            unsigned char* pk = PKF + (size_t)((b * 4 + h) * 129) * PK_BYTES;
            for (int p = tid; p < PK_BYTES / 16; p += 512) *(u32x4*)(pk + p * 16) = (u32x4){0u, 0u, 0u, 0u};
            __syncthreads();
            if (tid < 128) { const int d = tid;
                float wd[16];
#pragma unroll
                for (int k = 0; k < 16; ++k) wd[k] = a.wd_f[k * 512 + h * 128 + d];
                const float bd = a.bd_f[h * 128 + d];
                float G_[16]; float run = 0.f;
#pragma unroll
                for (int m = 0; m < 16; ++m) { float dot = bd;
#pragma unroll
                    for (int k = 0; k < 16; ++k) dot += ZM[(size_t)m * NIN + 7168 + k] * wd[k];
                    run += logsig16(dot); G_[m] = run; }
                unsigned kw[8];
#pragma unroll
                for (int m = 0; m < 16; m += 2) { const float k0 = ZM[(size_t)m * NIN + phys_gk(h * 128 + d)] * __expf(run - G_[m]);
                    const float k1 = ZM[(size_t)(m + 1) * NIN + phys_gk(h * 128 + d)] * __expf(run - G_[m + 1]); kw[m >> 1] = pk2(k0, k1); }
                const int dt = d >> 5, r = d & 31;
                *(u32x4*)(pk + (dt * 4 + 3) * 1024 + (0 * 32 + r) * 16) = (u32x4){kw[0], kw[1], kw[2], kw[3]};
                *(u32x4*)(pk + (dt * 4 + 3) * 1024 + (1 * 32 + r) * 16) = (u32x4){kw[4], kw[5], kw[6], kw[7]};
                *(float*)(pk + PK_A_OFF + d * 4) = 1.0f;
            }
            if (b == 0 && tid < 256) { const int v = tid; const int c = h * 256 + v; bf16_t* row = VMT + (size_t)c * 64;
                for (int j = 0; j < 48; j += 8) *(u32x4*)(row + j) = (u32x4){0u, 0u, 0u, 0u};
                unsigned vw[8];
#pragma unroll
                for (int m = 0; m < 16; m += 2) vw[m >> 1] = pk2(ZM[(size_t)m * NIN + 256 * (20 + (c >> 8)) + (c & 255)], ZM[(size_t)(m + 1) * NIN + 256 * (20 + (c >> 8)) + (c & 255)]);
                *(u32x4*)(row + 48) = (u32x4){vw[0], vw[1], vw[2], vw[3]}; *(u32x4*)(row + 56) = (u32x4){vw[4], vw[5], vw[6], vw[7]}; }
            __syncthreads();
            continue;
        }
        const int b = task >> 9, h = (task >> 7) & 3, c = task & 127;
        const size_t tok0 = (size_t)b * SEQ + c * 64;
        unsigned char* pkf = PKF + (size_t)((b * 4 + h) * 129 + 1 + c) * PK_BYTES;
        unsigned char* pkb = PKB + (size_t)((b * 4 + h) * 128 + c) * PK_BYTES;
        { const f32x4* src = (const f32x4*)(R + tok0 * 32); ((f32x4*)RS)[tid] = src[tid]; }
        const int d = tid & 127, tq = tid >> 7;
        bf16_t qv[16], kv[16];
#pragma unroll
        for (int jj = 0; jj < 16; ++jj) { qv[jj] = QG[(tok0 + 16 * tq + jj) * 512 + h * 128 + d]; kv[jj] = KG[(tok0 + 16 * tq + jj) * 512 + h * 128 + d]; }
        float wf[16], wb[16];
#pragma unroll
        for (int k = 0; k < 16; ++k) { wf[k] = a.wd_f[k * 512 + h * 128 + d]; wb[k] = a.wd_b[k * 512 + h * 128 + d]; }
        const float bf_ = a.bd_f[h * 128 + d], bb_ = a.bd_b[h * 128 + d];
        __syncthreads();
        float pf[16], pb[16];
        { float rf = 0.f, rb = 0.f;
#pragma unroll
          for (int jj = 0; jj < 16; ++jj) { const float* rr = RS + (16 * tq + jj) * 32; float df = bf_, db = bb_;
#pragma unroll
              for (int k4 = 0; k4 < 4; ++k4) { const f32x4 x0 = *(const f32x4*)(rr + 4 * k4), x1 = *(const f32x4*)(rr + 16 + 4 * k4);
                  df += x0[0] * wf[4 * k4] + x0[1] * wf[4 * k4 + 1] + x0[2] * wf[4 * k4 + 2] + x0[3] * wf[4 * k4 + 3];
                  db += x1[0] * wb[4 * k4] + x1[1] * wb[4 * k4 + 1] + x1[2] * wb[4 * k4 + 2] + x1[3] * wb[4 * k4 + 3]; }
              rf += logsig16(df); rb += logsig16(db); pf[jj] = rf; pb[jj] = rb; }
          PART[(0 * 4 + tq) * 128 + d] = rf; PART[(1 * 4 + tq) * 128 + d] = rb; }
        __syncthreads();
        float offf = 0.f, totf = 0.f, offb = 0.f, totb = 0.f;
#pragma unroll
        for (int q = 0; q < 4; ++q) { const float tf = PART[(0 * 4 + q) * 128 + d], tb = PART[(1 * 4 + q) * 128 + d]; totf += tf; totb += tb; if (q < tq) offf += tf; if (q > tq) offb += tb; }
        const float mytb = pb[15];
        unsigned ksf[8], ksb[8];
#pragma unroll
        for (int jj = 0; jj < 16; jj += 2) {
            float kstf[2], kstb[2];
#pragma unroll
            for (int e = 0; e < 2; ++e) { const int j = 16 * tq + jj + e;
                const float q = bf2f(qv[jj + e]), k = bf2f(kv[jj + e]);
                const float Gf = offf + pf[jj + e];
                const float Gb = offb + (mytb - ((jj + e) ? pb[jj + e - 1] : 0.f));
                const float ef = __expf(Gf), eb = __expf(Gb);
                T_QF[j * PREP_LD + d] = (bf16_t)(pk2(q * ef, 0.f) & 0xffffu);
                T_KF[j * PREP_LD + d] = (bf16_t)(pk2(k * __expf(-Gf), 0.f) & 0xffffu);
                T_QB[j * PREP_LD + d] = (bf16_t)(pk2(q * eb, 0.f) & 0xffffu);
                T_KB[j * PREP_LD + d] = (bf16_t)(pk2(k * __expf(-Gb), 0.f) & 0xffffu);
                kstf[e] = k * __expf(totf - Gf); kstb[e] = k * __expf(totb - Gb); }
            ksf[jj >> 1] = pk2(kstf[0], kstf[1]); ksb[jj >> 1] = pk2(kstb[0], kstb[1]);
        }
        { const int dt = d >> 5, r = d & 31;
          *(u32x4*)(pkf + (dt * 4 + tq) * 1024 + (0 * 32 + r) * 16) = (u32x4){ksf[0], ksf[1], ksf[2], ksf[3]};
          *(u32x4*)(pkf + (dt * 4 + tq) * 1024 + (1 * 32 + r) * 16) = (u32x4){ksf[4], ksf[5], ksf[6], ksf[7]};
          *(u32x4*)(pkb + (dt * 4 + tq) * 1024 + (0 * 32 + r) * 16) = (u32x4){ksb[0], ksb[1], ksb[2], ksb[3]};
          *(u32x4*)(pkb + (dt * 4 + tq) * 1024 + (1 * 32 + r) * 16) = (u32x4){ksb[4], ksb[5], ksb[6], ksb[7]};
          if (tq == 0) { *(float*)(pkf + PK_A_OFF + d * 4) = __expf(totf); *(float*)(pkb + PK_A_OFF + d * 4) = __expf(totb); } }
        __syncthreads();
        {
            const int dir = wave >> 2, jt = (wave >> 1) & 1, it = wave & 1;
            const bf16_t* TQ = dir ? T_QB : T_QF; const bf16_t* TK = dir ? T_KB : T_KF; unsigned char* pk = dir ? pkb : pkf;
            const int rho = lane & 31, hh = lane >> 5;
            const int pj = (rho & ~12) | ((rho & 4) << 1) | ((rho & 8) >> 1);
            const int jrow = 32 * jt + pj, icol = 32 * it + rho;
            f32x16 acc;
#pragma unroll
            for (int i = 0; i < 16; ++i) acc[i] = 0.f;
#pragma unroll
            for (int kd = 0; kd < 8; ++kd) { const bf16x8 af = *(const bf16x8*)(TK + jrow * PREP_LD + 16 * kd + 8 * hh); const bf16x8 bfr = *(const bf16x8*)(TQ + icol * PREP_LD + 16 * kd + 8 * hh);
                acc = MFMA32(af, bfr, acc); }
#pragma unroll
            for (int s = 0; s < 2; ++s) {
                unsigned w[4];
#pragma unroll
                for (int e = 0; e < 8; e += 2) {
                    float v[2];
#pragma unroll
                    for (int x = 0; x < 2; ++x) { const int j = 32 * jt + 16 * s + 8 * hh + e + x; const bool keep = dir ? (j >= icol) : (j <= icol); v[x] = keep ? acc[8 * s + e + x] : 0.f; }
                    w[e >> 1] = pk2(v[0], v[1]);
                }
                *(u32x4*)(pk + (32 + it * 4 + 2 * jt + s) * 1024 + lane * 16) = (u32x4){w[0], w[1], w[2], w[3]};
            }
#pragma unroll
            for (int ff = 0; ff < 4; ++ff) { const int f = (wave & 3) * 4 + ff, it2 = f >> 3, kd = f & 7;
                const bf16_t* rowp = TQ + (32 * it2 + rho) * PREP_LD + 16 * kd + 4 * hh;
                const u32x2 lo = *(const u32x2*)(rowp), hi = *(const u32x2*)(rowp + 8);
                *(u32x4*)(pk + (16 + f) * 1024 + lane * 16) = (u32x4){lo.x, lo.y, hi.x, hi.y}; }
        }
        __syncthreads();
    }
}

constexpr int SCAN_BUF = 46080;
constexpr int SCAN_VT = 41984;
constexpr int SCAN_OST = 3 * SCAN_BUF;
DI bf16x8 pack8(const f32x16& x, int s) {
    u32x4 p; p.x = pk2(x[8 * s], x[8 * s + 1]); p.y = pk2(x[8 * s + 2], x[8 * s + 3]); p.z = pk2(x[8 * s + 4], x[8 * s + 5]); p.w = pk2(x[8 * s + 6], x[8 * s + 7]);
    return __builtin_bit_cast(bf16x8, p);
}
#define SCAN_BAR() do { asm volatile("s_waitcnt lgkmcnt(0)" ::: "memory"); __builtin_amdgcn_s_barrier(); asm volatile("" ::: "memory"); } while (0)
#define SCAN_LDF(f) (*(const bf16x8*)(buf + (f) * 1024 + lane * 16))
constexpr int SCAN_UB = 3 * SCAN_BUF;
constexpr int SCAN_XO = SCAN_UB + 16384;
DI void scan_stage(const unsigned char* src, const bf16_t* vsrc, int vstride, unsigned char* dst, int lw, int ih, int lane) {
#pragma unroll
    for (int k = 0; k < 9; ++k) { const int i = 4 * k + lw; if (i >= 33) continue;
        if (i < 29) { const int q = (i < 16) ? i : (i < 24) ? (16 + 8 * ih + (i - 16)) : (i < 28) ? (32 + 4 * ih + (i - 24)) : 40;
            __builtin_amdgcn_global_load_lds((const unsigned*)(src + (size_t)q * 1024 + lane * 16), (PG8_LAS unsigned*)(dst + q * 1024), 16, 0, 0); }
        else __builtin_amdgcn_global_load_lds((const unsigned*)(vsrc + (size_t)(i - 29) * vstride), (PG8_LAS unsigned*)(dst + SCAN_VT + (i - 29) * 1024), 16, 0, 0); }
}
DI void scan_phase(const Args& a, unsigned char* lds, int wave, int lane) {
    const int sb = blockIdx.x; if (sb >= 256) return;
    unsigned char* ws = a.ws;
    const int stream = sb & 15, eighth = (sb >> 4) & 7, ih = sb >> 7;
    const int b = stream >> 3, dir = (stream >> 2) & 1, h = stream & 3;
    const int nsteps = dir ? 128 : 129;
    const unsigned char* pkbase = dir ? (ws + WS_PKB + (size_t)((b * 4 + h) * 128) * PK_BYTES) : (ws + WS_PKF + (size_t)((b * 4 + h) * 129) * PK_BYTES);
    const bf16_t* VP = (const bf16_t*)(ws + WS_VGT); const bf16_t* VMT = (const bf16_t*)(ws + WS_VMT);
    const int vcol0 = h * 256 + eighth * 32;
#define SCAN_PKIDX(s_) (dir ? (127 - (s_)) : (s_))
#define SCAN_STAGE(s_) do { const int ss_ = (s_); \
        if (dir == 0 && ss_ == 0) scan_stage(pkbase, VMT + (size_t)(vcol0 + (lane & 31)) * 64 + 8 * (lane >> 5), 16, lds + (size_t)(ss_ % 3) * SCAN_BUF, lw, ih, lane); \
        else { const int cc_ = dir ? (127 - ss_) : (ss_ - 1); \
            scan_stage(pkbase + (size_t)SCAN_PKIDX(ss_) * PK_BYTES, VP + ((size_t)((b * 4 + h) * 128 + cc_) * 8 + eighth) * 2048 + lane * 8, 512, lds + (size_t)(ss_ % 3) * SCAN_BUF, lw, ih, lane); } } while (0)
#define SCAN_LWAIT() do { if (lw == 0) asm volatile("s_waitcnt vmcnt(9)" ::: "memory"); else asm volatile("s_waitcnt vmcnt(8)" ::: "memory"); } while (0)
    if (wave >= 4) {
        const int lw = wave - 4;
        SCAN_STAGE(0); SCAN_STAGE(1);
        SCAN_LWAIT();
        SCAN_BAR();
        for (int n = 0; n < nsteps; ++n) {
            if (n + 2 < nsteps) { SCAN_STAGE(n + 2); SCAN_LWAIT(); }
            else asm volatile("s_waitcnt vmcnt(0)" ::: "memory");
            SCAN_BAR();
        }
        return;
    }
    unsigned char* SF = lds + SCAN_UB; unsigned char* XO = lds + SCAN_XO;
    const int r = lane & 31, hh = lane >> 5;
    if (wave < 2) {
        f32x16 S[2];
#pragma unroll
        for (int dt = 0; dt < 2; ++dt)
#pragma unroll
            for (int i = 0; i < 16; ++i) S[dt][i] = 0.f;
#pragma unroll
        for (int f = 0; f < 8; ++f) *(u32x4*)(SF + (wave * 8 + f) * 1024 + lane * 16) = (u32x4){0u, 0u, 0u, 0u};
        SCAN_BAR();
        for (int n = 0; n < nsteps; ++n) {
            const unsigned char* buf = lds + (size_t)(n % 3) * SCAN_BUF;
            bf16x8 vt[4], kf[8];
            f32x4 av[8];
#pragma unroll
            for (int i = 0; i < 8; ++i) av[i] = *(const f32x4*)(buf + PK_A_OFF + (64 * wave + 32 * (i >> 2) + 8 * (i & 3) + 4 * hh) * 4);
#pragma unroll
            for (int ks = 0; ks < 4; ++ks) vt[ks] = *(const bf16x8*)(buf + SCAN_VT + ks * 1024 + lane * 16);
#pragma unroll
            for (int ks = 0; ks < 4; ++ks)
#pragma unroll
                for (int dt = 0; dt < 2; ++dt) kf[dt * 4 + ks] = SCAN_LDF((2 * wave + dt) * 4 + ks);
#pragma unroll
            for (int dt = 0; dt < 2; ++dt)
#pragma unroll
                for (int g4 = 0; g4 < 4; ++g4) { const f32x4 v = av[4 * dt + g4]; S[dt][4 * g4] *= v[0]; S[dt][4 * g4 + 1] *= v[1]; S[dt][4 * g4 + 2] *= v[2]; S[dt][4 * g4 + 3] *= v[3]; }
#pragma unroll
            for (int ks = 0; ks < 4; ++ks)
#pragma unroll
                for (int dt = 0; dt < 2; ++dt) S[dt] = MFMA32(kf[dt * 4 + ks], vt[ks], S[dt]);
            unsigned char* sfo = SF + (n & 1) * 8192;
#pragma unroll
            for (int dt = 0; dt < 2; ++dt) { const bf16x8 s0 = pack8(S[dt], 0), s1 = pack8(S[dt], 1);
                *(bf16x8*)(sfo + (4 * wave + 2 * dt) * 1024 + lane * 16) = s0; *(bf16x8*)(sfo + (4 * wave + 2 * dt + 1) * 1024 + lane * 16) = s1; }
            SCAN_BAR();
        }
        return;
    }
    bf16_t* OUT = dir ? (bf16_t*)(ws + WS_OB) : (bf16_t*)(ws + WS_AO); const int ldo = dir ? 1024 : 2048;
    const int oh = wave - 2;
    f32x16 oprev; int cprev = -1;
#pragma unroll
    for (int i = 0; i < 16; ++i) oprev[i] = 0.f;
    SCAN_BAR();
    for (int n = 0; n < nsteps; ++n) {
        const unsigned char* buf = lds + (size_t)(n % 3) * SCAN_BUF;
        if (oh == 0 && cprev >= 0) {
            const unsigned char* xo = XO + ((n + 1) & 1) * 4096;
            bf16_t* op = OUT + ((size_t)b * SEQ + cprev * 64 + 32 * ih + r) * ldo + vcol0 + 4 * hh;
#pragma unroll
            for (int g4 = 0; g4 < 4; ++g4) { const f32x4 pv = *(const f32x4*)(xo + g4 * 1024 + lane * 16);
                u32x2 w; w.x = pk2(oprev[4 * g4] + pv[0], oprev[4 * g4 + 1] + pv[1]); w.y = pk2(oprev[4 * g4 + 2] + pv[2], oprev[4 * g4 + 3] + pv[3]);
                *(u32x2*)(op + 8 * g4) = w; }
            cprev = -1;
        }
        if (dir == 0 && n == 0) { SCAN_BAR(); continue; }
        bf16x8 vt[2], qf[4], af[2], sf[4];
#pragma unroll
        for (int kd = 0; kd < 4; ++kd) { qf[kd] = SCAN_LDF(16 + ih * 8 + 4 * oh + kd); sf[kd] = *(const bf16x8*)(SF + ((n + 1) & 1) * 8192 + (4 * oh + kd) * 1024 + lane * 16); }
#pragma unroll
        for (int ks = 0; ks < 2; ++ks) { vt[ks] = *(const bf16x8*)(buf + SCAN_VT + (2 * oh + ks) * 1024 + lane * 16); af[ks] = SCAN_LDF(32 + ih * 4 + 2 * oh + ks); }
        f32x16 o;
#pragma unroll
        for (int i = 0; i < 16; ++i) o[i] = 0.f;
#pragma unroll
        for (int kd = 0; kd < 4; ++kd) o = MFMA32(sf[kd], qf[kd], o);
        o = MFMA32(vt[0], af[0], o); o = MFMA32(vt[1], af[1], o);
        if (oh == 1) {
            unsigned char* xo = XO + (n & 1) * 4096;
#pragma unroll
            for (int g4 = 0; g4 < 4; ++g4) *(f32x4*)(xo + g4 * 1024 + lane * 16) = (f32x4){o[4 * g4], o[4 * g4 + 1], o[4 * g4 + 2], o[4 * g4 + 3]};
        } else { oprev = o; cprev = dir ? (127 - n) : (n - 1); }
        SCAN_BAR();
    }
    if (oh == 0 && cprev >= 0) {
        const unsigned char* xo = XO + ((nsteps + 1) & 1) * 4096;
        bf16_t* op = OUT + ((size_t)b * SEQ + cprev * 64 + 32 * ih + r) * ldo + vcol0 + 4 * hh;
#pragma unroll
        for (int g4 = 0; g4 < 4; ++g4) { const f32x4 pv = *(const f32x4*)(xo + g4 * 1024 + lane * 16);
            u32x2 w; w.x = pk2(oprev[4 * g4] + pv[0], oprev[4 * g4 + 1] + pv[1]); w.y = pk2(oprev[4 * g4 + 2] + pv[2], oprev[4 * g4 + 3] + pv[3]);
            *(u32x2*)(op + 8 * g4) = w; }
    }
}

DI void combine_phase(const Args& a, int vcu, int G, int wave, int lane, bf16_t* CDST, int cstride) {
    unsigned char* ws = a.ws;
    bf16_t* AO = (bf16_t*)(ws + WS_AO); const bf16_t* OB = (const bf16_t*)(ws + WS_OB); const bf16_t* GG = (const bf16_t*)a.out;
    const int gw = vcu * NWAVES + wave, NGW = G * NWAVES;
    const f32x4 gn = *(const f32x4*)(a.gla_g + 4 * lane);
    for (int tok = gw; tok < NTOK; tok += NGW) {
        u32x2 f[4], bq[4], gg[4];
#pragma unroll
        for (int h = 0; h < 4; ++h) { f[h] = *(const u32x2*)(AO + (size_t)tok * 2048 + h * 256 + 4 * lane);
            bq[h] = *(const u32x2*)(OB + (size_t)tok * 1024 + h * 256 + 4 * lane); gg[h] = *(const u32x2*)(GG + (size_t)tok * 1024 + h * 256 + 4 * lane); }
#pragma unroll
        for (int h = 0; h < 4; ++h) {
            float o[4];
            o[0] = __uint_as_float(f[h].x << 16) + __uint_as_float(bq[h].x << 16); o[1] = __uint_as_float(f[h].x & 0xffff0000u) + __uint_as_float(bq[h].x & 0xffff0000u);
            o[2] = __uint_as_float(f[h].y << 16) + __uint_as_float(bq[h].y << 16); o[3] = __uint_as_float(f[h].y & 0xffff0000u) + __uint_as_float(bq[h].y & 0xffff0000u);
            const float ss = wave_sum((o[0] * o[0] + o[1] * o[1]) + (o[2] * o[2] + o[3] * o[3]));
            const float rstd = 1.0f / sqrtf(ss * (1.f / 256.f) + RMS_EPS);
            const float g0 = __uint_as_float(gg[h].x << 16), g1 = __uint_as_float(gg[h].x & 0xffff0000u), g2 = __uint_as_float(gg[h].y << 16), g3 = __uint_as_float(gg[h].y & 0xffff0000u);
            u32x2 w; w.x = pk2(o[0] * rstd * gn[0] * g0, o[1] * rstd * gn[1] * g1); w.y = pk2(o[2] * rstd * gn[2] * g2, o[3] * rstd * gn[3] * g3);
            *(u32x2*)(CDST + (size_t)tok * cstride + h * 256 + 4 * lane) = w;
        }
    }
}

#define LAS __attribute__((address_space(3)))
#define XB_TMO      128
#define XB_XCNT(j)  (256  + 64 * (j))
#define XB_XSUB(j)  (1280 + 64 * (j))
#define XB_XGEN(j)  (2304 + 64 * (j))
#define XB_TOP      3328
#define XB_TOPGEN   3392
#define XCD_BAR_WORDS 3456
#define XB_SPIN_CAP (1u << 18)

__device__ __forceinline__ unsigned xb_ld(unsigned* p)              { return __hip_atomic_load(p, __ATOMIC_RELAXED, __HIP_MEMORY_SCOPE_AGENT); }
__device__ __forceinline__ unsigned xb_add(unsigned* p, unsigned v) { return __hip_atomic_fetch_add(p, v, __ATOMIC_RELAXED, __HIP_MEMORY_SCOPE_AGENT); }
__device__ __forceinline__ unsigned xb_xcc_id() { return (unsigned)__builtin_amdgcn_s_getreg((3 << 11) | 20) & 0xFu; }
#define XB_SPIN(cond, bar) do { unsigned _sp = 0; while (cond) { __builtin_amdgcn_s_sleep(1); \
    if ((++_sp & 255u) == 0u) { if (xb_ld(&(bar)[XB_TMO])) break; if (_sp > XB_SPIN_CAP) { atomicAdd(&(bar)[XB_TMO], 1u); break; } } } } while (0)

struct XcdBarrier {
    unsigned* bar; unsigned x;
    volatile LAS unsigned* st;
};

__device__ __forceinline__ XcdBarrier xcd_barrier_post(unsigned* bar, volatile LAS unsigned* st) {
    XcdBarrier b; b.bar = bar; b.x = xb_xcc_id(); b.st = st;
    if (threadIdx.x == 0) (void)xb_add(&bar[XB_XCNT(b.x)], 1u);
    return b;
}
__device__ __forceinline__ void xcd_barrier_complete(unsigned* bar, unsigned x, unsigned& nloc, unsigned& nx) {
    const unsigned G = gridDim.x * gridDim.y * gridDim.z;
    unsigned sum, cnt, mine, sp = 0u;
    for (;;) {
        sum = 0u; cnt = 0u; mine = 0u;
#pragma unroll
        for (unsigned j = 0; j < 16; ++j) { const unsigned c = xb_ld(&bar[XB_XCNT(j)]); sum += c; cnt += (c > 0u) ? 1u : 0u; mine = (j == x) ? c : mine; }
        if (sum == G) break;
        __builtin_amdgcn_s_sleep(1);
        if ((++sp & 255u) == 0u) { if (xb_ld(&bar[XB_TMO])) break; if (sp > XB_SPIN_CAP) { atomicAdd(&bar[XB_TMO], 1u); break; } }
    }
    nloc = mine > 0u ? mine : 1u; nx = cnt > 0u ? cnt : 1u;
}

__device__ __forceinline__ void xcd_barrier(const XcdBarrier& b) {
    asm volatile("s_waitcnt vmcnt(0)" ::: "memory");
    __syncthreads();
    if (threadIdx.x == 0) {
        unsigned* bar = b.bar;
        __builtin_amdgcn_s_waitcnt(0);
        unsigned nloc = b.st[0], nx = b.st[1];
        if (nloc == 0u) { xcd_barrier_complete(bar, b.x, nloc, nx); b.st[0] = nloc; b.st[1] = nx; }
        const unsigned old = xb_add(&bar[XB_XSUB(b.x)], 1u);
        const unsigned gen = old / nloc;
        if (old + 1u == (gen + 1u) * nloc) {
            __builtin_amdgcn_fence(__ATOMIC_RELEASE, "agent");
            asm volatile("s_waitcnt vmcnt(0)" ::: "memory");
            const unsigned og = xb_add(&bar[XB_TOP], 1u);
            const unsigned tg = og / nx;
            if (og + 1u == (tg + 1u) * nx) xb_add(&bar[XB_TOPGEN], 1u);
            else XB_SPIN(xb_ld(&bar[XB_TOPGEN]) == tg, bar);
            __builtin_amdgcn_fence(__ATOMIC_ACQUIRE, "agent");
            xb_add(&bar[XB_XGEN(b.x)], 1u);
            asm volatile("s_waitcnt vmcnt(0)" ::: "memory");
        } else {
            XB_SPIN(xb_ld(&bar[XB_XGEN(b.x)]) == gen, bar);
            __builtin_amdgcn_fence(__ATOMIC_ACQUIRE, "agent");
            asm volatile("s_waitcnt vmcnt(0)" ::: "memory");
        }
    }
    __syncthreads();
}

__global__ void __launch_bounds__(NWAVES * 64, 2) hybrid_fwd(Args args, int ph_lo, int ph_hi) {
    extern __shared__ __attribute__((aligned(16))) unsigned char lds[];
    cg::grid_group grid = cg::this_grid();
    const int tid = threadIdx.x, lane = tid & 63, wave = __builtin_amdgcn_readfirstlane(tid >> 6);
    const int G = gridDim.x, bx = blockIdx.x;
    const int vcu = (G % 8 == 0) ? (bx % 8) * (G / 8) + bx / 8 : bx;
    unsigned char* ws = args.ws;
#ifndef REP_PHASE
#define REP_PHASE -1
#endif
#ifndef PHMASK
#define PHMASK 0x7f
#endif
#define IN(k) (ph_lo <= (k) && (k) < ph_hi && ((PHMASK >> (k)) & 1))
    volatile LAS unsigned* bst = (volatile LAS unsigned*)(lds + LDS_BYTES - 64);
    if (tid < 2) bst[tid] = 0u;
    __syncthreads();
    XcdBarrier bar = xcd_barrier_post((unsigned*)(ws + WS_CTL), bst);
    if (ph_lo < 0) grid.sync();
#define SEAM(k) do { if (IN(k) && IN((k) + 1)) xcd_barrier(bar); } while (0)
    if (IN(0)) { p0_phase(args, lds, vcu, G, wave, lane); if (REP_PHASE == 0 || REP_PHASE == 60) { xcd_barrier(bar); p0_phase(args, lds, vcu, G, wave, lane); } }
    SEAM(0);
    if (IN(1)) {
        p1_skinny(args, vcu, G, wave, lane);
        const bf16_t* XW = (const bf16_t*)(ws + WS_XW);
        pg8::Gemm g{XW, XW, NTOK, 7168, DM};
        OrderIn S{G, bx};
        EpiIn E{(bf16_t*)(ws + WS_QG), (bf16_t*)(ws + WS_KG), (bf16_t*)args.out, (bf16_t*)args.out + (size_t)NTOK * 1024, (bf16_t*)(ws + WS_AO), (bf16_t*)(ws + WS_NK),
                (bf16_t*)(ws + WS_VGT), (bf16_t*)(ws + WS_NVT), args.qn_g, args.kn_g};
        pg8::gemm_phase<EpiIn, OrderIn, true, true>((PG8_LAS unsigned char*)lds, g, S, E);
        }
#if REP_PHASE == 1
    if (IN(1)) { xcd_barrier(bar);
        p1_skinny(args, vcu, G, wave, lane);
        const bf16_t* XW = (const bf16_t*)(ws + WS_XW);
        pg8::Gemm g{XW, XW, NTOK, 7168, DM};
        OrderIn S{G, bx};
        EpiIn E{(bf16_t*)(ws + WS_QG), (bf16_t*)(ws + WS_KG), (bf16_t*)args.out, (bf16_t*)args.out + (size_t)NTOK * 1024, (bf16_t*)(ws + WS_AO), (bf16_t*)(ws + WS_NK),
                (bf16_t*)(ws + WS_VGT), (bf16_t*)(ws + WS_NVT), args.qn_g, args.kn_g};
        pg8::gemm_phase<EpiIn, OrderIn, true, true>((PG8_LAS unsigned char*)lds, g, S, E);
        }
#endif
    SEAM(1);
    if (IN(2)) {
#if REP_PHASE == 2
        na_phase(args, lds, vcu, G, wave, lane, (bf16_t*)(ws + WS_XW), 1024); xcd_barrier(bar);
#endif
        na_phase(args, lds, vcu, G, wave, lane, (bf16_t*)(ws + WS_AO) + 1024, 2048); }
    SEAM(2);
    if (IN(3)) { prep_phase(args, lds, vcu, G, wave, lane); if (REP_PHASE == 3) { xcd_barrier(bar); prep_phase(args, lds, vcu, G, wave, lane); } }
    SEAM(3);
    if (IN(4)) { scan_phase(args, lds, wave, lane); if (REP_PHASE == 4) { xcd_barrier(bar); scan_phase(args, lds, wave, lane); } }
    SEAM(4);
#ifdef REP_SYNC
    for (int i_ = 0; i_ < REP_SYNC; ++i_) xcd_barrier(bar);
#endif
    if (IN(5)) {
#if REP_PHASE == 5
        combine_phase(args, vcu, G, wave, lane, (bf16_t*)(ws + WS_XW), 1024); xcd_barrier(bar);
#endif
        combine_phase(args, vcu, G, wave, lane, (bf16_t*)(ws + WS_AO), 2048); }
    SEAM(5);
    if (IN(6)) {
        pg8::Gemm g{(const bf16_t*)(ws + WS_AO), (const bf16_t*)(ws + WS_WO), NTOK, DM, 2048};
        pg8::StaticOrder S; S.init(NTOK, DM, G, bx);
        EpiOut E{args.x, args.out};
        pg8::gemm_phase<EpiOut, pg8::StaticOrder, false, true>((PG8_LAS unsigned char*)lds, g, S, E);
        }
#if REP_PHASE == 6 || REP_PHASE == 60
    if (IN(6)) { xcd_barrier(bar);
        pg8::Gemm g{(const bf16_t*)(ws + WS_AO), (const bf16_t*)(ws + WS_WO), NTOK, DM, 2048};
        pg8::StaticOrder S; S.init(NTOK, DM, G, bx);
        EpiOut E{args.x, args.out};
        pg8::gemm_phase<EpiOut, pg8::StaticOrder, false, true>((PG8_LAS unsigned char*)lds, g, S, E);
        }
#endif
#ifdef SCAN_DBG
    if (bx == 0 && tid == 0) { const float* dbg = (const float*)(ws + WS_ZM + 480 * 1024); const float ratio = dbg[0] / dbg[1];
        args.out[0] = (DBG_WHAT == 0) ? (ratio < 0.33f ? 100.f : (ratio < 0.66f ? 200.f : 300.f)) : (dbg[1] < 10000.f ? 100.f : (dbg[1] < 15000.f ? 200.f : (dbg[1] < 20000.f ? 300.f : 400.f))); }
#endif
#ifdef SCAN_DBG
    if (bx == 0 && tid == 0) { const float* dbg = (const float*)(ws + WS_ZM + 480 * 1024);
        const float ratio = (DBG_WHAT == 0 ? dbg[0] : dbg[2]) / dbg[1];
        args.out[0] = (DBG_WHAT == 2) ? 100.f * floorf(dbg[1] * (1.f / 100000.f) + 1.f) : 100.f * (1.f + floorf(ratio * 5.f)); }
#endif
#undef IN
#undef SEAM
}

#ifndef N_LAUNCHES
#define N_LAUNCHES 1
#endif
extern "C" void kernel_launch(void* const* d_in, const int* in_sizes, int n_in, void* d_out, int out_size, void* d_ws, size_t ws_size, hipStream_t stream) {
    static int grid = 0;
    if (grid == 0) {
        if (n_in != 14 || out_size != NTOK * DM || ws_size < WS_END) { fprintf(stderr, "kernel_launch: unexpected problem (n_in %d out %d ws %zu)\n", n_in, out_size, ws_size); grid = -1; return; }
        int dev = 0, cus = 0, per_cu = 0;
        hipGetDevice(&dev); hipDeviceGetAttribute(&cus, hipDeviceAttributeMultiprocessorCount, dev);
        if (hipFuncSetAttribute((const void*)hybrid_fwd, hipFuncAttributeMaxDynamicSharedMemorySize, LDS_BYTES) != hipSuccess) { fprintf(stderr, "kernel_launch: hipFuncSetAttribute failed\n"); grid = -1; return; }
        if (hipOccupancyMaxActiveBlocksPerMultiprocessor(&per_cu, (const void*)hybrid_fwd, NWAVES * 64, LDS_BYTES) != hipSuccess || per_cu < 1) { fprintf(stderr, "kernel_launch: occupancy query gave %d\n", per_cu); per_cu = 1; }
        (void)hipGetLastError();
        grid = cus * per_cu;
        if (grid > 256) grid = 256;
    }
    if (grid < 0) return;
    Args a{};
    a.x = (const float*)d_in[0]; a.meta = (const float*)d_in[1]; a.norm_g = (const float*)d_in[2]; a.w_in = (const float*)d_in[3];
    a.wd_f = (const float*)d_in[4]; a.bd_f = (const float*)d_in[5]; a.wd_b = (const float*)d_in[6]; a.bd_b = (const float*)d_in[7];
    a.gla_g = (const float*)d_in[8]; a.qn_g = (const float*)d_in[9]; a.kn_g = (const float*)d_in[10]; a.rpb = (const float*)d_in[11];
    a.meta_bias = (const float*)d_in[12]; a.w_out = (const float*)d_in[13];
    a.out = (float*)d_out; a.ws = (unsigned char*)d_ws;
    if (hipMemsetAsync((char*)d_ws + WS_CTL, 0, 16384, stream) != hipSuccess) { fprintf(stderr, "kernel_launch: memset of the barrier words failed\n"); return; }
#if N_LAUNCHES == 1
    int lo = 0, hi = 7;
    void* kargs[] = {&a, &lo, &hi};
    hipError_t e = hipLaunchCooperativeKernel((const void*)hybrid_fwd, dim3(grid), dim3(NWAVES * 64), kargs, LDS_BYTES, stream);
    if (e != hipSuccess) fprintf(stderr, "kernel_launch: cooperative launch failed: %s (grid %d)\n", hipGetErrorString(e), grid);
#else
    for (int p = 0; p < 7; ++p) hipLaunchKernelGGL(hybrid_fwd, dim3(grid), dim3(NWAVES * 64), LDS_BYTES, stream, a, p, p + 1);
#endif
}
```

```cpp
#include <hip/hip_runtime.h>
#include <hip/hip_cooperative_groups.h>
#include <cstdio>
#include <cstdint>
namespace cg = cooperative_groups;
namespace pg8 {
#define PG8_LAS __attribute__((address_space(3)))
typedef unsigned short bf16_t;
typedef short bf16x8 __attribute__((ext_vector_type(8)));
typedef float f32x4 __attribute__((ext_vector_type(4)));
typedef unsigned u32x4 __attribute__((ext_vector_type(4)));
constexpr int BM = 256, BK = 64, HALF = 128, HTB = HALF * BK * 2  , STAGE_BYTES = 8 * HTB, NXCD = 8, WGM = 8;

__host__ __device__ __forceinline__ int lds_byte(int r, int c) { const int st = (r >> 4) * 2 + (c >> 5), rr = r & 15, cc = c & 31, ob = rr * 64 + cc * 2; return st * 1024 + (ob ^ (((ob >> 9) & 1) << 5)); }
__host__ __device__ __forceinline__ void stage_rc(int b, int& R, int& C) { const int st = b / 1024, sb = b % 1024, swz = sb ^ (((sb >> 9) & 1) << 5); R = (st >> 1) * 16 + swz / 64; C = (st & 1) * 32 + (swz % 64) / 2; }
__host__ __device__ __forceinline__ int perm32(int rho) { const int n = rho >> 4, i = rho & 15; return 8 * (i >> 2) + 4 * n + (i & 3); }

struct Unit { int pm, pn; };
struct Gemm { const bf16_t* A; const bf16_t* Bt; int M, N, K; };

struct StaticOrder {
    int nM, nN, nwg, G, c;
    __host__ __device__ void init(int M, int N, int G_, int c_) { nM = M / BM; nN = N / BM; nwg = nM * nN; G = G_; c = c_; }
    __host__ __device__ bool next(int i, Unit& u) const {
        const long L = (long)i * G + c; if (L >= nwg) return false;
        int wgid = (int)L; { const int q = nwg / NXCD, r = nwg % NXCD, xcd = wgid % NXCD, off = wgid / NXCD; wgid = (xcd < r ? xcd * (q + 1) : r * (q + 1) + (xcd - r) * q) + off; }
        const int nig = WGM * nN, gid = wgid / nig, fm = gid * WGM, gsz = (nM - fm) < WGM ? (nM - fm) : WGM;
        u.pm = fm + ((wgid % nig) % gsz); u.pn = (wgid % nig) / gsz; return true;
    }
    __device__ __forceinline__ void a_ready(const Unit&) const {}
    __device__ __forceinline__ void done(const Unit&) const {}
};

__device__ __forceinline__ unsigned cvt_pk_bf16(float lo, float hi) { unsigned r; asm volatile("v_cvt_pk_bf16_f32 %0, %1, %2" : "=v"(r) : "v"(lo), "v"(hi)); return r; }
template <class Epi, class Sched, bool ALIGN_EPI = false, bool SP2 = false>
__device__ __forceinline__ void gemm_phase(PG8_LAS unsigned char* lds, const Gemm g, const Sched& S, const Epi& E) {
    const int tid = threadIdx.x, wid = __builtin_amdgcn_readfirstlane(tid >> 6), lane = tid & 63, wr = wid >> 2, wc = wid & 3, fr = lane & 15, fq = lane >> 4;
    const int K = g.K, nt = K / BK;
    unsigned voffA[2], voffB[2];
#pragma unroll
    for (int i = 0; i < 2; ++i) { int R, C; stage_rc(tid * 16 + i * 8192, R, C); const int Rb = Epi::PERM ? ((R & ~31) + perm32(R & 31)) : R;
        voffA[i] = (unsigned)(R * K + C) * 2u; voffB[i] = (unsigned)(Rb * K + C) * 2u; }
    const size_t kstep = (size_t)(BK * 2);
    const size_t hstep = (size_t)HALF * K * 2;
    const size_t tstep = 2 * hstep;
    const unsigned ldsw = (unsigned)wid * 1024u;
    const int aoff = lds_byte(wr * 64 + fr, fq * 8), boff = lds_byte(wc * 32 + fr, fq * 8);
#define PG8_SA(b, h) (((b) * 2 + (h)) * HTB)
#define PG8_SB(b, h) ((4 + (b) * 2 + (h)) * HTB)
#define PG8_STAGE(bufoff, gbase, voff) do { _Pragma("unroll") for (int _i = 0; _i < 2; ++_i) \
        __builtin_amdgcn_global_load_lds((const unsigned*)((const char*)(gbase) + (voff)[_i]), (PG8_LAS unsigned*)(lds + (bufoff) + ldsw + _i * 8192), 16, 0, 0); } while (0)
#define PG8_LDA(dst, b, h) do { _Pragma("unroll") for (int m = 0; m < 4; ++m) _Pragma("unroll") for (int k = 0; k < 2; ++k) dst[m][k] = *(const PG8_LAS bf16x8*)(lds + PG8_SA(b, h) + aoff + m * 2048 + k * 1024); } while (0)
#define PG8_LDB(dst, b, h) do { _Pragma("unroll") for (int n = 0; n < 2; ++n) _Pragma("unroll") for (int k = 0; k < 2; ++k) dst[n][k] = *(const PG8_LAS bf16x8*)(lds + PG8_SB(b, h) + boff + n * 2048 + k * 1024); } while (0)
#define PG8_MMA(ai, bj, At, Bt) do { __builtin_amdgcn_s_setprio(1); _Pragma("unroll") for (int m = 0; m < 4; ++m) _Pragma("unroll") for (int n = 0; n < 2; ++n) _Pragma("unroll") for (int k = 0; k < 2; ++k) \
        acc[ai][bj][m][n] = __builtin_amdgcn_mfma_f32_16x16x32_bf16(Bt[n][k], At[m][k], acc[ai][bj][m][n], 0, 0, 0); __builtin_amdgcn_s_setprio(0); } while (0)
#define PG8_WAIT_V(n) asm volatile("s_waitcnt vmcnt(" #n ")" ::: "memory")
#define PG8_WAIT_L(n) asm volatile("s_waitcnt lgkmcnt(" #n ")" ::: "memory")
#define PG8_BAR __builtin_amdgcn_s_barrier()
#define PG8_SCHED __builtin_amdgcn_sched_barrier(0)
    Unit cur, nxt; int ui = 0;
    if (!S.next(0, cur)) return;
    f32x4 acc[2][2][4][2];
#pragma unroll
    for (int a = 0; a < 2; ++a)
#pragma unroll
        for (int b = 0; b < 2; ++b)
#pragma unroll
            for (int m = 0; m < 4; ++m)
#pragma unroll
                for (int n = 0; n < 2; ++n) acc[a][b][m][n] = (f32x4){0.f, 0.f, 0.f, 0.f};
    bf16x8 At[4][2], B0[2][2], B1[2][2];
    const char* cA = (const char*)g.A + (size_t)cur.pm * tstep; const char* cB = (const char*)g.Bt + (size_t)cur.pn * tstep;
    S.a_ready(cur);
    if constexpr (SP2) {
        PG8_STAGE(PG8_SB(0, 0), cB, voffB); PG8_STAGE(PG8_SB(0, 1), cB + hstep, voffB); PG8_STAGE(PG8_SA(0, 0), cA, voffA); PG8_STAGE(PG8_SA(0, 1), cA + hstep, voffA);
        if (wr == 1) PG8_BAR;
        PG8_WAIT_V(2); PG8_BAR;
        PG8_STAGE(PG8_SB(1, 0), cB + kstep, voffB); PG8_STAGE(PG8_SA(1, 0), cA + kstep, voffA); PG8_STAGE(PG8_SB(1, 1), cB + hstep + kstep, voffB);
        PG8_WAIT_V(6); PG8_BAR;
    } else {
        PG8_STAGE(PG8_SB(0, 0), cB, voffB); PG8_STAGE(PG8_SA(0, 0), cA, voffA); PG8_STAGE(PG8_SB(0, 1), cB + hstep, voffB); PG8_STAGE(PG8_SA(0, 1), cA + hstep, voffA);
        if (wr == 1) PG8_BAR;
        PG8_WAIT_V(4); PG8_BAR;
        PG8_STAGE(PG8_SB(1, 0), cB + kstep, voffB); PG8_STAGE(PG8_SA(1, 0), cA + kstep, voffA); PG8_STAGE(PG8_SB(1, 1), cB + hstep + kstep, voffB);
        PG8_WAIT_V(6); PG8_BAR;
    }
    for (;;) {
        const bool has_next = S.next(ui + 1, nxt);
        const char* nA = has_next ? (const char*)g.A + (size_t)nxt.pm * tstep : cA; const char* nB = has_next ? (const char*)g.Bt + (size_t)nxt.pn * tstep : cB;
        for (int t = 0; t < nt; t += 2) {
            const bool last = (t == nt - 2);
            const char* a1 = cA + (size_t)(t + 1) * kstep;
            const char* a2 = last ? nA : cA + (size_t)(t + 2) * kstep; const char* b2 = last ? nB : cB + (size_t)(t + 2) * kstep;
            const char* a3 = a2 + kstep; const char* b3 = b2 + kstep;
            if (last && has_next) S.a_ready(nxt);
            if constexpr (SP2) {
            PG8_LDB(B0, 0, 0); PG8_LDB(B1, 0, 1); PG8_SCHED; PG8_LDA(At, 0, 0); PG8_STAGE(PG8_SA(1, 1), a1 + hstep, voffA);
            PG8_WAIT_V(8); PG8_WAIT_L(0); PG8_BAR; PG8_MMA(0, 0, At, B0); PG8_MMA(0, 1, At, B1); PG8_BAR; PG8_SCHED;
            PG8_LDA(At, 0, 1); PG8_STAGE(PG8_SB(0, 0), b2, voffB); PG8_STAGE(PG8_SB(0, 1), b2 + hstep, voffB); PG8_STAGE(PG8_SA(0, 0), a2, voffA);
            PG8_WAIT_V(8); PG8_WAIT_L(0); PG8_BAR; PG8_MMA(1, 0, At, B0); PG8_MMA(1, 1, At, B1); PG8_BAR; PG8_SCHED;
            PG8_LDB(B0, 1, 0); PG8_LDB(B1, 1, 1); PG8_SCHED; PG8_LDA(At, 1, 0); PG8_STAGE(PG8_SA(0, 1), a2 + hstep, voffA);
            PG8_WAIT_V(8); PG8_WAIT_L(0); PG8_BAR; PG8_MMA(0, 0, At, B0); PG8_MMA(0, 1, At, B1); PG8_BAR; PG8_SCHED;
            PG8_LDA(At, 1, 1); PG8_STAGE(PG8_SB(1, 0), b3, voffB); PG8_STAGE(PG8_SB(1, 1), b3 + hstep, voffB); PG8_STAGE(PG8_SA(1, 0), a3, voffA);
            PG8_WAIT_V(8); PG8_WAIT_L(0); PG8_BAR; PG8_MMA(1, 0, At, B0); PG8_MMA(1, 1, At, B1); PG8_BAR; PG8_SCHED;
            } else {
            PG8_LDB(B0, 0, 0); PG8_SCHED; PG8_LDA(At, 0, 0); PG8_STAGE(PG8_SA(1, 1), a1 + hstep, voffA);
            PG8_WAIT_L(8); PG8_BAR; PG8_WAIT_L(0); PG8_MMA(0, 0, At, B0); PG8_BAR; PG8_SCHED;
            PG8_LDB(B1, 0, 1); PG8_STAGE(PG8_SB(0, 0), b2, voffB);
            PG8_BAR; PG8_WAIT_L(0); PG8_MMA(0, 1, At, B1); PG8_BAR;
            PG8_LDA(At, 0, 1); PG8_STAGE(PG8_SA(0, 0), a2, voffA);
            PG8_BAR; PG8_WAIT_L(0); PG8_MMA(1, 0, At, B0); PG8_BAR; PG8_SCHED;
            PG8_STAGE(PG8_SB(0, 1), b2 + hstep, voffB);
            PG8_WAIT_V(6); PG8_BAR; PG8_MMA(1, 1, At, B1); PG8_BAR;
            PG8_LDB(B0, 1, 0); PG8_SCHED; PG8_LDA(At, 1, 0); PG8_STAGE(PG8_SA(0, 1), a2 + hstep, voffA);
            PG8_WAIT_L(8); PG8_BAR; PG8_WAIT_L(0); PG8_MMA(0, 0, At, B0); PG8_BAR; PG8_SCHED;
            PG8_LDB(B1, 1, 1); PG8_STAGE(PG8_SB(1, 0), b3, voffB);
            PG8_BAR; PG8_WAIT_L(0); PG8_MMA(0, 1, At, B1); PG8_BAR;
            PG8_LDA(At, 1, 1); PG8_STAGE(PG8_SA(1, 0), a3, voffA);
            PG8_BAR; PG8_WAIT_L(0); PG8_MMA(1, 0, At, B0); PG8_BAR; PG8_SCHED;
            PG8_STAGE(PG8_SB(1, 1), b3 + hstep, voffB);
            PG8_WAIT_V(6); PG8_BAR; PG8_MMA(1, 1, At, B1); PG8_BAR;
            }
        }
        if constexpr (ALIGN_EPI) { if (wr == 0) PG8_BAR; }
        if constexpr (!Epi::AFTER_DRAIN) { E(acc, cur, wr, wc, fr, fq); S.done(cur); }
        if (!has_next) break;
#pragma unroll
        for (int a = 0; a < 2; ++a)
#pragma unroll
            for (int b = 0; b < 2; ++b)
#pragma unroll
                for (int m = 0; m < 4; ++m)
#pragma unroll
                    for (int n = 0; n < 2; ++n) acc[a][b][m][n] = (f32x4){0.f, 0.f, 0.f, 0.f};
        cur = nxt; cA = nA; cB = nB; ++ui;
        if constexpr (ALIGN_EPI) { if (wr == 1) PG8_BAR; }
    }
    PG8_WAIT_V(0);
    if constexpr (!ALIGN_EPI) { if (wr == 0) PG8_BAR; }
    PG8_BAR;
    if constexpr (Epi::AFTER_DRAIN) { E.fused(acc, cur, wr, wc, fr, fq, lds, wid, lane); S.done(cur); }
#undef PG8_SA
#undef PG8_SB
#undef PG8_STAGE
#undef PG8_LDA
#undef PG8_LDB
#undef PG8_MMA
#undef PG8_WAIT_V
#undef PG8_WAIT_L
#undef PG8_BAR
#undef PG8_SCHED
}
}

#define DI __device__ __forceinline__
typedef unsigned short bf16_t;
typedef short bf16x8 __attribute__((ext_vector_type(8)));
typedef float f32x4 __attribute__((ext_vector_type(4)));
typedef float f32x2 __attribute__((ext_vector_type(2)));
typedef float f32x16 __attribute__((ext_vector_type(16)));
typedef unsigned u32x4 __attribute__((ext_vector_type(4)));
typedef unsigned u32x2 __attribute__((ext_vector_type(2)));
typedef __bf16 bf2_t __attribute__((ext_vector_type(2)));

constexpr int NTOK = 16384, SEQ = 8192, DM = 1024, NIN = 7200, NWAVES = 8;
constexpr float RMS_EPS = 1e-6f;
constexpr float LOG2E = 1.4426950408889634f;
constexpr size_t MiB = (size_t)1 << 20;
constexpr size_t WS_ZM = 0, WS_VMT = 512 * 1024, WS_UM = 640 * 1024, WS_WS = 704 * 1024, WS_R = 1 * MiB, WS_WO = 3 * MiB, WS_XW = 8 * MiB,
                 WS_AO = 54 * MiB, WS_NK = 118 * MiB, WS_NVT = 150 * MiB, WS_VGT = 182 * MiB, WS_QG = 214 * MiB, WS_KG = 230 * MiB, WS_OB = 214 * MiB,
                 WS_PKF = WS_XW, WS_PKB = WS_NK, WS_CTL = 246 * MiB, WS_END = 247 * MiB;
constexpr int PK_BYTES = 41472;
constexpr int PK_A_OFF = 40960;
constexpr int LDS_BYTES = 163840;

DI unsigned pk2(float lo, float hi) { f32x2 v = {lo, hi}; bf2_t b = __builtin_convertvector(v, bf2_t); return __builtin_bit_cast(unsigned, b); }
DI float bf2f(bf16_t u) { return __uint_as_float(((unsigned)u) << 16); }
DI float wave_sum(float v) {
#pragma unroll
    for (int o = 1; o < 64; o <<= 1) v += __shfl_xor(v, o);
    return v;
}
DI float silu_f(float x) { return x * __builtin_amdgcn_rcpf(1.f + __expf(-x)); }
DI int crow(int reg, int h) { return (reg & 3) + 8 * (reg >> 2) + 4 * h; }
#define MFMA32(a, b, c) __builtin_amdgcn_mfma_f32_32x32x16_bf16((a), (b), (c), 0, 0, 0)
#define MFMA16(a, b, c) __builtin_amdgcn_mfma_f32_16x16x32_bf16((a), (b), (c), 0, 0, 0)

struct Args {
    const float *x, *meta, *norm_g, *w_in, *wd_f, *bd_f, *wd_b, *bd_b, *gla_g, *qn_g, *kn_g, *rpb, *meta_bias, *w_out;
    float* out; unsigned char* ws;
};

DI int phys_norm(int wt, int lc) { return 256 * wt + 128 * ((lc >> 5) & 1) + 32 * (lc >> 6) + (lc & 31); }

DI void p0_transpose_item(const float* W, int ldw, int k0, int n0, bf16_t* WT, int ldwt, int row0, float* scr, int lane) {
#pragma unroll 8
    for (int i = 0; i < 32; ++i) { const int kk = 2 * i + (lane >> 5); scr[kk * 33 + (lane & 31)] = W[(size_t)(k0 + kk) * ldw + n0 + (lane & 31)]; }
    asm volatile("s_waitcnt lgkmcnt(0)" ::: "memory");
    const int c = lane & 7;
#pragma unroll
    for (int j = 0; j < 4; ++j) { const int n = (lane >> 3) + 8 * j; const float* s = scr + (8 * c) * 33 + n;
        u32x4 o; o.x = pk2(s[0 * 33], s[1 * 33]); o.y = pk2(s[2 * 33], s[3 * 33]); o.z = pk2(s[4 * 33], s[5 * 33]); o.w = pk2(s[6 * 33], s[7 * 33]);
        *(u32x4*)(WT + (size_t)(row0 + n) * ldwt + k0 + 8 * c) = o; }
    asm volatile("s_waitcnt lgkmcnt(0)" ::: "memory");
}
DI int wt_base(int wt) {
    if (wt < 2) return 0 + 256 * wt;
    if (wt < 4) return 512 + 256 * (wt - 2);
    if (wt < 8) return 2080 + 256 * (wt - 4);
    if (wt < 12) return 3104 + 256 * (wt - 8);
    if (wt < 16) return 4128 + 256 * (wt - 12);
    if (wt < 20) return 6176 + 256 * (wt - 16);
    if (wt < 24) return 1024 + 256 * (wt - 20);
    return 5152 + 256 * (wt - 24);
}
DI void rms_row_to_bf16(const float* xrow, const float* g, bf16_t* orow, int lane) {
    const f32x4* xr = (const f32x4*)xrow + lane; const f32x4* gr = (const f32x4*)g + lane;
    f32x4 v[4]; float s = 0.f;
#pragma unroll
    for (int j = 0; j < 4; ++j) { v[j] = xr[64 * j]; s += (v[j].x * v[j].x + v[j].y * v[j].y) + (v[j].z * v[j].z + v[j].w * v[j].w); }
    const float rstd = 1.0f / sqrtf(wave_sum(s) * (1.f / DM) + RMS_EPS);
    unsigned long long* o8 = (unsigned long long*)orow + lane;
#pragma unroll
    for (int j = 0; j < 4; ++j) { const f32x4 gg = gr[64 * j];
        o8[64 * j] = (unsigned long long)pk2(v[j].x * rstd * gg.x, v[j].y * rstd * gg.y) | ((unsigned long long)pk2(v[j].z * rstd * gg.z, v[j].w * rstd * gg.w) << 32); }
}
DI void p0_block_item(const float* W, int ldw, int k0, int n0, bool perm, bf16_t* WT, int ldwt, int row0, float* T  , int tid) {
    f32x4 v[8];
#pragma unroll
    for (int i = 0; i < 8; ++i) { const int e = tid + 512 * i, kk = e >> 6, c4 = e & 63; v[i] = *(const f32x4*)(W + (size_t)(k0 + kk) * ldw + n0 + 4 * c4); }
#pragma unroll
    for (int i = 0; i < 8; ++i) { const int e = tid + 512 * i, kk = e >> 6, c4 = e & 63; float* t = T + kk * 257 + 4 * c4; t[0] = v[i][0]; t[1] = v[i][1]; t[2] = v[i][2]; t[3] = v[i][3]; }
    __syncthreads();
    { const int pp = tid >> 1, kh = tid & 1; const int lc = perm ? (64 * ((pp >> 5) & 3) + 32 * (pp >> 7) + (pp & 31)) : pp;
      const float* t = T + (32 * kh) * 257 + lc;
      unsigned w[16];
#pragma unroll
      for (int j = 0; j < 16; ++j) w[j] = pk2(t[(2 * j) * 257], t[(2 * j + 1) * 257]);
      u32x4* dst = (u32x4*)(WT + (size_t)(row0 + pp) * ldwt + k0 + 32 * kh);
#pragma unroll
      for (int j = 0; j < 4; ++j) dst[j] = (u32x4){w[4 * j], w[4 * j + 1], w[4 * j + 2], w[4 * j + 3]}; }
    __syncthreads();
}
DI void rms_rows2_to_bf16(const float* x0, const float* x1, const float* g, bf16_t* o0, bf16_t* o1, int lane) {
    const f32x4* xa = (const f32x4*)x0 + lane; const f32x4* xb = (const f32x4*)x1 + lane; const f32x4* gr = (const f32x4*)g + lane;
    f32x4 va[4], vb[4]; float sa = 0.f, sb2 = 0.f;
#pragma unroll
    for (int j = 0; j < 4; ++j) { va[j] = xa[64 * j]; vb[j] = xb[64 * j]; }
#pragma unroll
    for (int j = 0; j < 4; ++j) { sa += (va[j].x * va[j].x + va[j].y * va[j].y) + (va[j].z * va[j].z + va[j].w * va[j].w); sb2 += (vb[j].x * vb[j].x + vb[j].y * vb[j].y) + (vb[j].z * vb[j].z + vb[j].w * vb[j].w); }
    const float ra = 1.0f / sqrtf(wave_sum(sa) * (1.f / DM) + RMS_EPS), rb = 1.0f / sqrtf(wave_sum(sb2) * (1.f / DM) + RMS_EPS);
    unsigned long long* oa = (unsigned long long*)o0 + lane; unsigned long long* ob = (unsigned long long*)o1 + lane;
#pragma unroll
    for (int j = 0; j < 4; ++j) { const f32x4 gg = gr[64 * j];
        oa[64 * j] = (unsigned long long)pk2(va[j].x * ra * gg.x, va[j].y * ra * gg.y) | ((unsigned long long)pk2(va[j].z * ra * gg.z, va[j].w * ra * gg.w) << 32);
        ob[64 * j] = (unsigned long long)pk2(vb[j].x * rb * gg.x, vb[j].y * rb * gg.y) | ((unsigned long long)pk2(vb[j].z * rb * gg.z, vb[j].w * rb * gg.w) << 32); }
}
DI void p0_phase(const Args& a, unsigned char* lds, int vcu, int G, int wave, int lane) {
    unsigned char* ws = a.ws;
    bf16_t* XW = (bf16_t*)(ws + WS_XW); bf16_t* WSs = (bf16_t*)(ws + WS_WS); bf16_t* WO = (bf16_t*)(ws + WS_WO); bf16_t* UM = (bf16_t*)(ws + WS_UM);
    const int gw = vcu * NWAVES + wave, NGW = G * NWAVES, tid = wave * 64 + lane;
    for (int it = vcu; it < 448 + 128; it += G) {
        if (it < 448) { const int kb = it / 28, wt = it % 28; p0_block_item(a.w_in, NIN, 64 * kb, wt_base(wt), wt < 20, XW, DM, NTOK + 256 * wt, (float*)lds, tid); }
        else { const int r = it - 448, kb = r >> 2, nb = r & 3; p0_block_item(a.w_out, DM, 64 * kb, 256 * nb, false, WO, 2048, 256 * nb, (float*)lds, tid); }
    }
    { float* scr = (float*)(lds + wave * 16384);
      for (int it = gw; it < 16; it += NGW) p0_transpose_item(a.w_in, NIN, 64 * it, 2048, WSs, DM, 0, scr, lane); }
    for (int m = 2 * gw; m < NTOK; m += 2 * NGW) rms_rows2_to_bf16(a.x + (size_t)m * DM, a.x + (size_t)(m + 1) * DM, a.norm_g, XW + (size_t)m * DM, XW + (size_t)(m + 1) * DM, lane);
    for (int m = gw; m < 16; m += NGW) rms_row_to_bf16(a.meta + (size_t)m * DM, a.norm_g, UM + (size_t)m * DM, lane);
}

DI void skinny_task(const bf16_t* A, const bf16_t* B, float* O, int ldo, int lane) {
    const int r = lane & 15, q = lane >> 4;
    const bf16x8* ap = (const bf16x8*)(A + (size_t)r * DM + 8 * q);
    const bf16x8* b0 = (const bf16x8*)(B + (size_t)r * DM + 8 * q);
    const bf16x8* b1 = (const bf16x8*)(B + (size_t)(16 + r) * DM + 8 * q);
    f32x4 acc0 = {0.f, 0.f, 0.f, 0.f}, acc1 = {0.f, 0.f, 0.f, 0.f};
#pragma unroll
    for (int kh = 0; kh < 2; ++kh) {
        bf16x8 av[16], bv0[16], bv1[16];
#pragma unroll
        for (int ks = 0; ks < 16; ++ks) { av[ks] = ap[4 * (16 * kh + ks)]; bv0[ks] = b0[4 * (16 * kh + ks)]; bv1[ks] = b1[4 * (16 * kh + ks)]; }
#pragma unroll
        for (int ks = 0; ks < 16; ++ks) { acc0 = MFMA16(av[ks], bv0[ks], acc0); acc1 = MFMA16(av[ks], bv1[ks], acc1); }
    }
#pragma unroll
    for (int i = 0; i < 4; ++i) { O[(size_t)(4 * q + i) * ldo + r] = acc0[i]; O[(size_t)(4 * q + i) * ldo + 16 + r] = acc1[i]; }
}
DI void p1_skinny(const Args& a, int vcu, int G, int wave, int lane) {
    unsigned char* ws = a.ws;
    const bf16_t* XW = (const bf16_t*)(ws + WS_XW); const bf16_t* WSs = (const bf16_t*)(ws + WS_WS); const bf16_t* UM = (const bf16_t*)(ws + WS_UM);
    float* R = (float*)(ws + WS_R); float* ZM = (float*)(ws + WS_ZM);
    const int gw = vcu * NWAVES + wave, NGW = G * NWAVES;
    for (int t = gw; t < 1024 + 225; t += NGW) {
        if (t < 1024) skinny_task(XW + (size_t)t * 16 * DM, WSs, R + (size_t)t * 16 * 32, 32, lane);
        else { const int c = t - 1024;
            if (c < 224) skinny_task(UM, XW + (size_t)(NTOK + 32 * c) * DM, ZM + 32 * c, NIN, lane);
            else skinny_task(UM, WSs, ZM + 7168, NIN, lane); }
    }
}

struct OrderIn {
    int G, c;
    DI bool next(int i, pg8::Unit& u) const {
        const long L = (long)i * G + c; if (L >= 1792) return false;
        const int ii = (int)(L >> 8), cc = (int)(L & 255), xcd = cc & 7, j = cc >> 3, tok = 8 * xcd + (j & 7), w4 = j >> 3;
        if (ii < 5) { u.pm = tok; u.pn = 64 + 4 * ii + w4; } else { u.pm = 64 + 20 + 4 * (ii - 5) + w4; u.pn = tok; }
        return true;
    }
    DI void a_ready(const pg8::Unit&) const {}
    DI void done(const pg8::Unit&) const {}
};

struct EpiIn {
    static constexpr bool PERM = true, AFTER_DRAIN = false;
    bf16_t *QG, *KG, *GG, *NGt, *AO, *NK, *VGT, *NVT; const float *qn_g, *kn_g;
    DI void operator()(const f32x4 (&acc)[2][2][4][2], const pg8::Unit& u, int wr, int wc, int fr, int fq) const {
        if (u.pm < 64) {
            const int wt = u.pn - 64;
            const int row0 = u.pm * 256 + wr * 64 + fr;
            if (wt < 8 || wt >= 16) {
                bf16_t* base; int ld; float sc = 1.f; bool act = false;
                if (wt < 2) { base = QG + 256 * wt; ld = 512; sc = 0.08838834764831845f; }
                else if (wt < 4) { base = KG + 256 * (wt - 2); ld = 512; }
                else if (wt < 8) { base = GG + 256 * (wt - 4); ld = 1024; act = true; }
                else { base = NGt + 256 * (wt - 16); ld = 1024; act = true; }
#pragma unroll
                for (int ai = 0; ai < 2; ++ai)
#pragma unroll
                    for (int m = 0; m < 4; ++m) { bf16_t* rowp = base + (size_t)(row0 + ai * 128 + m * 16) * ld + 64 * wc + 8 * fq;
#pragma unroll
                        for (int bj = 0; bj < 2; ++bj) { f32x4 v0 = acc[ai][bj][m][0], v1 = acc[ai][bj][m][1];
                            if (act) { v0 = (f32x4){silu_f(v0[0]), silu_f(v0[1]), silu_f(v0[2]), silu_f(v0[3])}; v1 = (f32x4){silu_f(v1[0]), silu_f(v1[1]), silu_f(v1[2]), silu_f(v1[3])}; }
                            v0 = v0 * sc; v1 = v1 * sc;
                            u32x4 w; w.x = pk2(v0[0], v0[1]); w.y = pk2(v0[2], v0[3]); w.z = pk2(v1[0], v1[1]); w.w = pk2(v1[2], v1[3]);
                            *(u32x4*)(rowp + 32 * bj) = w; } }
            } else {
                const bool isq = wt < 12; const float* g = isq ? qn_g : kn_g; const float gs = isq ? (0.125f * LOG2E) : 1.0f;
                const int kb_ = u.pm >> 5, kgrow_ = (u.pm & 31) * 4 + wr;
                bf16_t* base = isq ? (AO + 1024 + 256 * (wt - 8)) : (NK + ((size_t)((kb_ * 16 + 4 * (wt - 12) + wc) * 128 + kgrow_) * 4096)); const int ld = isq ? 2048 : 1024;
                f32x4 gv[2][2];
#pragma unroll
                for (int bj = 0; bj < 2; ++bj)
#pragma unroll
                    for (int n = 0; n < 2; ++n) gv[bj][n] = *(const f32x4*)(g + 32 * bj + 8 * fq + 4 * n) * gs;
#pragma unroll
                for (int ai = 0; ai < 2; ++ai)
#pragma unroll
                    for (int m = 0; m < 4; ++m) {
                        float ss = 0.f;
#pragma unroll
                        for (int bj = 0; bj < 2; ++bj)
#pragma unroll
                            for (int n = 0; n < 2; ++n) { const f32x4 v = acc[ai][bj][m][n]; ss += (v[0] * v[0] + v[1] * v[1]) + (v[2] * v[2] + v[3] * v[3]); }
                        ss += __shfl_xor(ss, 16); ss += __shfl_xor(ss, 32);
                        const float rstd = 1.0f / sqrtf(ss * (1.f / 64.f) + RMS_EPS);
                        bf16_t* rowp = isq ? (base + (size_t)(row0 + ai * 128 + m * 16) * ld + 64 * wc + 8 * fq) : (base + (size_t)ai * 2 * 4096 + (m * 16 + fr) * 64 + 8 * fq);
#pragma unroll
                        for (int bj = 0; bj < 2; ++bj) { const f32x4 v0 = acc[ai][bj][m][0] * rstd * gv[bj][0], v1 = acc[ai][bj][m][1] * rstd * gv[bj][1];
                            u32x4 w; w.x = pk2(v0[0], v0[1]); w.y = pk2(v0[2], v0[3]); w.z = pk2(v1[0], v1[1]); w.w = pk2(v1[2], v1[3]);
                            *(u32x4*)(rowp + 32 * bj) = w; }
                    }
            }
        } else {
            const int wt = u.pm - 64;
            if (wt < 24) {
                const int bb = u.pn >> 5, cbase = (u.pn & 31) * 4 + (wc >> 1), ksb = (wc & 1) * 2;
                bf16_t* lp = VGT + ((fq & 1) * 32 + fr) * 8 + (fq >> 1) * 512;
#pragma unroll
                for (int ai = 0; ai < 2; ++ai)
#pragma unroll
                    for (int m = 0; m < 4; ++m)
#pragma unroll
                        for (int bj = 0; bj < 2; ++bj) { const f32x4 v0 = acc[ai][bj][m][0], v1 = acc[ai][bj][m][1];
                            u32x4 w; w.x = pk2(v0[0], v0[1]); w.y = pk2(v0[2], v0[3]); w.z = pk2(v1[0], v1[1]); w.w = pk2(v1[2], v1[3]);
                            const int frag = (((bb * 4 + (wt - 20)) * 128 + cbase + 2 * bj) * 8 + wr * 2 + ai * 4 + (m >> 1)) * 4 + ksb;
                            *(u32x4*)(lp + (size_t)frag * 512 + (m & 1) * 128) = w; }
            } else {
                const int vb_ = u.pn >> 5, vgrow_ = (u.pn & 31) * 4 + (wc >> 1);
                bf16_t* lp = NVT + fr * 64 + (wc & 1) * 32 + 8 * fq;
#pragma unroll
                for (int ai = 0; ai < 2; ++ai)
#pragma unroll
                    for (int m = 0; m < 4; ++m)
#pragma unroll
                        for (int bj = 0; bj < 2; ++bj) { const f32x4 v0 = acc[ai][bj][m][0], v1 = acc[ai][bj][m][1];
                            u32x4 w; w.x = pk2(v0[0], v0[1]); w.y = pk2(v0[2], v0[3]); w.z = pk2(v1[0], v1[1]); w.w = pk2(v1[2], v1[3]);
                            const int slab = (vb_ * 16 + 4 * (wt - 24) + 2 * ai + wr) * 128 + vgrow_ + 2 * bj;
                            *(u32x4*)(lp + (size_t)slab * 4096 + m * 16 * 64) = w; }
            }
        }
    }
};

struct EpiOut {
    static constexpr bool PERM = false, AFTER_DRAIN = false;
    const float* x; float* out;
    DI void operator()(const f32x4 (&acc)[2][2][4][2], const pg8::Unit& u, int wr, int wc, int fr, int fq) const {
        const int row0 = u.pm * 256 + wr * 64 + fr, col0 = u.pn * 256 + wc * 32 + 4 * fq;
#pragma unroll
        for (int ai = 0; ai < 2; ++ai)
#pragma unroll
            for (int m = 0; m < 4; ++m) { const size_t off = (size_t)(row0 + ai * 128 + m * 16) * DM + col0;
#pragma unroll
                for (int bj = 0; bj < 2; ++bj)
#pragma unroll
                    for (int n = 0; n < 2; ++n) { const f32x4 xs = *(const f32x4*)(x + off + bj * 128 + n * 16); *(f32x4*)(out + off + bj * 128 + n * 16) = xs + acc[ai][bj][m][n]; } }
    }
};

constexpr int NA_SLOT = 16384, NA_NSLOT = 9, NA_KM = NA_NSLOT * NA_SLOT, NA_VM = NA_KM + 2048, NA_RPB = NA_VM + 2048, NA_MB = NA_RPB + 1920;
#define NA_BAR() do { asm volatile("s_waitcnt lgkmcnt(0)" ::: "memory"); __builtin_amdgcn_s_barrier(); asm volatile("" ::: "memory"); } while (0)
DI void na_stage_row(const bf16_t* kslab, const bf16_t* vslab, unsigned char* slot, int lw, int lane) {
#pragma unroll
    for (int i = 0; i < 2; ++i) { const int piece = 2 * lw + i, P = 64 * piece + lane, line = P >> 4, pos = P & 15;
        { const int b0 = ((pos >> 3) & 1) ^ (line & 1), uu = (pos & 7) ^ (4 * b0 + ((line >> 2) & 3)), key = 2 * line + b0;
          __builtin_amdgcn_global_load_lds((const unsigned*)(kslab + key * 64 + uu * 8), (PG8_LAS unsigned*)(slot + piece * 1024), 16, 0, 0); }
        { const int x = pos ^ (line & 7), d = 2 * line + (x >> 3), uk = x & 7;
          __builtin_amdgcn_global_load_lds((const unsigned*)(vslab + d * 64 + uk * 8), (PG8_LAS unsigned*)(slot + 8192 + piece * 1024), 16, 0, 0); } }
}
DI int na_rs(int r) { int rs = r - 4; return rs < 0 ? 0 : (rs > 120 ? 120 : rs); }
DI void na_phase(const Args& a, unsigned char* lds, int vcu, int G, int wave, int lane, bf16_t* ODST, int ostride) {
    unsigned char* ws = a.ws;
    const float* ZM = (const float*)(ws + WS_ZM);
    bf16_t* AO = (bf16_t*)(ws + WS_AO); const bf16_t* NKP = (const bf16_t*)(ws + WS_NK); const bf16_t* NVP = (const bf16_t*)(ws + WS_NVT);
    const bf16_t* NGt = (const bf16_t*)a.out + (size_t)NTOK * 1024;
    bf16_t* KM = (bf16_t*)(lds + NA_KM); bf16_t* VM = (bf16_t*)(lds + NA_VM); float* RPB = (float*)(lds + NA_RPB); float* MB = (float*)(lds + NA_MB);
    const int tid = wave * 64 + lane;
    for (int task = vcu; task < 256; task += G) {
        const int b = task >> 7, h = (task >> 3) & 15, r0 = (task & 7) * 16;
        const bf16_t* kbase = NKP + (size_t)((b * 16 + h) * 128) * 4096; const bf16_t* vbase = NVP + (size_t)((b * 16 + h) * 128) * 4096;
        for (int m = wave; m < 16; m += NWAVES) { const int d = lane;
            const float v = ZM[(size_t)m * NIN + 256 * (12 + (h >> 2)) + 128 * (d >> 5) + 32 * (h & 3) + (d & 31)];
            const float rstd = 1.0f / sqrtf(wave_sum(v * v) * (1.f / 64.f) + RMS_EPS);
            KM[m * 64 + d] = (bf16_t)(pk2(v * rstd * a.kn_g[d], 0.f) & 0xffffu); }
        for (int e = tid; e < 1024; e += 512) { const int m = e & 15, d = e >> 4;
            VM[e] = (bf16_t)(pk2(ZM[(size_t)m * NIN + 256 * (24 + (h >> 2)) + 64 * (h & 3) + d], 0.f) & 0xffffu); }
        if (tid < 465) RPB[tid] = a.rpb[h * 465 + tid] * LOG2E;
        if (tid < 16) MB[tid] = a.meta_bias[h * 16 + tid] * LOG2E;
        const int lo = na_rs(r0);
        if (wave >= 4) {
            const int lw = wave - 4;
            for (int x = lo; x < lo + 8; ++x) na_stage_row(kbase + (size_t)x * 4096, vbase + (size_t)x * 4096, lds + (x % NA_NSLOT) * NA_SLOT, lw, lane);
            asm volatile("s_waitcnt vmcnt(0)" ::: "memory");
            NA_BAR();
            for (int r = r0; r < r0 + 16; ++r) {
                if (r + 1 < r0 + 16 && na_rs(r + 1) > na_rs(r)) { const int x = na_rs(r + 1) + 7;
                    na_stage_row(kbase + (size_t)x * 4096, vbase + (size_t)x * 4096, lds + (x % NA_NSLOT) * NA_SLOT, lw, lane); }
                asm volatile("s_waitcnt vmcnt(0)" ::: "memory");
                NA_BAR();
            }
            continue;
        }
        const int n = lane & 15, q4 = lane >> 4, qt = wave;
        const int c0 = (qt == 0) ? 0 : (qt == 1) ? 8 : (qt == 2) ? 24 : 32;
        const int qc = 16 * qt + n;
        int cs = qc - 8; cs = cs < 0 ? 0 : (cs > 48 ? 48 : cs);
        bf16x8 qf[2], qn[2];
        { const size_t qtok = (size_t)b * SEQ + r0 * 64 + qc;
#pragma unroll
          for (int ks = 0; ks < 2; ++ks) qf[ks] = *(const bf16x8*)(AO + qtok * 2048 + 1024 + h * 64 + 32 * ks + 8 * q4); }
        int koff[2][2];
#pragma unroll
        for (int t = 0; t < 2; ++t) { const int key = c0 + 8 * (n >> 2) + 4 * t + (n & 3); const int f = ((key & 3) << 2) | ((key >> 3) & 3);
#pragma unroll
            for (int ks = 0; ks < 2; ++ks) koff[t][ks] = ((key >> 1) * 16 + ((((key & 1) * 8) + 4 * ks + q4) ^ f)) * 16; }
        int voff[4];
#pragma unroll
        for (int dt = 0; dt < 4; ++dt) { const int d = 16 * dt + n, uk = (c0 >> 3) + q4; voff[dt] = 8192 + ((d >> 1) * 16 + ((((d & 1) * 8) + uk) ^ ((d >> 1) & 7))) * 16; }
        float madd[2][4]; int boff[2][4];
#pragma unroll
        for (int t = 0; t < 2; ++t)
#pragma unroll
            for (int i = 0; i < 4; ++i) { const int kc = c0 + 8 * q4 + 4 * t + i; const bool valid = (kc >= cs) && (kc < cs + 16);
                int dcol = kc - qc + 15; dcol = dcol < 0 ? 0 : (dcol > 30 ? 30 : dcol); madd[t][i] = valid ? 0.f : -1e30f; boff[t][i] = dcol * 4; }
        NA_BAR();
        for (int r = r0; r < r0 + 16; ++r) {
            const int rs = na_rs(r);
            const size_t qtok = (size_t)b * SEQ + r * 64 + qc;
            if (r + 1 < r0 + 16) {
#pragma unroll
                for (int ks = 0; ks < 2; ++ks) qn[ks] = *(const bf16x8*)(AO + (qtok + 64) * 2048 + 1024 + h * 64 + 32 * ks + 8 * q4);
            }
            u32x2 gw[4];
#pragma unroll
            for (int dt = 0; dt < 4; ++dt) gw[dt] = *(const u32x2*)(NGt + qtok * 1024 + h * 64 + 16 * dt + 4 * q4);
            f32x4 sc[17];
#pragma unroll
            for (int kr = 0; kr < 8; ++kr) {
                const unsigned char* slot = lds + ((rs + kr) % NA_NSLOT) * NA_SLOT;
#pragma unroll
                for (int t = 0; t < 2; ++t) {
                    const bf16x8 k0 = *(const bf16x8*)(slot + koff[t][0]);
                    const bf16x8 k1 = *(const bf16x8*)(slot + koff[t][1]);
                    f32x4 z = {0.f, 0.f, 0.f, 0.f};
                    z = MFMA16(k0, qf[0], z); z = MFMA16(k1, qf[1], z);
                    sc[2 * kr + t] = z;
                }
            }
            {
                const bf16x8 k0 = *(const bf16x8*)(KM + n * 64 + 8 * q4);
                const bf16x8 k1 = *(const bf16x8*)(KM + n * 64 + 32 + 8 * q4);
                f32x4 z = {0.f, 0.f, 0.f, 0.f};
                z = MFMA16(k0, qf[0], z); z = MFMA16(k1, qf[1], z);
                sc[16] = z;
            }
            float mx = -1e30f;
            const unsigned char* rpb0 = (const unsigned char*)RPB + (rs - r + 7) * 124;
#pragma unroll
            for (int kr = 0; kr < 8; ++kr) {
#pragma unroll
                for (int t = 0; t < 2; ++t)
#pragma unroll
                    for (int i = 0; i < 4; ++i) {
                        const float bias = *(const float*)(rpb0 + kr * 124 + boff[t][i]);
                        const float sv = sc[2 * kr + t][i] + (bias + madd[t][i]);
                        sc[2 * kr + t][i] = sv; mx = fmaxf(mx, sv);
                    }
            }
#pragma unroll
            for (int i = 0; i < 4; ++i) { const float sv = sc[16][i] + MB[4 * q4 + i]; sc[16][i] = sv; mx = fmaxf(mx, sv); }
            mx = fmaxf(mx, __shfl_xor(mx, 16)); mx = fmaxf(mx, __shfl_xor(mx, 32));
            float sum = 0.f;
#pragma unroll
            for (int j = 0; j < 17; ++j)
#pragma unroll
                for (int i = 0; i < 4; ++i) { const float pp = __builtin_amdgcn_exp2f(sc[j][i] - mx); sc[j][i] = pp; sum += pp; }
            sum += __shfl_xor(sum, 16); sum += __shfl_xor(sum, 32);
            const float inv = 1.0f / sum;
            f32x4 o[4];
#pragma unroll
            for (int dt = 0; dt < 4; ++dt) o[dt] = (f32x4){0.f, 0.f, 0.f, 0.f};
#pragma unroll
            for (int kr = 0; kr < 8; ++kr) {
                const unsigned char* slot = lds + ((rs + kr) % NA_NSLOT) * NA_SLOT;
                u32x4 pw; pw.x = pk2(sc[2 * kr][0], sc[2 * kr][1]); pw.y = pk2(sc[2 * kr][2], sc[2 * kr][3]); pw.z = pk2(sc[2 * kr + 1][0], sc[2 * kr + 1][1]); pw.w = pk2(sc[2 * kr + 1][2], sc[2 * kr + 1][3]);
                const bf16x8 pf = __builtin_bit_cast(bf16x8, pw);
#pragma unroll
                for (int dt = 0; dt < 4; ++dt) { const bf16x8 vf = *(const bf16x8*)(slot + voff[dt]); o[dt] = MFMA16(vf, pf, o[dt]); }
            }
            {
                u32x4 pw; pw.x = pk2(sc[16][0], sc[16][1]); pw.y = pk2(sc[16][2], sc[16][3]); pw.z = 0u; pw.w = 0u;
                const bf16x8 pf = __builtin_bit_cast(bf16x8, pw);
#pragma unroll
                for (int dt = 0; dt < 4; ++dt) {
                    const u32x2 lo2 = *(const u32x2*)(VM + ((16 * dt + n) * 16 + 4 * q4));
                    u32x4 vw; vw.x = lo2.x; vw.y = lo2.y; vw.z = 0u; vw.w = 0u;
                    o[dt] = MFMA16(__builtin_bit_cast(bf16x8, vw), pf, o[dt]);
                }
            }
#pragma unroll
            for (int dt = 0; dt < 4; ++dt) {
                const int d0 = h * 64 + 16 * dt + 4 * q4;
                const float g0 = __uint_as_float(gw[dt].x << 16), g1 = __uint_as_float(gw[dt].x & 0xffff0000u), g2 = __uint_as_float(gw[dt].y << 16), g3 = __uint_as_float(gw[dt].y & 0xffff0000u);
                u32x2 w; w.x = pk2(o[dt][0] * inv * g0, o[dt][1] * inv * g1); w.y = pk2(o[dt][2] * inv * g2, o[dt][3] * inv * g3);
                *(u32x2*)(ODST + qtok * ostride + d0) = w;
            }
            qf[0] = qn[0]; qf[1] = qn[1];
            NA_BAR();
        }
    }
}

constexpr int PREP_LD = 136;
constexpr int PREP_TILE = 64 * PREP_LD * 2;
constexpr int PREP_R = 4 * PREP_TILE, PREP_PART = PREP_R + 8192;
DI float logsig16(float x) { return (fminf(x, 0.f) - __logf(1.f + __expf(-fabsf(x)))) * (1.f / 16.f); }
DI int phys_gk(int c) { return phys_norm(2 + (c >> 8), c & 255); }
DI void prep_phase(const Args& a, unsigned char* lds, int vcu, int G, int wave, int lane) {
    unsigned char* ws = a.ws;
    const float* ZM = (const float*)(ws + WS_ZM); const float* R = (const float*)(ws + WS_R);
    const bf16_t* QG = (const bf16_t*)(ws + WS_QG); const bf16_t* KG = (const bf16_t*)(ws + WS_KG);
    unsigned char* PKF = ws + WS_PKF; unsigned char* PKB = ws + WS_PKB; bf16_t* VMT = (bf16_t*)(ws + WS_VMT);
    const int tid = wave * 64 + lane;
    bf16_t* T_QF = (bf16_t*)(lds); bf16_t* T_KF = (bf16_t*)(lds + PREP_TILE); bf16_t* T_QB = (bf16_t*)(lds + 2 * PREP_TILE); bf16_t* T_KB = (bf16_t*)(lds + 3 * PREP_TILE);
    float* RS = (float*)(lds + PREP_R); float* PART = (float*)(lds + PREP_PART);
    for (int task = vcu; task < 1024 + 8; task += G) {
        if (task >= 1024) {
            const int mt = task - 1024, b = mt >> 2, h = mt & 3;
            unsigned char* pk = PKF + (size_t)((b * 4 + h) * 129) * PK_BYTES;
            for (int p = tid; p < PK_BYTES / 16; p += 512) *(u32x4*)(pk + p * 16) = (u32x4){0u, 0u, 0u, 0u};
            __syncthreads();
            if (tid < 128) { const int d = tid;
                float wd[16];
#pragma unroll
                for (int k = 0; k < 16; ++k) wd[k] = a.wd_f[k * 512 + h * 128 + d];
                const float bd = a.bd_f[h * 128 + d];
                float G_[16]; float run = 0.f;
#pragma unroll
                for (int m = 0; m < 16; ++m) { float dot = bd;
#pragma unroll
                    for (int k = 0; k < 16; ++k) dot += ZM[(size_t)m * NIN + 7168 + k] * wd[k];
                    run += logsig16(dot); G_[m] = run; }
                unsigned kw[8];
#pragma unroll
                for (int m = 0; m < 16; m += 2) { const float k0 = ZM[(size_t)m * NIN + phys_gk(h * 128 + d)] * __expf(run - G_[m]);
                    const float k1 = ZM[(size_t)(m + 1) * NIN + phys_gk(h * 128 + d)] * __expf(run - G_[m + 1]); kw[m >> 1] = pk2(k0, k1); }
                const int dt = d >> 5, r = d & 31;
                *(u32x4*)(pk + (dt * 4 + 3) * 1024 + (0 * 32 + r) * 16) = (u32x4){kw[0], kw[1], kw[2], kw[3]};
                *(u32x4*)(pk + (dt * 4 + 3) * 1024 + (1 * 32 + r) * 16) = (u32x4){kw[4], kw[5], kw[6], kw[7]};
                *(float*)(pk + PK_A_OFF + d * 4) = 1.0f;
            }
            if (b == 0 && tid < 256) { const int v = tid; const int c = h * 256 + v; bf16_t* row = VMT + (size_t)c * 64;
                for (int j = 0; j < 48; j += 8) *(u32x4*)(row + j) = (u32x4){0u, 0u, 0u, 0u};
                unsigned vw[8];
#pragma unroll
                for (int m = 0; m < 16; m += 2) vw[m >> 1] = pk2(ZM[(size_t)m * NIN + 256 * (20 + (c >> 8)) + (c & 255)], ZM[(size_t)(m + 1) * NIN + 256 * (20 + (c >> 8)) + (c & 255)]);
                *(u32x4*)(row + 48) = (u32x4){vw[0], vw[1], vw[2], vw[3]}; *(u32x4*)(row + 56) = (u32x4){vw[4], vw[5], vw[6], vw[7]}; }
            __syncthreads();
            continue;
        }
        const int b = task >> 9, h = (task >> 7) & 3, c = task & 127;
        const size_t tok0 = (size_t)b * SEQ + c * 64;
        unsigned char* pkf = PKF + (size_t)((b * 4 + h) * 129 + 1 + c) * PK_BYTES;
        unsigned char* pkb = PKB + (size_t)((b * 4 + h) * 128 + c) * PK_BYTES;
        { const f32x4* src = (const f32x4*)(R + tok0 * 32); ((f32x4*)RS)[tid] = src[tid]; }
        const int d = tid & 127, tq = tid >> 7;
        bf16_t qv[16], kv[16];
#pragma unroll
        for (int jj = 0; jj < 16; ++jj) { qv[jj] = QG[(tok0 + 16 * tq + jj) * 512 + h * 128 + d]; kv[jj] = KG[(tok0 + 16 * tq + jj) * 512 + h * 128 + d]; }
        float wf[16], wb[16];
#pragma unroll
        for (int k = 0; k < 16; ++k) { wf[k] = a.wd_f[k * 512 + h * 128 + d]; wb[k] = a.wd_b[k * 512 + h * 128 + d]; }
        const float bf_ = a.bd_f[h * 128 + d], bb_ = a.bd_b[h * 128 + d];
        __syncthreads();
        float pf[16], pb[16];
        { float rf = 0.f, rb = 0.f;
#pragma unroll
          for (int jj = 0; jj < 16; ++jj) { const float* rr = RS + (16 * tq + jj) * 32; float df = bf_, db = bb_;
#pragma unroll
              for (int k4 = 0; k4 < 4; ++k4) { const f32x4 x0 = *(const f32x4*)(rr + 4 * k4), x1 = *(const f32x4*)(rr + 16 + 4 * k4);
                  df += x0[0] * wf[4 * k4] + x0[1] * wf[4 * k4 + 1] + x0[2] * wf[4 * k4 + 2] + x0[3] * wf[4 * k4 + 3];
                  db += x1[0] * wb[4 * k4] + x1[1] * wb[4 * k4 + 1] + x1[2] * wb[4 * k4 + 2] + x1[3] * wb[4 * k4 + 3]; }
              rf += logsig16(df); rb += logsig16(db); pf[jj] = rf; pb[jj] = rb; }
          PART[(0 * 4 + tq) * 128 + d] = rf; PART[(1 * 4 + tq) * 128 + d] = rb; }
        __syncthreads();
        float offf = 0.f, totf = 0.f, offb = 0.f, totb = 0.f;
#pragma unroll
        for (int q = 0; q < 4; ++q) { const float tf = PART[(0 * 4 + q) * 128 + d], tb = PART[(1 * 4 + q) * 128 + d]; totf += tf; totb += tb; if (q < tq) offf += tf; if (q > tq) offb += tb; }
        const float mytb = pb[15];
        unsigned ksf[8], ksb[8];
#pragma unroll
        for (int jj = 0; jj < 16; jj += 2) {
            float kstf[2], kstb[2];
#pragma unroll
            for (int e = 0; e < 2; ++e) { const int j = 16 * tq + jj + e;
                const float q = bf2f(qv[jj + e]), k = bf2f(kv[jj + e]);
                const float Gf = offf + pf[jj + e];
                const float Gb = offb + (mytb - ((jj + e) ? pb[jj + e - 1] : 0.f));
                const float ef = __expf(Gf), eb = __expf(Gb);
                T_QF[j * PREP_LD + d] = (bf16_t)(pk2(q * ef, 0.f) & 0xffffu);
                T_KF[j * PREP_LD + d] = (bf16_t)(pk2(k * __expf(-Gf), 0.f) & 0xffffu);
                T_QB[j * PREP_LD + d] = (bf16_t)(pk2(q * eb, 0.f) & 0xffffu);
                T_KB[j * PREP_LD + d] = (bf16_t)(pk2(k * __expf(-Gb), 0.f) & 0xffffu);
                kstf[e] = k * __expf(totf - Gf); kstb[e] = k * __expf(totb - Gb); }
            ksf[jj >> 1] = pk2(kstf[0], kstf[1]); ksb[jj >> 1] = pk2(kstb[0], kstb[1]);
        }
        { const int dt = d >> 5, r = d & 31;
          *(u32x4*)(pkf + (dt * 4 + tq) * 1024 + (0 * 32 + r) * 16) = (u32x4){ksf[0], ksf[1], ksf[2], ksf[3]};
          *(u32x4*)(pkf + (dt * 4 + tq) * 1024 + (1 * 32 + r) * 16) = (u32x4){ksf[4], ksf[5], ksf[6], ksf[7]};
          *(u32x4*)(pkb + (dt * 4 + tq) * 1024 + (0 * 32 + r) * 16) = (u32x4){ksb[0], ksb[1], ksb[2], ksb[3]};
          *(u32x4*)(pkb + (dt * 4 + tq) * 1024 + (1 * 32 + r) * 16) = (u32x4){ksb[4], ksb[5], ksb[6], ksb[7]};
          if (tq == 0) { *(float*)(pkf + PK_A_OFF + d * 4) = __expf(totf); *(float*)(pkb + PK_A_OFF + d * 4) = __expf(totb); } }
        __syncthreads();
        {
            const int dir = wave >> 2, jt = (wave >> 1) & 1, it = wave & 1;
            const bf16_t* TQ = dir ? T_QB : T_QF; const bf16_t* TK = dir ? T_KB : T_KF; unsigned char* pk = dir ? pkb : pkf;
            const int rho = lane & 31, hh = lane >> 5;
            const int pj = (rho & ~12) | ((rho & 4) << 1) | ((rho & 8) >> 1);
            const int jrow = 32 * jt + pj, icol = 32 * it + rho;
            f32x16 acc;
#pragma unroll
            for (int i = 0; i < 16; ++i) acc[i] = 0.f;
#pragma unroll
            for (int kd = 0; kd < 8; ++kd) { const bf16x8 af = *(const bf16x8*)(TK + jrow * PREP_LD + 16 * kd + 8 * hh); const bf16x8 bfr = *(const bf16x8*)(TQ + icol * PREP_LD + 16 * kd + 8 * hh);
                acc = MFMA32(af, bfr, acc); }
#pragma unroll
            for (int s = 0; s < 2; ++s) {
                unsigned w[4];
#pragma unroll
                for (int e = 0; e < 8; e += 2) {
                    float v[2];
#pragma unroll
                    for (int x = 0; x < 2; ++x) { const int j = 32 * jt + 16 * s + 8 * hh + e + x; const bool keep = dir ? (j >= icol) : (j <= icol); v[x] = keep ? acc[8 * s + e + x] : 0.f; }
                    w[e >> 1] = pk2(v[0], v[1]);
                }
                *(u32x4*)(pk + (32 + it * 4 + 2 * jt + s) * 1024 + lane * 16) = (u32x4){w[0], w[1], w[2], w[3]};
            }
#pragma unroll
            for (int ff = 0; ff < 4; ++ff) { const int f = (wave & 3) * 4 + ff, it2 = f >> 3, kd = f & 7;
                const bf16_t* rowp = TQ + (32 * it2 + rho) * PREP_LD + 16 * kd + 4 * hh;
                const u32x2 lo = *(const u32x2*)(rowp), hi = *(const u32x2*)(rowp + 8);
                *(u32x4*)(pk + (16 + f) * 1024 + lane * 16) = (u32x4){lo.x, lo.y, hi.x, hi.y}; }
        }
        __syncthreads();
    }
}

constexpr int SCAN_BUF = 46080;
constexpr int SCAN_VT = 41984;
constexpr int SCAN_OST = 3 * SCAN_BUF;
DI bf16x8 pack8(const f32x16& x, int s) {
    u32x4 p; p.x = pk2(x[8 * s], x[8 * s + 1]); p.y = pk2(x[8 * s + 2], x[8 * s + 3]); p.z = pk2(x[8 * s + 4], x[8 * s + 5]); p.w = pk2(x[8 * s + 6], x[8 * s + 7]);
    return __builtin_bit_cast(bf16x8, p);
}
#define SCAN_BAR() do { asm volatile("s_waitcnt lgkmcnt(0)" ::: "memory"); __builtin_amdgcn_s_barrier(); asm volatile("" ::: "memory"); } while (0)
#define SCAN_LDF(f) (*(const bf16x8*)(buf + (f) * 1024 + lane * 16))
constexpr int SCAN_SLOT = 33 * 1024, SCAN_NSLOT = 4;
constexpr int SCAN_UB = SCAN_NSLOT * SCAN_SLOT;
constexpr int SCAN_XO = SCAN_UB + 16384;
DI void scan_stage(const unsigned char* src, const bf16_t* vsrc, int vstride, unsigned char* dst, int lw, int ih, int lane) {
#pragma unroll
    for (int k = 0; k < 7; ++k) { const int i = 5 * k + lw; if (i >= 33) continue;
        if (i < 29) { const int q = (i < 16) ? i : (i < 24) ? (16 + 8 * ih + (i - 16)) : (i < 28) ? (32 + 4 * ih + (i - 24)) : 40;
            __builtin_amdgcn_global_load_lds((const unsigned*)(src + (size_t)q * 1024 + lane * 16), (PG8_LAS unsigned*)(dst + i * 1024), 16, 0, 0); }
        else __builtin_amdgcn_global_load_lds((const unsigned*)(vsrc + (size_t)(i - 29) * vstride), (PG8_LAS unsigned*)(dst + i * 1024), 16, 0, 0); }
}
DI void scan_phase(const Args& a, unsigned char* lds, int wave, int lane) {
    const int sb = blockIdx.x; if (sb >= 256) return;
    unsigned char* ws = a.ws;
    const int stream = sb & 15, eighth = (sb >> 4) & 7, ih = sb >> 7;
    const int b = stream >> 3, dir = (stream >> 2) & 1, h = stream & 3;
    const int nsteps = dir ? 128 : 129;
    const unsigned char* pkbase = dir ? (ws + WS_PKB + (size_t)((b * 4 + h) * 128) * PK_BYTES) : (ws + WS_PKF + (size_t)((b * 4 + h) * 129) * PK_BYTES);
    const bf16_t* VP = (const bf16_t*)(ws + WS_VGT); const bf16_t* VMT = (const bf16_t*)(ws + WS_VMT);
    const int vcol0 = h * 256 + eighth * 32;
#define SCAN_PKIDX(s_) (dir ? (127 - (s_)) : (s_))
#define SCAN_STAGE(s_) do { const int ss_ = (s_); \
        if (dir == 0 && ss_ == 0) scan_stage(pkbase, VMT + (size_t)(vcol0 + (lane & 31)) * 64 + 8 * (lane >> 5), 16, lds + (size_t)(ss_ & 3) * SCAN_SLOT, lw, ih, lane); \
        else { const int cc_ = dir ? (127 - ss_) : (ss_ - 1); \
            scan_stage(pkbase + (size_t)SCAN_PKIDX(ss_) * PK_BYTES, VP + ((size_t)((b * 4 + h) * 128 + cc_) * 8 + eighth) * 2048 + lane * 8, 512, lds + (size_t)(ss_ & 3) * SCAN_SLOT, lw, ih, lane); } } while (0)
#define SCAN_LWAIT2() do { if (lw < 3) asm volatile("s_waitcnt vmcnt(14)" ::: "memory"); else asm volatile("s_waitcnt vmcnt(12)" ::: "memory"); } while (0)
#define SCAN_LWAIT() do { if (lw < 3) asm volatile("s_waitcnt vmcnt(7)" ::: "memory"); else asm volatile("s_waitcnt vmcnt(6)" ::: "memory"); } while (0)
    if (wave >= 3) {
        const int lw = wave - 3;
        SCAN_STAGE(0); SCAN_STAGE(1); SCAN_STAGE(2);
        SCAN_LWAIT2();
        SCAN_BAR();
        for (int n = 0; n < nsteps; ++n) {
            if (n + 3 < nsteps) { SCAN_STAGE(n + 3); SCAN_LWAIT2(); }
            else if (n + 2 < nsteps) SCAN_LWAIT();
            else asm volatile("s_waitcnt vmcnt(0)" ::: "memory");
            SCAN_BAR();
        }
        return;
    }
    unsigned char* SF = lds + SCAN_UB; unsigned char* XO = lds + SCAN_XO;
    const int r = lane & 31, hh = lane >> 5;
    if (wave < 2) {
        f32x16 S[2];
#pragma unroll
        for (int dt = 0; dt < 2; ++dt)
#pragma unroll
            for (int i = 0; i < 16; ++i) S[dt][i] = 0.f;
#pragma unroll
        for (int f = 0; f < 8; ++f) *(u32x4*)(SF + (wave * 8 + f) * 1024 + lane * 16) = (u32x4){0u, 0u, 0u, 0u};
        SCAN_BAR();
        for (int n = 0; n < nsteps; ++n) {
            const unsigned char* buf = lds + (size_t)(n & 3) * SCAN_SLOT;
            bf16x8 vt[4], kf[8];
            f32x4 av[8];
#pragma unroll
            for (int i = 0; i < 8; ++i) av[i] = *(const f32x4*)(buf + 28 * 1024 + (64 * wave + 32 * (i >> 2) + 8 * (i & 3) + 4 * hh) * 4);
#pragma unroll
            for (int ks = 0; ks < 4; ++ks) vt[ks] = *(const bf16x8*)(buf + (29 + ks) * 1024 + lane * 16);
#pragma unroll
            for (int ks = 0; ks < 4; ++ks)
#pragma unroll
                for (int dt = 0; dt < 2; ++dt) kf[dt * 4 + ks] = SCAN_LDF((2 * wave + dt) * 4 + ks);
#pragma unroll
            for (int dt = 0; dt < 2; ++dt)
#pragma unroll
                for (int g4 = 0; g4 < 4; ++g4) { const f32x4 v = av[4 * dt + g4]; S[dt][4 * g4] *= v[0]; S[dt][4 * g4 + 1] *= v[1]; S[dt][4 * g4 + 2] *= v[2]; S[dt][4 * g4 + 3] *= v[3]; }
#pragma unroll
            for (int ks = 0; ks < 4; ++ks)
#pragma unroll
                for (int dt = 0; dt < 2; ++dt) S[dt] = MFMA32(kf[dt * 4 + ks], vt[ks], S[dt]);
            unsigned char* sfo = SF + (n & 1) * 8192;
#pragma unroll
            for (int dt = 0; dt < 2; ++dt) { const bf16x8 s0 = pack8(S[dt], 0), s1 = pack8(S[dt], 1);
                *(bf16x8*)(sfo + (4 * wave + 2 * dt) * 1024 + lane * 16) = s0; *(bf16x8*)(sfo + (4 * wave + 2 * dt + 1) * 1024 + lane * 16) = s1; }
            SCAN_BAR();
        }
        return;
    }
    bf16_t* OUT = dir ? (bf16_t*)(ws + WS_OB) : (bf16_t*)(ws + WS_AO); const int ldo = dir ? 1024 : 2048;
    SCAN_BAR();
    for (int n = 0; n < nsteps; ++n) {
        const unsigned char* buf = lds + (size_t)(n & 3) * SCAN_SLOT;
        if (dir == 0 && n == 0) { SCAN_BAR(); continue; }
        bf16x8 vt[4], qf[8], af[4], sf[8];
#pragma unroll
        for (int kd = 0; kd < 8; ++kd) { qf[kd] = SCAN_LDF(16 + kd); sf[kd] = *(const bf16x8*)(SF + ((n + 1) & 1) * 8192 + kd * 1024 + lane * 16); }
#pragma unroll
        for (int ks = 0; ks < 4; ++ks) { vt[ks] = *(const bf16x8*)(buf + (29 + ks) * 1024 + lane * 16); af[ks] = SCAN_LDF(24 + ks); }
        f32x16 oa, ob;
#pragma unroll
        for (int i = 0; i < 16; ++i) { oa[i] = 0.f; ob[i] = 0.f; }
#pragma unroll
        for (int kd = 0; kd < 4; ++kd) { oa = MFMA32(sf[kd], qf[kd], oa); ob = MFMA32(sf[4 + kd], qf[4 + kd], ob); }
        oa = MFMA32(vt[0], af[0], oa); ob = MFMA32(vt[2], af[2], ob);
        oa = MFMA32(vt[1], af[1], oa); ob = MFMA32(vt[3], af[3], ob);
        { const int c = dir ? (127 - n) : (n - 1);
          bf16_t* op = OUT + ((size_t)b * SEQ + c * 64 + 32 * ih + r) * ldo + vcol0 + 4 * hh;
#pragma unroll
          for (int g4 = 0; g4 < 4; ++g4) { u32x2 w; w.x = pk2(oa[4 * g4] + ob[4 * g4], oa[4 * g4 + 1] + ob[4 * g4 + 1]); w.y = pk2(oa[4 * g4 + 2] + ob[4 * g4 + 2], oa[4 * g4 + 3] + ob[4 * g4 + 3]);
              *(u32x2*)(op + 8 * g4) = w; } }
        SCAN_BAR();
    }
}

DI void combine_phase(const Args& a, int vcu, int G, int wave, int lane, bf16_t* CDST, int cstride) {
    unsigned char* ws = a.ws;
    bf16_t* AO = (bf16_t*)(ws + WS_AO); const bf16_t* OB = (const bf16_t*)(ws + WS_OB); const bf16_t* GG = (const bf16_t*)a.out;
    const int gw = vcu * NWAVES + wave, NGW = G * NWAVES;
    const f32x4 gn = *(const f32x4*)(a.gla_g + 4 * lane);
    for (int tok = gw; tok < NTOK; tok += NGW) {
        u32x2 f[4], bq[4], gg[4];
#pragma unroll
        for (int h = 0; h < 4; ++h) { f[h] = *(const u32x2*)(AO + (size_t)tok * 2048 + h * 256 + 4 * lane);
            bq[h] = *(const u32x2*)(OB + (size_t)tok * 1024 + h * 256 + 4 * lane); gg[h] = *(const u32x2*)(GG + (size_t)tok * 1024 + h * 256 + 4 * lane); }
#pragma unroll
        for (int h = 0; h < 4; ++h) {
            float o[4];
            o[0] = __uint_as_float(f[h].x << 16) + __uint_as_float(bq[h].x << 16); o[1] = __uint_as_float(f[h].x & 0xffff0000u) + __uint_as_float(bq[h].x & 0xffff0000u);
            o[2] = __uint_as_float(f[h].y << 16) + __uint_as_float(bq[h].y << 16); o[3] = __uint_as_float(f[h].y & 0xffff0000u) + __uint_as_float(bq[h].y & 0xffff0000u);
            const float ss = wave_sum((o[0] * o[0] + o[1] * o[1]) + (o[2] * o[2] + o[3] * o[3]));
            const float rstd = 1.0f / sqrtf(ss * (1.f / 256.f) + RMS_EPS);
            const float g0 = __uint_as_float(gg[h].x << 16), g1 = __uint_as_float(gg[h].x & 0xffff0000u), g2 = __uint_as_float(gg[h].y << 16), g3 = __uint_as_float(gg[h].y & 0xffff0000u);
            u32x2 w; w.x = pk2(o[0] * rstd * gn[0] * g0, o[1] * rstd * gn[1] * g1); w.y = pk2(o[2] * rstd * gn[2] * g2, o[3] * rstd * gn[3] * g3);
            *(u32x2*)(CDST + (size_t)tok * cstride + h * 256 + 4 * lane) = w;
        }
    }
}

#define LAS __attribute__((address_space(3)))
#define XB_TMO      128
#define XB_XCNT(j)  (256  + 64 * (j))
#define XB_XSUB(j)  (1280 + 64 * (j))
#define XB_XGEN(j)  (2304 + 64 * (j))
#define XB_TOP      3328
#define XB_TOPGEN   3392
#define XCD_BAR_WORDS 3456
#define XB_SPIN_CAP (1u << 18)

__device__ __forceinline__ unsigned xb_ld(unsigned* p)              { return __hip_atomic_load(p, __ATOMIC_RELAXED, __HIP_MEMORY_SCOPE_AGENT); }
__device__ __forceinline__ unsigned xb_add(unsigned* p, unsigned v) { return __hip_atomic_fetch_add(p, v, __ATOMIC_RELAXED, __HIP_MEMORY_SCOPE_AGENT); }
__device__ __forceinline__ unsigned xb_xcc_id() { return (unsigned)__builtin_amdgcn_s_getreg((3 << 11) | 20) & 0xFu; }
#define XB_SPIN(cond, bar) do { unsigned _sp = 0; while (cond) { __builtin_amdgcn_s_sleep(1); \
    if ((++_sp & 255u) == 0u) { if (xb_ld(&(bar)[XB_TMO])) break; if (_sp > XB_SPIN_CAP) { atomicAdd(&(bar)[XB_TMO], 1u); break; } } } } while (0)

struct XcdBarrier {
    unsigned* bar; unsigned x;
    volatile LAS unsigned* st;
};

__device__ __forceinline__ XcdBarrier xcd_barrier_post(unsigned* bar, volatile LAS unsigned* st) {
    XcdBarrier b; b.bar = bar; b.x = xb_xcc_id(); b.st = st;
    if (threadIdx.x == 0) (void)xb_add(&bar[XB_XCNT(b.x)], 1u);
    return b;
}
__device__ __forceinline__ void xcd_barrier_complete(unsigned* bar, unsigned x, unsigned& nloc, unsigned& nx) {
    const unsigned G = gridDim.x * gridDim.y * gridDim.z;
    unsigned sum, cnt, mine, sp = 0u;
    for (;;) {
        sum = 0u; cnt = 0u; mine = 0u;
#pragma unroll
        for (unsigned j = 0; j < 16; ++j) { const unsigned c = xb_ld(&bar[XB_XCNT(j)]); sum += c; cnt += (c > 0u) ? 1u : 0u; mine = (j == x) ? c : mine; }
        if (sum == G) break;
        __builtin_amdgcn_s_sleep(1);
        if ((++sp & 255u) == 0u) { if (xb_ld(&bar[XB_TMO])) break; if (sp > XB_SPIN_CAP) { atomicAdd(&bar[XB_TMO], 1u); break; } }
    }
    nloc = mine > 0u ? mine : 1u; nx = cnt > 0u ? cnt : 1u;
}

__device__ __forceinline__ void xcd_barrier(const XcdBarrier& b) {
    asm volatile("s_waitcnt vmcnt(0)" ::: "memory");
    __syncthreads();
    if (threadIdx.x == 0) {
        unsigned* bar = b.bar;
        __builtin_amdgcn_s_waitcnt(0);
        unsigned nloc = b.st[0], nx = b.st[1];
        if (nloc == 0u) { xcd_barrier_complete(bar, b.x, nloc, nx); b.st[0] = nloc; b.st[1] = nx; }
        const unsigned old = xb_add(&bar[XB_XSUB(b.x)], 1u);
        const unsigned gen = old / nloc;
        if (old + 1u == (gen + 1u) * nloc) {
            __builtin_amdgcn_fence(__ATOMIC_RELEASE, "agent");
            asm volatile("s_waitcnt vmcnt(0)" ::: "memory");
            const unsigned og = xb_add(&bar[XB_TOP], 1u);
            const unsigned tg = og / nx;
            if (og + 1u == (tg + 1u) * nx) xb_add(&bar[XB_TOPGEN], 1u);
            else XB_SPIN(xb_ld(&bar[XB_TOPGEN]) == tg, bar);
            __builtin_amdgcn_fence(__ATOMIC_ACQUIRE, "agent");
            xb_add(&bar[XB_XGEN(b.x)], 1u);
            asm volatile("s_waitcnt vmcnt(0)" ::: "memory");
        } else {
            XB_SPIN(xb_ld(&bar[XB_XGEN(b.x)]) == gen, bar);
            __builtin_amdgcn_fence(__ATOMIC_ACQUIRE, "agent");
            asm volatile("s_waitcnt vmcnt(0)" ::: "memory");
        }
    }
    __syncthreads();
}

__global__ void __launch_bounds__(NWAVES * 64, 2) hybrid_fwd(Args args, int ph_lo, int ph_hi) {
    extern __shared__ __attribute__((aligned(16))) unsigned char lds[];
    cg::grid_group grid = cg::this_grid();
    const int tid = threadIdx.x, lane = tid & 63, wave = __builtin_amdgcn_readfirstlane(tid >> 6);
    const int G = gridDim.x, bx = blockIdx.x;
    const int vcu = (G % 8 == 0) ? (bx % 8) * (G / 8) + bx / 8 : bx;
    unsigned char* ws = args.ws;
#ifndef REP_PHASE
#define REP_PHASE -1
#endif
#ifndef PHMASK
#define PHMASK 0x7f
#endif
#define IN(k) (ph_lo <= (k) && (k) < ph_hi && ((PHMASK >> (k)) & 1))
    volatile LAS unsigned* bst = (volatile LAS unsigned*)(lds + LDS_BYTES - 64);
    if (tid < 2) bst[tid] = 0u;
    __syncthreads();
    XcdBarrier bar = xcd_barrier_post((unsigned*)(ws + WS_CTL), bst);
    if (ph_lo < 0) grid.sync();
#define SEAM(k) do { if (IN(k) && IN((k) + 1)) xcd_barrier(bar); } while (0)
    if (IN(0)) { p0_phase(args, lds, vcu, G, wave, lane); if (REP_PHASE == 0 || REP_PHASE == 60) { xcd_barrier(bar); p0_phase(args, lds, vcu, G, wave, lane); } }
    SEAM(0);
    if (IN(1)) {
        p1_skinny(args, vcu, G, wave, lane);
        const bf16_t* XW = (const bf16_t*)(ws + WS_XW);
        pg8::Gemm g{XW, XW, NTOK, 7168, DM};
        OrderIn S{G, bx};
        EpiIn E{(bf16_t*)(ws + WS_QG), (bf16_t*)(ws + WS_KG), (bf16_t*)args.out, (bf16_t*)args.out + (size_t)NTOK * 1024, (bf16_t*)(ws + WS_AO), (bf16_t*)(ws + WS_NK),
                (bf16_t*)(ws + WS_VGT), (bf16_t*)(ws + WS_NVT), args.qn_g, args.kn_g};
        pg8::gemm_phase<EpiIn, OrderIn, true, true>((PG8_LAS unsigned char*)lds, g, S, E);
        }
#if REP_PHASE == 1
    if (IN(1)) { xcd_barrier(bar);
        p1_skinny(args, vcu, G, wave, lane);
        const bf16_t* XW = (const bf16_t*)(ws + WS_XW);
        pg8::Gemm g{XW, XW, NTOK, 7168, DM};
        OrderIn S{G, bx};
        EpiIn E{(bf16_t*)(ws + WS_QG), (bf16_t*)(ws + WS_KG), (bf16_t*)args.out, (bf16_t*)args.out + (size_t)NTOK * 1024, (bf16_t*)(ws + WS_AO), (bf16_t*)(ws + WS_NK),
                (bf16_t*)(ws + WS_VGT), (bf16_t*)(ws + WS_NVT), args.qn_g, args.kn_g};
        pg8::gemm_phase<EpiIn, OrderIn, true, true>((PG8_LAS unsigned char*)lds, g, S, E);
        }
#endif
    SEAM(1);
    if (IN(2)) {
#if REP_PHASE == 2
        na_phase(args, lds, vcu, G, wave, lane, (bf16_t*)(ws + WS_XW), 1024); xcd_barrier(bar);
#endif
        na_phase(args, lds, vcu, G, wave, lane, (bf16_t*)(ws + WS_AO) + 1024, 2048); }
    SEAM(2);
    if (IN(3)) { prep_phase(args, lds, vcu, G, wave, lane); if (REP_PHASE == 3) { xcd_barrier(bar); prep_phase(args, lds, vcu, G, wave, lane); } }
    SEAM(3);
    if (IN(4)) { scan_phase(args, lds, wave, lane); if (REP_PHASE == 4) { xcd_barrier(bar); scan_phase(args, lds, wave, lane); } }
    SEAM(4);
#ifdef REP_SYNC
    for (int i_ = 0; i_ < REP_SYNC; ++i_) xcd_barrier(bar);
#endif
    if (IN(5)) {
#if REP_PHASE == 5
        combine_phase(args, vcu, G, wave, lane, (bf16_t*)(ws + WS_XW), 1024); xcd_barrier(bar);
#endif
        combine_phase(args, vcu, G, wave, lane, (bf16_t*)(ws + WS_AO), 2048); }
    SEAM(5);
    if (IN(6)) {
        pg8::Gemm g{(const bf16_t*)(ws + WS_AO), (const bf16_t*)(ws + WS_WO), NTOK, DM, 2048};
        pg8::StaticOrder S; S.init(NTOK, DM, G, bx);
        EpiOut E{args.x, args.out};
        pg8::gemm_phase<EpiOut, pg8::StaticOrder, false, true>((PG8_LAS unsigned char*)lds, g, S, E);
        }
#if REP_PHASE == 6 || REP_PHASE == 60
    if (IN(6)) { xcd_barrier(bar);
        pg8::Gemm g{(const bf16_t*)(ws + WS_AO), (const bf16_t*)(ws + WS_WO), NTOK, DM, 2048};
        pg8::StaticOrder S; S.init(NTOK, DM, G, bx);
        EpiOut E{args.x, args.out};
        pg8::gemm_phase<EpiOut, pg8::StaticOrder, false, true>((PG8_LAS unsigned char*)lds, g, S, E);
        }
#endif
#ifdef SCAN_DBG
    if (bx == 0 && tid == 0) { const float* dbg = (const float*)(ws + WS_ZM + 480 * 1024); const float ratio = dbg[0] / dbg[1];
        args.out[0] = (DBG_WHAT == 0) ? (ratio < 0.33f ? 100.f : (ratio < 0.66f ? 200.f : 300.f)) : (dbg[1] < 10000.f ? 100.f : (dbg[1] < 15000.f ? 200.f : (dbg[1] < 20000.f ? 300.f : 400.f))); }
#endif
#ifdef SCAN_DBG
    if (bx == 0 && tid == 0) { const float* dbg = (const float*)(ws + WS_ZM + 480 * 1024);
        const float ratio = (DBG_WHAT == 0 ? dbg[0] : dbg[2]) / dbg[1];
        args.out[0] = (DBG_WHAT == 2) ? 100.f * floorf(dbg[1] * (1.f / 100000.f) + 1.f) : 100.f * (1.f + floorf(ratio * 5.f)); }
#endif
#undef IN
#undef SEAM
}

#ifndef N_LAUNCHES
#define N_LAUNCHES 1
#endif
extern "C" void kernel_launch(void* const* d_in, const int* in_sizes, int n_in, void* d_out, int out_size, void* d_ws, size_t ws_size, hipStream_t stream) {
    static int grid = 0;
    if (grid == 0) {
        if (n_in != 14 || out_size != NTOK * DM || ws_size < WS_END) { fprintf(stderr, "kernel_launch: unexpected problem (n_in %d out %d ws %zu)\n", n_in, out_size, ws_size); grid = -1; return; }
        int dev = 0, cus = 0, per_cu = 0;
        hipGetDevice(&dev); hipDeviceGetAttribute(&cus, hipDeviceAttributeMultiprocessorCount, dev);
        if (hipFuncSetAttribute((const void*)hybrid_fwd, hipFuncAttributeMaxDynamicSharedMemorySize, LDS_BYTES) != hipSuccess) { fprintf(stderr, "kernel_launch: hipFuncSetAttribute failed\n"); grid = -1; return; }
        if (hipOccupancyMaxActiveBlocksPerMultiprocessor(&per_cu, (const void*)hybrid_fwd, NWAVES * 64, LDS_BYTES) != hipSuccess || per_cu < 1) { fprintf(stderr, "kernel_launch: occupancy query gave %d\n", per_cu); per_cu = 1; }
        (void)hipGetLastError();
        grid = cus * per_cu;
        if (grid > 256) grid = 256;
    }
    if (grid < 0) return;
    Args a{};
    a.x = (const float*)d_in[0]; a.meta = (const float*)d_in[1]; a.norm_g = (const float*)d_in[2]; a.w_in = (const float*)d_in[3];
    a.wd_f = (const float*)d_in[4]; a.bd_f = (const float*)d_in[5]; a.wd_b = (const float*)d_in[6]; a.bd_b = (const float*)d_in[7];
    a.gla_g = (const float*)d_in[8]; a.qn_g = (const float*)d_in[9]; a.kn_g = (const float*)d_in[10]; a.rpb = (const float*)d_in[11];
    a.meta_bias = (const float*)d_in[12]; a.w_out = (const float*)d_in[13];
    a.out = (float*)d_out; a.ws = (unsigned char*)d_ws;
    if (hipMemsetAsync((char*)d_ws + WS_CTL, 0, 16384, stream) != hipSuccess) { fprintf(stderr, "kernel_launch: memset of the barrier words failed\n"); return; }
#if N_LAUNCHES == 1
    int lo = 0, hi = 7;
    void* kargs[] = {&a, &lo, &hi};
    hipError_t e = hipLaunchCooperativeKernel((const void*)hybrid_fwd, dim3(grid), dim3(NWAVES * 64), kargs, LDS_BYTES, stream);
    if (e != hipSuccess) fprintf(stderr, "kernel_launch: cooperative launch failed: %s (grid %d)\n", hipGetErrorString(e), grid);
#else
    for (int p = 0; p < 7; ++p) hipLaunchKernelGGL(hybrid_fwd, dim3(grid), dim3(NWAVES * 64), LDS_BYTES, stream, a, p, p + 1);
#endif
}
```

```cpp
#include <hip/hip_runtime.h>
#include <hip/hip_cooperative_groups.h>
#include <cstdio>
#include <cstdint>
namespace cg = cooperative_groups;
namespace pg8 {
#define PG8_LAS __attribute__((address_space(3)))
typedef unsigned short bf16_t;
typedef short bf16x8 __attribute__((ext_vector_type(8)));
typedef float f32x4 __attribute__((ext_vector_type(4)));
typedef unsigned u32x4 __attribute__((ext_vector_type(4)));
constexpr int BM = 256, BK = 64, HALF = 128, HTB = HALF * BK * 2  , STAGE_BYTES = 8 * HTB, NXCD = 8, WGM = 8;

__host__ __device__ __forceinline__ int lds_byte(int r, int c) { const int st = (r >> 4) * 2 + (c >> 5), rr = r & 15, cc = c & 31, ob = rr * 64 + cc * 2; return st * 1024 + (ob ^ (((ob >> 9) & 1) << 5)); }
__host__ __device__ __forceinline__ void stage_rc(int b, int& R, int& C) { const int st = b / 1024, sb = b % 1024, swz = sb ^ (((sb >> 9) & 1) << 5); R = (st >> 1) * 16 + swz / 64; C = (st & 1) * 32 + (swz % 64) / 2; }
__host__ __device__ __forceinline__ int perm32(int rho) { const int n = rho >> 4, i = rho & 15; return 8 * (i >> 2) + 4 * n + (i & 3); }

struct Unit { int pm, pn; };
struct Gemm { const bf16_t* A; const bf16_t* Bt; int M, N, K; };

struct StaticOrder {
    int nM, nN, nwg, G, c;
    __host__ __device__ void init(int M, int N, int G_, int c_) { nM = M / BM; nN = N / BM; nwg = nM * nN; G = G_; c = c_; }
    __host__ __device__ bool next(int i, Unit& u) const {
        const long L = (long)i * G + c; if (L >= nwg) return false;
        int wgid = (int)L; { const int q = nwg / NXCD, r = nwg % NXCD, xcd = wgid % NXCD, off = wgid / NXCD; wgid = (xcd < r ? xcd * (q + 1) : r * (q + 1) + (xcd - r) * q) + off; }
        const int nig = WGM * nN, gid = wgid / nig, fm = gid * WGM, gsz = (nM - fm) < WGM ? (nM - fm) : WGM;
        u.pm = fm + ((wgid % nig) % gsz); u.pn = (wgid % nig) / gsz; return true;
    }
    __device__ __forceinline__ void a_ready(const Unit&) const {}
    __device__ __forceinline__ void done(const Unit&) const {}
};

__device__ __forceinline__ unsigned cvt_pk_bf16(float lo, float hi) { unsigned r; asm volatile("v_cvt_pk_bf16_f32 %0, %1, %2" : "=v"(r) : "v"(lo), "v"(hi)); return r; }
template <class Epi, class Sched, bool ALIGN_EPI = false, bool SP2 = false>
__device__ __forceinline__ void gemm_phase(PG8_LAS unsigned char* lds, const Gemm g, const Sched& S, const Epi& E) {
    const int tid = threadIdx.x, wid = __builtin_amdgcn_readfirstlane(tid >> 6), lane = tid & 63, wr = wid >> 2, wc = wid & 3, fr = lane & 15, fq = lane >> 4;
    const int K = g.K, nt = K / BK;
    unsigned voffA[2], voffB[2];
#pragma unroll
    for (int i = 0; i < 2; ++i) { int R, C; stage_rc(tid * 16 + i * 8192, R, C); const int Rb = Epi::PERM ? ((R & ~31) + perm32(R & 31)) : R;
        voffA[i] = (unsigned)(R * K + C) * 2u; voffB[i] = (unsigned)(Rb * K + C) * 2u; }
    const size_t kstep = (size_t)(BK * 2);
    const size_t hstep = (size_t)HALF * K * 2;
    const size_t tstep = 2 * hstep;
    const unsigned ldsw = (unsigned)wid * 1024u;
    const int aoff = lds_byte(wr * 64 + fr, fq * 8), boff = lds_byte(wc * 32 + fr, fq * 8);
#define PG8_SA(b, h) (((b) * 2 + (h)) * HTB)
#define PG8_SB(b, h) ((4 + (b) * 2 + (h)) * HTB)
#define PG8_STAGE(bufoff, gbase, voff) do { _Pragma("unroll") for (int _i = 0; _i < 2; ++_i) \
        __builtin_amdgcn_global_load_lds((const unsigned*)((const char*)(gbase) + (voff)[_i]), (PG8_LAS unsigned*)(lds + (bufoff) + ldsw + _i * 8192), 16, 0, 0); } while (0)
#define PG8_LDA(dst, b, h) do { _Pragma("unroll") for (int m = 0; m < 4; ++m) _Pragma("unroll") for (int k = 0; k < 2; ++k) dst[m][k] = *(const PG8_LAS bf16x8*)(lds + PG8_SA(b, h) + aoff + m * 2048 + k * 1024); } while (0)
#define PG8_LDB(dst, b, h) do { _Pragma("unroll") for (int n = 0; n < 2; ++n) _Pragma("unroll") for (int k = 0; k < 2; ++k) dst[n][k] = *(const PG8_LAS bf16x8*)(lds + PG8_SB(b, h) + boff + n * 2048 + k * 1024); } while (0)
#define PG8_MMA(ai, bj, At, Bt) do { __builtin_amdgcn_s_setprio(1); _Pragma("unroll") for (int m = 0; m < 4; ++m) _Pragma("unroll") for (int n = 0; n < 2; ++n) _Pragma("unroll") for (int k = 0; k < 2; ++k) \
        acc[ai][bj][m][n] = __builtin_amdgcn_mfma_f32_16x16x32_bf16(Bt[n][k], At[m][k], acc[ai][bj][m][n], 0, 0, 0); __builtin_amdgcn_s_setprio(0); } while (0)
#define PG8_WAIT_V(n) asm volatile("s_waitcnt vmcnt(" #n ")" ::: "memory")
#define PG8_WAIT_L(n) asm volatile("s_waitcnt lgkmcnt(" #n ")" ::: "memory")
#define PG8_BAR __builtin_amdgcn_s_barrier()
#define PG8_SCHED __builtin_amdgcn_sched_barrier(0)
    Unit cur, nxt; int ui = 0;
    if (!S.next(0, cur)) return;
    f32x4 acc[2][2][4][2];
#pragma unroll
    for (int a = 0; a < 2; ++a)
#pragma unroll
        for (int b = 0; b < 2; ++b)
#pragma unroll
            for (int m = 0; m < 4; ++m)
#pragma unroll
                for (int n = 0; n < 2; ++n) acc[a][b][m][n] = (f32x4){0.f, 0.f, 0.f, 0.f};
    bf16x8 At[4][2], B0[2][2], B1[2][2];
    const char* cA = (const char*)g.A + (size_t)cur.pm * tstep; const char* cB = (const char*)g.Bt + (size_t)cur.pn * tstep;
    S.a_ready(cur);
    if constexpr (SP2) {
        PG8_STAGE(PG8_SB(0, 0), cB, voffB); PG8_STAGE(PG8_SB(0, 1), cB + hstep, voffB); PG8_STAGE(PG8_SA(0, 0), cA, voffA); PG8_STAGE(PG8_SA(0, 1), cA + hstep, voffA);
        if (wr == 1) PG8_BAR;
        PG8_WAIT_V(2); PG8_BAR;
        PG8_STAGE(PG8_SB(1, 0), cB + kstep, voffB); PG8_STAGE(PG8_SA(1, 0), cA + kstep, voffA); PG8_STAGE(PG8_SB(1, 1), cB + hstep + kstep, voffB);
        PG8_WAIT_V(6); PG8_BAR;
    } else {
        PG8_STAGE(PG8_SB(0, 0), cB, voffB); PG8_STAGE(PG8_SA(0, 0), cA, voffA); PG8_STAGE(PG8_SB(0, 1), cB + hstep, voffB); PG8_STAGE(PG8_SA(0, 1), cA + hstep, voffA);
        if (wr == 1) PG8_BAR;
        PG8_WAIT_V(4); PG8_BAR;
        PG8_STAGE(PG8_SB(1, 0), cB + kstep, voffB); PG8_STAGE(PG8_SA(1, 0), cA + kstep, voffA); PG8_STAGE(PG8_SB(1, 1), cB + hstep + kstep, voffB);
        PG8_WAIT_V(6); PG8_BAR;
    }
    for (;;) {
        const bool has_next = S.next(ui + 1, nxt);
        const char* nA = has_next ? (const char*)g.A + (size_t)nxt.pm * tstep : cA; const char* nB = has_next ? (const char*)g.Bt + (size_t)nxt.pn * tstep : cB;
        for (int t = 0; t < nt; t += 2) {
            const bool last = (t == nt - 2);
            const char* a1 = cA + (size_t)(t + 1) * kstep;
            const char* a2 = last ? nA : cA + (size_t)(t + 2) * kstep; const char* b2 = last ? nB : cB + (size_t)(t + 2) * kstep;
            const char* a3 = a2 + kstep; const char* b3 = b2 + kstep;
            if (last && has_next) S.a_ready(nxt);
            if constexpr (SP2) {
            PG8_LDB(B0, 0, 0); PG8_LDB(B1, 0, 1); PG8_SCHED; PG8_LDA(At, 0, 0); PG8_STAGE(PG8_SA(1, 1), a1 + hstep, voffA);
            PG8_WAIT_V(8); PG8_WAIT_L(0); PG8_BAR; PG8_MMA(0, 0, At, B0); PG8_MMA(0, 1, At, B1); PG8_BAR; PG8_SCHED;
            PG8_LDA(At, 0, 1); PG8_STAGE(PG8_SB(0, 0), b2, voffB); PG8_STAGE(PG8_SB(0, 1), b2 + hstep, voffB); PG8_STAGE(PG8_SA(0, 0), a2, voffA);
            PG8_WAIT_V(8); PG8_WAIT_L(0); PG8_BAR; PG8_MMA(1, 0, At, B0); PG8_MMA(1, 1, At, B1); PG8_BAR; PG8_SCHED;
            PG8_LDB(B0, 1, 0); PG8_LDB(B1, 1, 1); PG8_SCHED; PG8_LDA(At, 1, 0); PG8_STAGE(PG8_SA(0, 1), a2 + hstep, voffA);
            PG8_WAIT_V(8); PG8_WAIT_L(0); PG8_BAR; PG8_MMA(0, 0, At, B0); PG8_MMA(0, 1, At, B1); PG8_BAR; PG8_SCHED;
            PG8_LDA(At, 1, 1); PG8_STAGE(PG8_SB(1, 0), b3, voffB); PG8_STAGE(PG8_SB(1, 1), b3 + hstep, voffB); PG8_STAGE(PG8_SA(1, 0), a3, voffA);
            PG8_WAIT_V(8); PG8_WAIT_L(0); PG8_BAR; PG8_MMA(1, 0, At, B0); PG8_MMA(1, 1, At, B1); PG8_BAR; PG8_SCHED;
            } else {
            PG8_LDB(B0, 0, 0); PG8_SCHED; PG8_LDA(At, 0, 0); PG8_STAGE(PG8_SA(1, 1), a1 + hstep, voffA);
            PG8_WAIT_L(8); PG8_BAR; PG8_WAIT_L(0); PG8_MMA(0, 0, At, B0); PG8_BAR; PG8_SCHED;
            PG8_LDB(B1, 0, 1); PG8_STAGE(PG8_SB(0, 0), b2, voffB);
            PG8_BAR; PG8_WAIT_L(0); PG8_MMA(0, 1, At, B1); PG8_BAR;
            PG8_LDA(At, 0, 1); PG8_STAGE(PG8_SA(0, 0), a2, voffA);
            PG8_BAR; PG8_WAIT_L(0); PG8_MMA(1, 0, At, B0); PG8_BAR; PG8_SCHED;
            PG8_STAGE(PG8_SB(0, 1), b2 + hstep, voffB);
            PG8_WAIT_V(6); PG8_BAR; PG8_MMA(1, 1, At, B1); PG8_BAR;
            PG8_LDB(B0, 1, 0); PG8_SCHED; PG8_LDA(At, 1, 0); PG8_STAGE(PG8_SA(0, 1), a2 + hstep, voffA);
            PG8_WAIT_L(8); PG8_BAR; PG8_WAIT_L(0); PG8_MMA(0, 0, At, B0); PG8_BAR; PG8_SCHED;
            PG8_LDB(B1, 1, 1); PG8_STAGE(PG8_SB(1, 0), b3, voffB);
            PG8_BAR; PG8_WAIT_L(0); PG8_MMA(0, 1, At, B1); PG8_BAR;
            PG8_LDA(At, 1, 1); PG8_STAGE(PG8_SA(1, 0), a3, voffA);
            PG8_BAR; PG8_WAIT_L(0); PG8_MMA(1, 0, At, B0); PG8_BAR; PG8_SCHED;
            PG8_STAGE(PG8_SB(1, 1), b3 + hstep, voffB);
            PG8_WAIT_V(6); PG8_BAR; PG8_MMA(1, 1, At, B1); PG8_BAR;
            }
        }
        if constexpr (ALIGN_EPI) { if (wr == 0) PG8_BAR; }
        if constexpr (!Epi::AFTER_DRAIN) { E(acc, cur, wr, wc, fr, fq); S.done(cur); }
        if (!has_next) break;
#pragma unroll
        for (int a = 0; a < 2; ++a)
#pragma unroll
            for (int b = 0; b < 2; ++b)
#pragma unroll
                for (int m = 0; m < 4; ++m)
#pragma unroll
                    for (int n = 0; n < 2; ++n) acc[a][b][m][n] = (f32x4){0.f, 0.f, 0.f, 0.f};
        cur = nxt; cA = nA; cB = nB; ++ui;
        if constexpr (ALIGN_EPI) { if (wr == 1) PG8_BAR; }
    }
    PG8_WAIT_V(0);
    if constexpr (!ALIGN_EPI) { if (wr == 0) PG8_BAR; }
    PG8_BAR;
    if constexpr (Epi::AFTER_DRAIN) { E.fused(acc, cur, wr, wc, fr, fq, lds, wid, lane); S.done(cur); }
#undef PG8_SA
#undef PG8_SB
#undef PG8_STAGE
#undef PG8_LDA
#undef PG8_LDB
#undef PG8_MMA
#undef PG8_WAIT_V
#undef PG8_WAIT_L
#undef PG8_BAR
#undef PG8_SCHED
}
}

#define DI __device__ __forceinline__
typedef unsigned short bf16_t;
typedef short bf16x8 __attribute__((ext_vector_type(8)));
typedef float f32x4 __attribute__((ext_vector_type(4)));
typedef float f32x2 __attribute__((ext_vector_type(2)));
typedef float f32x16 __attribute__((ext_vector_type(16)));
typedef unsigned u32x4 __attribute__((ext_vector_type(4)));
typedef unsigned u32x2 __attribute__((ext_vector_type(2)));
typedef __bf16 bf2_t __attribute__((ext_vector_type(2)));

constexpr int NTOK = 16384, SEQ = 8192, DM = 1024, NIN = 7200, NWAVES = 8;
constexpr float RMS_EPS = 1e-6f;
constexpr float LOG2E = 1.4426950408889634f;
constexpr size_t MiB = (size_t)1 << 20;
constexpr size_t WS_ZM = 0, WS_VMT = 512 * 1024, WS_UM = 640 * 1024, WS_WS = 704 * 1024, WS_R = 1 * MiB, WS_WO = 3 * MiB, WS_XW = 8 * MiB,
                 WS_AO = 54 * MiB, WS_NK = 118 * MiB, WS_NVT = 150 * MiB, WS_VGT = 182 * MiB, WS_QG = 214 * MiB, WS_KG = 230 * MiB, WS_OB = 214 * MiB,
                 WS_PKF = WS_XW, WS_PKB = WS_NK, WS_CTL = 246 * MiB, WS_END = 247 * MiB;
constexpr int PK_BYTES = 41472;
constexpr int PK_A_OFF = 40960;
constexpr int LDS_BYTES = 163840;

DI unsigned pk2(float lo, float hi) { f32x2 v = {lo, hi}; bf2_t b = __builtin_convertvector(v, bf2_t); return __builtin_bit_cast(unsigned, b); }
DI float bf2f(bf16_t u) { return __uint_as_float(((unsigned)u) << 16); }
DI float wave_sum(float v) {
#pragma unroll
    for (int o = 1; o < 64; o <<= 1) v += __shfl_xor(v, o);
    return v;
}
DI float silu_f(float x) { return x * __builtin_amdgcn_rcpf(1.f + __expf(-x)); }
DI int crow(int reg, int h) { return (reg & 3) + 8 * (reg >> 2) + 4 * h; }
#define MFMA32(a, b, c) __builtin_amdgcn_mfma_f32_32x32x16_bf16((a), (b), (c), 0, 0, 0)
#define MFMA16(a, b, c) __builtin_amdgcn_mfma_f32_16x16x32_bf16((a), (b), (c), 0, 0, 0)

struct Args {
    const float *x, *meta, *norm_g, *w_in, *wd_f, *bd_f, *wd_b, *bd_b, *gla_g, *qn_g, *kn_g, *rpb, *meta_bias, *w_out;
    float* out; unsigned char* ws;
};

DI int phys_norm(int wt, int lc) { return 256 * wt + 128 * ((lc >> 5) & 1) + 32 * (lc >> 6) + (lc & 31); }

DI void p0_transpose_item(const float* W, int ldw, int k0, int n0, bf16_t* WT, int ldwt, int row0, float* scr, int lane) {
#pragma unroll 8
    for (int i = 0; i < 32; ++i) { const int kk = 2 * i + (lane >> 5); scr[kk * 33 + (lane & 31)] = W[(size_t)(k0 + kk) * ldw + n0 + (lane & 31)]; }
    asm volatile("s_waitcnt lgkmcnt(0)" ::: "memory");
    const int c = lane & 7;
#pragma unroll
    for (int j = 0; j < 4; ++j) { const int n = (lane >> 3) + 8 * j; const float* s = scr + (8 * c) * 33 + n;
        u32x4 o; o.x = pk2(s[0 * 33], s[1 * 33]); o.y = pk2(s[2 * 33], s[3 * 33]); o.z = pk2(s[4 * 33], s[5 * 33]); o.w = pk2(s[6 * 33], s[7 * 33]);
        *(u32x4*)(WT + (size_t)(row0 + n) * ldwt + k0 + 8 * c) = o; }
    asm volatile("s_waitcnt lgkmcnt(0)" ::: "memory");
}
DI int wt_base(int wt) {
    if (wt < 2) return 0 + 256 * wt;
    if (wt < 4) return 512 + 256 * (wt - 2);
    if (wt < 8) return 2080 + 256 * (wt - 4);
    if (wt < 12) return 3104 + 256 * (wt - 8);
    if (wt < 16) return 4128 + 256 * (wt - 12);
    if (wt < 20) return 6176 + 256 * (wt - 16);
    if (wt < 24) return 1024 + 256 * (wt - 20);
    return 5152 + 256 * (wt - 24);
}
DI void rms_row_to_bf16(const float* xrow, const float* g, bf16_t* orow, int lane) {
    const f32x4* xr = (const f32x4*)xrow + lane; const f32x4* gr = (const f32x4*)g + lane;
    f32x4 v[4]; float s = 0.f;
#pragma unroll
    for (int j = 0; j < 4; ++j) { v[j] = xr[64 * j]; s += (v[j].x * v[j].x + v[j].y * v[j].y) + (v[j].z * v[j].z + v[j].w * v[j].w); }
    const float rstd = 1.0f / sqrtf(wave_sum(s) * (1.f / DM) + RMS_EPS);
    unsigned long long* o8 = (unsigned long long*)orow + lane;
#pragma unroll
    for (int j = 0; j < 4; ++j) { const f32x4 gg = gr[64 * j];
        o8[64 * j] = (unsigned long long)pk2(v[j].x * rstd * gg.x, v[j].y * rstd * gg.y) | ((unsigned long long)pk2(v[j].z * rstd * gg.z, v[j].w * rstd * gg.w) << 32); }
}
DI void p0_block_item(const float* W, int ldw, int k0, int n0, bool perm, bf16_t* WT, int ldwt, int row0, float* T  , int tid) {
    f32x4 v[8];
#pragma unroll
    for (int i = 0; i < 8; ++i) { const int e = tid + 512 * i, kk = e >> 6, c4 = e & 63; v[i] = *(const f32x4*)(W + (size_t)(k0 + kk) * ldw + n0 + 4 * c4); }
#pragma unroll
    for (int i = 0; i < 8; ++i) { const int e = tid + 512 * i, kk = e >> 6, c4 = e & 63; float* t = T + kk * 257 + 4 * c4; t[0] = v[i][0]; t[1] = v[i][1]; t[2] = v[i][2]; t[3] = v[i][3]; }
    __syncthreads();
    { const int pp = tid >> 1, kh = tid & 1; const int lc = perm ? (64 * ((pp >> 5) & 3) + 32 * (pp >> 7) + (pp & 31)) : pp;
      const float* t = T + (32 * kh) * 257 + lc;
      unsigned w[16];
#pragma unroll
      for (int j = 0; j < 16; ++j) w[j] = pk2(t[(2 * j) * 257], t[(2 * j + 1) * 257]);
      u32x4* dst = (u32x4*)(WT + (size_t)(row0 + pp) * ldwt + k0 + 32 * kh);
#pragma unroll
      for (int j = 0; j < 4; ++j) dst[j] = (u32x4){w[4 * j], w[4 * j + 1], w[4 * j + 2], w[4 * j + 3]}; }
    __syncthreads();
}
DI void rms_rows2_to_bf16(const float* x0, const float* x1, const float* g, bf16_t* o0, bf16_t* o1, int lane) {
    const f32x4* xa = (const f32x4*)x0 + lane; const f32x4* xb = (const f32x4*)x1 + lane; const f32x4* gr = (const f32x4*)g + lane;
    f32x4 va[4], vb[4]; float sa = 0.f, sb2 = 0.f;
#pragma unroll
    for (int j = 0; j < 4; ++j) { va[j] = xa[64 * j]; vb[j] = xb[64 * j]; }
#pragma unroll
    for (int j = 0; j < 4; ++j) { sa += (va[j].x * va[j].x + va[j].y * va[j].y) + (va[j].z * va[j].z + va[j].w * va[j].w); sb2 += (vb[j].x * vb[j].x + vb[j].y * vb[j].y) + (vb[j].z * vb[j].z + vb[j].w * vb[j].w); }
    const float ra = 1.0f / sqrtf(wave_sum(sa) * (1.f / DM) + RMS_EPS), rb = 1.0f / sqrtf(wave_sum(sb2) * (1.f / DM) + RMS_EPS);
    unsigned long long* oa = (unsigned long long*)o0 + lane; unsigned long long* ob = (unsigned long long*)o1 + lane;
#pragma unroll
    for (int j = 0; j < 4; ++j) { const f32x4 gg = gr[64 * j];
        oa[64 * j] = (unsigned long long)pk2(va[j].x * ra * gg.x, va[j].y * ra * gg.y) | ((unsigned long long)pk2(va[j].z * ra * gg.z, va[j].w * ra * gg.w) << 32);
        ob[64 * j] = (unsigned long long)pk2(vb[j].x * rb * gg.x, vb[j].y * rb * gg.y) | ((unsigned long long)pk2(vb[j].z * rb * gg.z, vb[j].w * rb * gg.w) << 32); }
}
DI void p0_phase(const Args& a, unsigned char* lds, int vcu, int G, int wave, int lane) {
    unsigned char* ws = a.ws;
    bf16_t* XW = (bf16_t*)(ws + WS_XW); bf16_t* WSs = (bf16_t*)(ws + WS_WS); bf16_t* WO = (bf16_t*)(ws + WS_WO); bf16_t* UM = (bf16_t*)(ws + WS_UM);
    const int gw = vcu * NWAVES + wave, NGW = G * NWAVES, tid = wave * 64 + lane;
    for (int it = vcu; it < 448 + 128; it += G) {
        if (it < 448) { const int kb = it / 28, wt = it % 28; p0_block_item(a.w_in, NIN, 64 * kb, wt_base(wt), wt < 20, XW, DM, NTOK + 256 * wt, (float*)lds, tid); }
        else { const int r = it - 448, kb = r >> 2, nb = r & 3; p0_block_item(a.w_out, DM, 64 * kb, 256 * nb, false, WO, 2048, 256 * nb, (float*)lds, tid); }
    }
    { float* scr = (float*)(lds + wave * 16384);
      for (int it = gw; it < 16; it += NGW) p0_transpose_item(a.w_in, NIN, 64 * it, 2048, WSs, DM, 0, scr, lane); }
    for (int m = 2 * gw; m < NTOK; m += 2 * NGW) rms_rows2_to_bf16(a.x + (size_t)m * DM, a.x + (size_t)(m + 1) * DM, a.norm_g, XW + (size_t)m * DM, XW + (size_t)(m + 1) * DM, lane);
    for (int m = gw; m < 16; m += NGW) rms_row_to_bf16(a.meta + (size_t)m * DM, a.norm_g, UM + (size_t)m * DM, lane);
}

DI void skinny_task(const bf16_t* A, const bf16_t* B, float* O, int ldo, int lane) {
    const int r = lane & 15, q = lane >> 4;
    const bf16x8* ap = (const bf16x8*)(A + (size_t)r * DM + 8 * q);
    const bf16x8* b0 = (const bf16x8*)(B + (size_t)r * DM + 8 * q);
    const bf16x8* b1 = (const bf16x8*)(B + (size_t)(16 + r) * DM + 8 * q);
    f32x4 acc0 = {0.f, 0.f, 0.f, 0.f}, acc1 = {0.f, 0.f, 0.f, 0.f};
#pragma unroll
    for (int kh = 0; kh < 2; ++kh) {
        bf16x8 av[16], bv0[16], bv1[16];
#pragma unroll
        for (int ks = 0; ks < 16; ++ks) { av[ks] = ap[4 * (16 * kh + ks)]; bv0[ks] = b0[4 * (16 * kh + ks)]; bv1[ks] = b1[4 * (16 * kh + ks)]; }
#pragma unroll
        for (int ks = 0; ks < 16; ++ks) { acc0 = MFMA16(av[ks], bv0[ks], acc0); acc1 = MFMA16(av[ks], bv1[ks], acc1); }
    }
#pragma unroll
    for (int i = 0; i < 4; ++i) { O[(size_t)(4 * q + i) * ldo + r] = acc0[i]; O[(size_t)(4 * q + i) * ldo + 16 + r] = acc1[i]; }
}
DI void p1_skinny(const Args& a, int vcu, int G, int wave, int lane) {
    unsigned char* ws = a.ws;
    const bf16_t* XW = (const bf16_t*)(ws + WS_XW); const bf16_t* WSs = (const bf16_t*)(ws + WS_WS); const bf16_t* UM = (const bf16_t*)(ws + WS_UM);
    float* R = (float*)(ws + WS_R); float* ZM = (float*)(ws + WS_ZM);
    const int gw = vcu * NWAVES + wave, NGW = G * NWAVES;
    for (int t = gw; t < 1024 + 225; t += NGW) {
        if (t < 1024) skinny_task(XW + (size_t)t * 16 * DM, WSs, R + (size_t)t * 16 * 32, 32, lane);
        else { const int c = t - 1024;
            if (c < 224) skinny_task(UM, XW + (size_t)(NTOK + 32 * c) * DM, ZM + 32 * c, NIN, lane);
            else skinny_task(UM, WSs, ZM + 7168, NIN, lane); }
    }
}

struct OrderIn {
    int G, c;
    DI bool next(int i, pg8::Unit& u) const {
        const long L = (long)i * G + c; if (L >= 1792) return false;
        const int ii = (int)(L >> 8), cc = (int)(L & 255), xcd = cc & 7, j = cc >> 3, tok = 8 * xcd + (j & 7), w4 = j >> 3;
        if (ii < 5) { u.pm = tok; u.pn = 64 + 4 * ii + w4; } else { u.pm = 64 + 20 + 4 * (ii - 5) + w4; u.pn = tok; }
        return true;
    }
    DI void a_ready(const pg8::Unit&) const {}
    DI void done(const pg8::Unit&) const {}
};

struct EpiIn {
    static constexpr bool PERM = true, AFTER_DRAIN = false;
    bf16_t *QG, *KG, *GG, *NGt, *AO, *NK, *VGT, *NVT; const float *qn_g, *kn_g;
    DI void operator()(const f32x4 (&acc)[2][2][4][2], const pg8::Unit& u, int wr, int wc, int fr, int fq) const {
        if (u.pm < 64) {
            const int wt = u.pn - 64;
            const int row0 = u.pm * 256 + wr * 64 + fr;
            if (wt < 8 || wt >= 16) {
                bf16_t* base; int ld; float sc = 1.f; bool act = false;
                if (wt < 2) { base = QG + 256 * wt; ld = 512; sc = 0.08838834764831845f; }
                else if (wt < 4) { base = KG + 256 * (wt - 2); ld = 512; }
                else if (wt < 8) { base = GG + 256 * (wt - 4); ld = 1024; act = true; }
                else { base = NGt + 256 * (wt - 16); ld = 1024; act = true; }
#pragma unroll
                for (int ai = 0; ai < 2; ++ai)
#pragma unroll
                    for (int m = 0; m < 4; ++m) { bf16_t* rowp = base + (size_t)(row0 + ai * 128 + m * 16) * ld + 64 * wc + 8 * fq;
#pragma unroll
                        for (int bj = 0; bj < 2; ++bj) { f32x4 v0 = acc[ai][bj][m][0], v1 = acc[ai][bj][m][1];
                            if (act) { v0 = (f32x4){silu_f(v0[0]), silu_f(v0[1]), silu_f(v0[2]), silu_f(v0[3])}; v1 = (f32x4){silu_f(v1[0]), silu_f(v1[1]), silu_f(v1[2]), silu_f(v1[3])}; }
                            v0 = v0 * sc; v1 = v1 * sc;
                            u32x4 w; w.x = pk2(v0[0], v0[1]); w.y = pk2(v0[2], v0[3]); w.z = pk2(v1[0], v1[1]); w.w = pk2(v1[2], v1[3]);
                            *(u32x4*)(rowp + 32 * bj) = w; } }
            } else {
                const bool isq = wt < 12; const float* g = isq ? qn_g : kn_g; const float gs = isq ? (0.125f * LOG2E) : 1.0f;
                const int kb_ = u.pm >> 5, kgrow_ = (u.pm & 31) * 4 + wr;
                bf16_t* base = isq ? (AO + 1024 + 256 * (wt - 8)) : (NK + ((size_t)((kb_ * 16 + 4 * (wt - 12) + wc) * 128 + kgrow_) * 4096)); const int ld = isq ? 2048 : 1024;
                f32x4 gv[2][2];
#pragma unroll
                for (int bj = 0; bj < 2; ++bj)
#pragma unroll
                    for (int n = 0; n < 2; ++n) gv[bj][n] = *(const f32x4*)(g + 32 * bj + 8 * fq + 4 * n) * gs;
#pragma unroll
                for (int ai = 0; ai < 2; ++ai)
#pragma unroll
                    for (int m = 0; m < 4; ++m) {
                        float ss = 0.f;
#pragma unroll
                        for (int bj = 0; bj < 2; ++bj)
#pragma unroll
                            for (int n = 0; n < 2; ++n) { const f32x4 v = acc[ai][bj][m][n]; ss += (v[0] * v[0] + v[1] * v[1]) + (v[2] * v[2] + v[3] * v[3]); }
                        ss += __shfl_xor(ss, 16); ss += __shfl_xor(ss, 32);
                        const float rstd = 1.0f / sqrtf(ss * (1.f / 64.f) + RMS_EPS);
                        bf16_t* rowp = isq ? (base + (size_t)(row0 + ai * 128 + m * 16) * ld + 64 * wc + 8 * fq) : (base + (size_t)ai * 2 * 4096 + (m * 16 + fr) * 64 + 8 * fq);
#pragma unroll
                        for (int bj = 0; bj < 2; ++bj) { const f32x4 v0 = acc[ai][bj][m][0] * rstd * gv[bj][0], v1 = acc[ai][bj][m][1] * rstd * gv[bj][1];
                            u32x4 w; w.x = pk2(v0[0], v0[1]); w.y = pk2(v0[2], v0[3]); w.z = pk2(v1[0], v1[1]); w.w = pk2(v1[2], v1[3]);
                            *(u32x4*)(rowp + 32 * bj) = w; }
                    }
            }
        } else {
            const int wt = u.pm - 64;
            if (wt < 24) {
                const int bb = u.pn >> 5, cbase = (u.pn & 31) * 4 + (wc >> 1), ksb = (wc & 1) * 2;
                bf16_t* lp = VGT + ((fq & 1) * 32 + fr) * 8 + (fq >> 1) * 512;
#pragma unroll
                for (int ai = 0; ai < 2; ++ai)
#pragma unroll
                    for (int m = 0; m < 4; ++m)
#pragma unroll
                        for (int bj = 0; bj < 2; ++bj) { const f32x4 v0 = acc[ai][bj][m][0], v1 = acc[ai][bj][m][1];
                            u32x4 w; w.x = pk2(v0[0], v0[1]); w.y = pk2(v0[2], v0[3]); w.z = pk2(v1[0], v1[1]); w.w = pk2(v1[2], v1[3]);
                            const int frag = (((bb * 4 + (wt - 20)) * 128 + cbase + 2 * bj) * 8 + wr * 2 + ai * 4 + (m >> 1)) * 4 + ksb;
                            *(u32x4*)(lp + (size_t)frag * 512 + (m & 1) * 128) = w; }
            } else {
                const int vb_ = u.pn >> 5, vgrow_ = (u.pn & 31) * 4 + (wc >> 1);
                bf16_t* lp = NVT + fr * 64 + (wc & 1) * 32 + 8 * fq;
#pragma unroll
                for (int ai = 0; ai < 2; ++ai)
#pragma unroll
                    for (int m = 0; m < 4; ++m)
#pragma unroll
                        for (int bj = 0; bj < 2; ++bj) { const f32x4 v0 = acc[ai][bj][m][0], v1 = acc[ai][bj][m][1];
                            u32x4 w; w.x = pk2(v0[0], v0[1]); w.y = pk2(v0[2], v0[3]); w.z = pk2(v1[0], v1[1]); w.w = pk2(v1[2], v1[3]);
                            const int slab = (vb_ * 16 + 4 * (wt - 24) + 2 * ai + wr) * 128 + vgrow_ + 2 * bj;
                            *(u32x4*)(lp + (size_t)slab * 4096 + m * 16 * 64) = w; }
            }
        }
    }
};

struct EpiOut {
    static constexpr bool PERM = false, AFTER_DRAIN = false;
    const float* x; float* out;
    DI void operator()(const f32x4 (&acc)[2][2][4][2], const pg8::Unit& u, int wr, int wc, int fr, int fq) const {
        const int row0 = u.pm * 256 + wr * 64 + fr, col0 = u.pn * 256 + wc * 32 + 4 * fq;
#pragma unroll
        for (int ai = 0; ai < 2; ++ai) {
            f32x4 xs[4][2][2];
#pragma unroll
            for (int m = 0; m < 4; ++m) { const size_t off = (size_t)(row0 + ai * 128 + m * 16) * DM + col0;
#pragma unroll
                for (int bj = 0; bj < 2; ++bj)
#pragma unroll
                    for (int n = 0; n < 2; ++n) xs[m][bj][n] = *(const f32x4*)(x + off + bj * 128 + n * 16); }
            asm volatile("" ::: "memory");
#pragma unroll
            for (int m = 0; m < 4; ++m) { const size_t off = (size_t)(row0 + ai * 128 + m * 16) * DM + col0;
#pragma unroll
                for (int bj = 0; bj < 2; ++bj)
#pragma unroll
                    for (int n = 0; n < 2; ++n) *(f32x4*)(out + off + bj * 128 + n * 16) = xs[m][bj][n] + acc[ai][bj][m][n]; }
        }
    }
};

constexpr int NA_SLOT = 16384, NA_NSLOT = 9, NA_KM = NA_NSLOT * NA_SLOT, NA_VM = NA_KM + 2048, NA_RPB = NA_VM + 2048, NA_MB = NA_RPB + 1920;
#define NA_BAR() do { asm volatile("s_waitcnt lgkmcnt(0)" ::: "memory"); __builtin_amdgcn_s_barrier(); asm volatile("" ::: "memory"); } while (0)
DI void na_stage_row(const bf16_t* kslab, const bf16_t* vslab, unsigned char* slot, int lw, int lane) {
#pragma unroll
    for (int i = 0; i < 2; ++i) { const int piece = 2 * lw + i, P = 64 * piece + lane, line = P >> 4, pos = P & 15;
        { const int b0 = ((pos >> 3) & 1) ^ (line & 1), uu = (pos & 7) ^ (4 * b0 + ((line >> 2) & 3)), key = 2 * line + b0;
          __builtin_amdgcn_global_load_lds((const unsigned*)(kslab + key * 64 + uu * 8), (PG8_LAS unsigned*)(slot + piece * 1024), 16, 0, 0); }
        { const int x = pos ^ (line & 7), d = 2 * line + (x >> 3), uk = x & 7;
          __builtin_amdgcn_global_load_lds((const unsigned*)(vslab + d * 64 + uk * 8), (PG8_LAS unsigned*)(slot + 8192 + piece * 1024), 16, 0, 0); } }
}
DI int na_rs(int r) { int rs = r - 4; return rs < 0 ? 0 : (rs > 120 ? 120 : rs); }
DI void na_phase(const Args& a, unsigned char* lds, int vcu, int G, int wave, int lane, bf16_t* ODST, int ostride) {
    unsigned char* ws = a.ws;
    const float* ZM = (const float*)(ws + WS_ZM);
    bf16_t* AO = (bf16_t*)(ws + WS_AO); const bf16_t* NKP = (const bf16_t*)(ws + WS_NK); const bf16_t* NVP = (const bf16_t*)(ws + WS_NVT);
    const bf16_t* NGt = (const bf16_t*)a.out + (size_t)NTOK * 1024;
    bf16_t* KM = (bf16_t*)(lds + NA_KM); bf16_t* VM = (bf16_t*)(lds + NA_VM); float* RPB = (float*)(lds + NA_RPB); float* MB = (float*)(lds + NA_MB);
    const int tid = wave * 64 + lane;
    for (int task = vcu; task < 256; task += G) {
        const int b = task >> 7, h = (task >> 3) & 15, r0 = (task & 7) * 16;
        const bf16_t* kbase = NKP + (size_t)((b * 16 + h) * 128) * 4096; const bf16_t* vbase = NVP + (size_t)((b * 16 + h) * 128) * 4096;
        for (int m = wave; m < 16; m += NWAVES) { const int d = lane;
            const float v = ZM[(size_t)m * NIN + 256 * (12 + (h >> 2)) + 128 * (d >> 5) + 32 * (h & 3) + (d & 31)];
            const float rstd = 1.0f / sqrtf(wave_sum(v * v) * (1.f / 64.f) + RMS_EPS);
            KM[m * 64 + d] = (bf16_t)(pk2(v * rstd * a.kn_g[d], 0.f) & 0xffffu); }
        for (int e = tid; e < 1024; e += 512) { const int m = e & 15, d = e >> 4;
            VM[e] = (bf16_t)(pk2(ZM[(size_t)m * NIN + 256 * (24 + (h >> 2)) + 64 * (h & 3) + d], 0.f) & 0xffffu); }
        if (tid < 465) RPB[tid] = a.rpb[h * 465 + tid] * LOG2E;
        if (tid < 16) MB[tid] = a.meta_bias[h * 16 + tid] * LOG2E;
        const int lo = na_rs(r0);
        if (wave >= 4) {
            const int lw = wave - 4;
            for (int x = lo; x < lo + 8; ++x) na_stage_row(kbase + (size_t)x * 4096, vbase + (size_t)x * 4096, lds + (x % NA_NSLOT) * NA_SLOT, lw, lane);
            asm volatile("s_waitcnt vmcnt(0)" ::: "memory");
            NA_BAR();
            for (int r = r0; r < r0 + 16; ++r) {
                if (r + 1 < r0 + 16 && na_rs(r + 1) > na_rs(r)) { const int x = na_rs(r + 1) + 7;
                    na_stage_row(kbase + (size_t)x * 4096, vbase + (size_t)x * 4096, lds + (x % NA_NSLOT) * NA_SLOT, lw, lane); }
                asm volatile("s_waitcnt vmcnt(0)" ::: "memory");
                NA_BAR();
            }
            continue;
        }
        const int n = lane & 15, q4 = lane >> 4, qt = wave;
        const int c0 = (qt == 0) ? 0 : (qt == 1) ? 8 : (qt == 2) ? 24 : 32;
        const int qc = 16 * qt + n;
        int cs = qc - 8; cs = cs < 0 ? 0 : (cs > 48 ? 48 : cs);
        bf16x8 qf[2], qn[2];
        { const size_t qtok = (size_t)b * SEQ + r0 * 64 + qc;
#pragma unroll
          for (int ks = 0; ks < 2; ++ks) qf[ks] = *(const bf16x8*)(AO + qtok * 2048 + 1024 + h * 64 + 32 * ks + 8 * q4); }
        int koff[2][2];
#pragma unroll
        for (int t = 0; t < 2; ++t) { const int key = c0 + 8 * (n >> 2) + 4 * t + (n & 3); const int f = ((key & 3) << 2) | ((key >> 3) & 3);
#pragma unroll
            for (int ks = 0; ks < 2; ++ks) koff[t][ks] = ((key >> 1) * 16 + ((((key & 1) * 8) + 4 * ks + q4) ^ f)) * 16; }
        int voff[4];
#pragma unroll
        for (int dt = 0; dt < 4; ++dt) { const int d = 16 * dt + n, uk = (c0 >> 3) + q4; voff[dt] = 8192 + ((d >> 1) * 16 + ((((d & 1) * 8) + uk) ^ ((d >> 1) & 7))) * 16; }
        float madd[2][4]; int boff[2][4];
#pragma unroll
        for (int t = 0; t < 2; ++t)
#pragma unroll
            for (int i = 0; i < 4; ++i) { const int kc = c0 + 8 * q4 + 4 * t + i; const bool valid = (kc >= cs) && (kc < cs + 16);
                int dcol = kc - qc + 15; dcol = dcol < 0 ? 0 : (dcol > 30 ? 30 : dcol); madd[t][i] = valid ? 0.f : -1e30f; boff[t][i] = dcol * 4; }
        NA_BAR();
        for (int r = r0; r < r0 + 16; ++r) {
            const int rs = na_rs(r);
            const size_t qtok = (size_t)b * SEQ + r * 64 + qc;
            if (r + 1 < r0 + 16) {
#pragma unroll
                for (int ks = 0; ks < 2; ++ks) qn[ks] = *(const bf16x8*)(AO + (qtok + 64) * 2048 + 1024 + h * 64 + 32 * ks + 8 * q4);
            }
            u32x2 gw[4];
#pragma unroll
            for (int dt = 0; dt < 4; ++dt) gw[dt] = *(const u32x2*)(NGt + qtok * 1024 + h * 64 + 16 * dt + 4 * q4);
            f32x4 sc[17];
#pragma unroll
            for (int kr = 0; kr < 8; ++kr) {
                const unsigned char* slot = lds + ((rs + kr) % NA_NSLOT) * NA_SLOT;
#pragma unroll
                for (int t = 0; t < 2; ++t) {
                    const bf16x8 k0 = *(const bf16x8*)(slot + koff[t][0]);
                    const bf16x8 k1 = *(const bf16x8*)(slot + koff[t][1]);
                    f32x4 z = {0.f, 0.f, 0.f, 0.f};
                    z = MFMA16(k0, qf[0], z); z = MFMA16(k1, qf[1], z);
                    sc[2 * kr + t] = z;
                }
            }
            {
                const bf16x8 k0 = *(const bf16x8*)(KM + n * 64 + 8 * q4);
                const bf16x8 k1 = *(const bf16x8*)(KM + n * 64 + 32 + 8 * q4);
                f32x4 z = {0.f, 0.f, 0.f, 0.f};
                z = MFMA16(k0, qf[0], z); z = MFMA16(k1, qf[1], z);
                sc[16] = z;
            }
            float mx = -1e30f;
            const unsigned char* rpb0 = (const unsigned char*)RPB + (rs - r + 7) * 124;
#pragma unroll
            for (int kr = 0; kr < 8; ++kr) {
#pragma unroll
                for (int t = 0; t < 2; ++t)
#pragma unroll
                    for (int i = 0; i < 4; ++i) {
                        const float bias = *(const float*)(rpb0 + kr * 124 + boff[t][i]);
                        const float sv = sc[2 * kr + t][i] + (bias + madd[t][i]);
                        sc[2 * kr + t][i] = sv; mx = fmaxf(mx, sv);
                    }
            }
#pragma unroll
            for (int i = 0; i < 4; ++i) { const float sv = sc[16][i] + MB[4 * q4 + i]; sc[16][i] = sv; mx = fmaxf(mx, sv); }
            mx = fmaxf(mx, __shfl_xor(mx, 16)); mx = fmaxf(mx, __shfl_xor(mx, 32));
            float sum = 0.f;
#pragma unroll
            for (int j = 0; j < 17; ++j)
#pragma unroll
                for (int i = 0; i < 4; ++i) { const float pp = __builtin_amdgcn_exp2f(sc[j][i] - mx); sc[j][i] = pp; sum += pp; }
            sum += __shfl_xor(sum, 16); sum += __shfl_xor(sum, 32);
            const float inv = 1.0f / sum;
            f32x4 o[4];
#pragma unroll
            for (int dt = 0; dt < 4; ++dt) o[dt] = (f32x4){0.f, 0.f, 0.f, 0.f};
#pragma unroll
            for (int kr = 0; kr < 8; ++kr) {
                const unsigned char* slot = lds + ((rs + kr) % NA_NSLOT) * NA_SLOT;
                u32x4 pw; pw.x = pk2(sc[2 * kr][0], sc[2 * kr][1]); pw.y = pk2(sc[2 * kr][2], sc[2 * kr][3]); pw.z = pk2(sc[2 * kr + 1][0], sc[2 * kr + 1][1]); pw.w = pk2(sc[2 * kr + 1][2], sc[2 * kr + 1][3]);
                const bf16x8 pf = __builtin_bit_cast(bf16x8, pw);
#pragma unroll
                for (int dt = 0; dt < 4; ++dt) { const bf16x8 vf = *(const bf16x8*)(slot + voff[dt]); o[dt] = MFMA16(vf, pf, o[dt]); }
            }
            {
                u32x4 pw; pw.x = pk2(sc[16][0], sc[16][1]); pw.y = pk2(sc[16][2], sc[16][3]); pw.z = 0u; pw.w = 0u;
                const bf16x8 pf = __builtin_bit_cast(bf16x8, pw);
#pragma unroll
                for (int dt = 0; dt < 4; ++dt) {
                    const u32x2 lo2 = *(const u32x2*)(VM + ((16 * dt + n) * 16 + 4 * q4));
                    u32x4 vw; vw.x = lo2.x; vw.y = lo2.y; vw.z = 0u; vw.w = 0u;
                    o[dt] = MFMA16(__builtin_bit_cast(bf16x8, vw), pf, o[dt]);
                }
            }
#pragma unroll
            for (int dt = 0; dt < 4; ++dt) {
                const int d0 = h * 64 + 16 * dt + 4 * q4;
                const float g0 = __uint_as_float(gw[dt].x << 16), g1 = __uint_as_float(gw[dt].x & 0xffff0000u), g2 = __uint_as_float(gw[dt].y << 16), g3 = __uint_as_float(gw[dt].y & 0xffff0000u);
                u32x2 w; w.x = pk2(o[dt][0] * inv * g0, o[dt][1] * inv * g1); w.y = pk2(o[dt][2] * inv * g2, o[dt][3] * inv * g3);
                *(u32x2*)(ODST + qtok * ostride + d0) = w;
            }
            qf[0] = qn[0]; qf[1] = qn[1];
            NA_BAR();
        }
    }
}

constexpr int PREP_LD = 136;
constexpr int PREP_TILE = 64 * PREP_LD * 2;
constexpr int PREP_R = 4 * PREP_TILE, PREP_PART = PREP_R + 8192;
DI float logsig16(float x) { return (fminf(x, 0.f) - __logf(1.f + __expf(-fabsf(x)))) * (1.f / 16.f); }
DI int phys_gk(int c) { return phys_norm(2 + (c >> 8), c & 255); }
DI void prep_phase(const Args& a, unsigned char* lds, int vcu, int G, int wave, int lane) {
    unsigned char* ws = a.ws;
    const float* ZM = (const float*)(ws + WS_ZM); const float* R = (const float*)(ws + WS_R);
    const bf16_t* QG = (const bf16_t*)(ws + WS_QG); const bf16_t* KG = (const bf16_t*)(ws + WS_KG);
    unsigned char* PKF = ws + WS_PKF; unsigned char* PKB = ws + WS_PKB; bf16_t* VMT = (bf16_t*)(ws + WS_VMT);
    const int tid = wave * 64 + lane;
    bf16_t* T_QF = (bf16_t*)(lds); bf16_t* T_KF = (bf16_t*)(lds + PREP_TILE); bf16_t* T_QB = (bf16_t*)(lds + 2 * PREP_TILE); bf16_t* T_KB = (bf16_t*)(lds + 3 * PREP_TILE);
    float* RS = (float*)(lds + PREP_R); float* PART = (float*)(lds + PREP_PART);
    for (int task = vcu; task < 1024 + 8; task += G) {
        if (task >= 1024) {
            const int mt = task - 1024, b = mt >> 2, h = mt & 3;
            unsigned char* pk = PKF + (size_t)((b * 4 + h) * 129) * PK_BYTES;
            for (int p = tid; p < PK_BYTES / 16; p += 512) *(u32x4*)(pk + p * 16) = (u32x4){0u, 0u, 0u, 0u};
            __syncthreads();
            if (tid < 128) { const int d = tid;
                float wd[16];
#pragma unroll
                for (int k = 0; k < 16; ++k) wd[k] = a.wd_f[k * 512 + h * 128 + d];
                const float bd = a.bd_f[h * 128 + d];
                float G_[16]; float run = 0.f;
#pragma unroll
                for (int m = 0; m < 16; ++m) { float dot = bd;
#pragma unroll
                    for (int k = 0; k < 16; ++k) dot += ZM[(size_t)m * NIN + 7168 + k] * wd[k];
                    run += logsig16(dot); G_[m] = run; }
                unsigned kw[8];
#pragma unroll
                for (int m = 0; m < 16; m += 2) { const float k0 = ZM[(size_t)m * NIN + phys_gk(h * 128 + d)] * __expf(run - G_[m]);
                    const float k1 = ZM[(size_t)(m + 1) * NIN + phys_gk(h * 128 + d)] * __expf(run - G_[m + 1]); kw[m >> 1] = pk2(k0, k1); }
                const int dt = d >> 5, r = d & 31;
                *(u32x4*)(pk + (dt * 4 + 3) * 1024 + (0 * 32 + r) * 16) = (u32x4){kw[0], kw[1], kw[2], kw[3]};
                *(u32x4*)(pk + (dt * 4 + 3) * 1024 + (1 * 32 + r) * 16) = (u32x4){kw[4], kw[5], kw[6], kw[7]};
                *(float*)(pk + PK_A_OFF + d * 4) = 1.0f;
            }
            if (b == 0 && tid < 256) { const int v = tid; const int c = h * 256 + v; bf16_t* row = VMT + (size_t)c * 64;
                for (int j = 0; j < 48; j += 8) *(u32x4*)(row + j) = (u32x4){0u, 0u, 0u, 0u};
                unsigned vw[8];
#pragma unroll
                for (int m = 0; m < 16; m += 2) vw[m >> 1] = pk2(ZM[(size_t)m * NIN + 256 * (20 + (c >> 8)) + (c & 255)], ZM[(size_t)(m + 1) * NIN + 256 * (20 + (c >> 8)) + (c & 255)]);
                *(u32x4*)(row + 48) = (u32x4){vw[0], vw[1], vw[2], vw[3]}; *(u32x4*)(row + 56) = (u32x4){vw[4], vw[5], vw[6], vw[7]}; }
            __syncthreads();
            continue;
        }
        const int b = task >> 9, h = (task >> 7) & 3, c = task & 127;
        const size_t tok0 = (size_t)b * SEQ + c * 64;
        unsigned char* pkf = PKF + (size_t)((b * 4 + h) * 129 + 1 + c) * PK_BYTES;
        unsigned char* pkb = PKB + (size_t)((b * 4 + h) * 128 + c) * PK_BYTES;
        { const f32x4* src = (const f32x4*)(R + tok0 * 32); ((f32x4*)RS)[tid] = src[tid]; }
        const int d = tid & 127, tq = tid >> 7;
        bf16_t qv[16], kv[16];
#pragma unroll
        for (int jj = 0; jj < 16; ++jj) { qv[jj] = QG[(tok0 + 16 * tq + jj) * 512 + h * 128 + d]; kv[jj] = KG[(tok0 + 16 * tq + jj) * 512 + h * 128 + d]; }
        float wf[16], wb[16];
#pragma unroll
        for (int k = 0; k < 16; ++k) { wf[k] = a.wd_f[k * 512 + h * 128 + d]; wb[k] = a.wd_b[k * 512 + h * 128 + d]; }
        const float bf_ = a.bd_f[h * 128 + d], bb_ = a.bd_b[h * 128 + d];
        __syncthreads();
        float pf[16], pb[16];
        { float rf = 0.f, rb = 0.f;
#pragma unroll
          for (int jj = 0; jj < 16; ++jj) { const float* rr = RS + (16 * tq + jj) * 32; float df = bf_, db = bb_;
#pragma unroll
              for (int k4 = 0; k4 < 4; ++k4) { const f32x4 x0 = *(const f32x4*)(rr + 4 * k4), x1 = *(const f32x4*)(rr + 16 + 4 * k4);
                  df += x0[0] * wf[4 * k4] + x0[1] * wf[4 * k4 + 1] + x0[2] * wf[4 * k4 + 2] + x0[3] * wf[4 * k4 + 3];
                  db += x1[0] * wb[4 * k4] + x1[1] * wb[4 * k4 + 1] + x1[2] * wb[4 * k4 + 2] + x1[3] * wb[4 * k4 + 3]; }
              rf += logsig16(df); rb += logsig16(db); pf[jj] = rf; pb[jj] = rb; }
          PART[(0 * 4 + tq) * 128 + d] = rf; PART[(1 * 4 + tq) * 128 + d] = rb; }
        __syncthreads();
        float offf = 0.f, totf = 0.f, offb = 0.f, totb = 0.f;
#pragma unroll
        for (int q = 0; q < 4; ++q) { const float tf = PART[(0 * 4 + q) * 128 + d], tb = PART[(1 * 4 + q) * 128 + d]; totf += tf; totb += tb; if (q < tq) offf += tf; if (q > tq) offb += tb; }
        const float mytb = pb[15];
        unsigned ksf[8], ksb[8];
#pragma unroll
        for (int jj = 0; jj < 16; jj += 2) {
            float kstf[2], kstb[2];
#pragma unroll
            for (int e = 0; e < 2; ++e) { const int j = 16 * tq + jj + e;
                const float q = bf2f(qv[jj + e]), k = bf2f(kv[jj + e]);
                const float Gf = offf + pf[jj + e];
                const float Gb = offb + (mytb - ((jj + e) ? pb[jj + e - 1] : 0.f));
                const float ef = __expf(Gf), eb = __expf(Gb);
                T_QF[j * PREP_LD + d] = (bf16_t)(pk2(q * ef, 0.f) & 0xffffu);
                T_KF[j * PREP_LD + d] = (bf16_t)(pk2(k * __expf(-Gf), 0.f) & 0xffffu);
                T_QB[j * PREP_LD + d] = (bf16_t)(pk2(q * eb, 0.f) & 0xffffu);
                T_KB[j * PREP_LD + d] = (bf16_t)(pk2(k * __expf(-Gb), 0.f) & 0xffffu);
                kstf[e] = k * __expf(totf - Gf); kstb[e] = k * __expf(totb - Gb); }
            ksf[jj >> 1] = pk2(kstf[0], kstf[1]); ksb[jj >> 1] = pk2(kstb[0], kstb[1]);
        }
        { const int dt = d >> 5, r = d & 31;
          *(u32x4*)(pkf + (dt * 4 + tq) * 1024 + (0 * 32 + r) * 16) = (u32x4){ksf[0], ksf[1], ksf[2], ksf[3]};
          *(u32x4*)(pkf + (dt * 4 + tq) * 1024 + (1 * 32 + r) * 16) = (u32x4){ksf[4], ksf[5], ksf[6], ksf[7]};
          *(u32x4*)(pkb + (dt * 4 + tq) * 1024 + (0 * 32 + r) * 16) = (u32x4){ksb[0], ksb[1], ksb[2], ksb[3]};
          *(u32x4*)(pkb + (dt * 4 + tq) * 1024 + (1 * 32 + r) * 16) = (u32x4){ksb[4], ksb[5], ksb[6], ksb[7]};
          if (tq == 0) { *(float*)(pkf + PK_A_OFF + d * 4) = __expf(totf); *(float*)(pkb + PK_A_OFF + d * 4) = __expf(totb); } }
        __syncthreads();
        {
            const int dir = wave >> 2, jt = (wave >> 1) & 1, it = wave & 1;
            const bf16_t* TQ = dir ? T_QB : T_QF; const bf16_t* TK = dir ? T_KB : T_KF; unsigned char* pk = dir ? pkb : pkf;
            const int rho = lane & 31, hh = lane >> 5;
            const int pj = (rho & ~12) | ((rho & 4) << 1) | ((rho & 8) >> 1);
            const int jrow = 32 * jt + pj, icol = 32 * it + rho;
            f32x16 acc;
#pragma unroll
            for (int i = 0; i < 16; ++i) acc[i] = 0.f;
#pragma unroll
            for (int kd = 0; kd < 8; ++kd) { const bf16x8 af = *(const bf16x8*)(TK + jrow * PREP_LD + 16 * kd + 8 * hh); const bf16x8 bfr = *(const bf16x8*)(TQ + icol * PREP_LD + 16 * kd + 8 * hh);
                acc = MFMA32(af, bfr, acc); }
#pragma unroll
            for (int s = 0; s < 2; ++s) {
                unsigned w[4];
#pragma unroll
                for (int e = 0; e < 8; e += 2) {
                    float v[2];
#pragma unroll
                    for (int x = 0; x < 2; ++x) { const int j = 32 * jt + 16 * s + 8 * hh + e + x; const bool keep = dir ? (j >= icol) : (j <= icol); v[x] = keep ? acc[8 * s + e + x] : 0.f; }
                    w[e >> 1] = pk2(v[0], v[1]);
                }
                *(u32x4*)(pk + (32 + it * 4 + 2 * jt + s) * 1024 + lane * 16) = (u32x4){w[0], w[1], w[2], w[3]};
            }
#pragma unroll
            for (int ff = 0; ff < 4; ++ff) { const int f = (wave & 3) * 4 + ff, it2 = f >> 3, kd = f & 7;
                const bf16_t* rowp = TQ + (32 * it2 + rho) * PREP_LD + 16 * kd + 4 * hh;
                const u32x2 lo = *(const u32x2*)(rowp), hi = *(const u32x2*)(rowp + 8);
                *(u32x4*)(pk + (16 + f) * 1024 + lane * 16) = (u32x4){lo.x, lo.y, hi.x, hi.y}; }
        }
        __syncthreads();
    }
}

constexpr int SCAN_BUF = 46080;
constexpr int SCAN_VT = 41984;
constexpr int SCAN_OST = 3 * SCAN_BUF;
DI bf16x8 pack8(const f32x16& x, int s) {
    u32x4 p; p.x = pk2(x[8 * s], x[8 * s + 1]); p.y = pk2(x[8 * s + 2], x[8 * s + 3]); p.z = pk2(x[8 * s + 4], x[8 * s + 5]); p.w = pk2(x[8 * s + 6], x[8 * s + 7]);
    return __builtin_bit_cast(bf16x8, p);
}
#define SCAN_BAR() do { asm volatile("s_waitcnt lgkmcnt(0)" ::: "memory"); __builtin_amdgcn_s_barrier(); asm volatile("" ::: "memory"); } while (0)
#define SCAN_LDF(f) (*(const bf16x8*)(buf + (f) * 1024 + lane * 16))
constexpr int SCAN_SLOT = 33 * 1024, SCAN_NSLOT = 4;
constexpr int SCAN_UB = SCAN_NSLOT * SCAN_SLOT;
constexpr int SCAN_XO = SCAN_UB + 16384;
DI void scan_stage(const unsigned char* src, const bf16_t* vsrc, int vstride, unsigned char* dst, int lw, int ih, int lane) {
#pragma unroll
    for (int k = 0; k < 7; ++k) { const int i = 5 * k + lw; if (i >= 33) continue;
        if (i < 29) { const int q = (i < 16) ? i : (i < 24) ? (16 + 8 * ih + (i - 16)) : (i < 28) ? (32 + 4 * ih + (i - 24)) : 40;
            __builtin_amdgcn_global_load_lds((const unsigned*)(src + (size_t)q * 1024 + lane * 16), (PG8_LAS unsigned*)(dst + i * 1024), 16, 0, 0); }
        else __builtin_amdgcn_global_load_lds((const unsigned*)(vsrc + (size_t)(i - 29) * vstride), (PG8_LAS unsigned*)(dst + i * 1024), 16, 0, 0); }
}
DI void scan_phase(const Args& a, unsigned char* lds, int wave, int lane) {
    const int sb = blockIdx.x; if (sb >= 256) return;
    unsigned char* ws = a.ws;
    const int stream = sb & 15, eighth = (sb >> 4) & 7, ih = sb >> 7;
    const int b = stream >> 3, dir = (stream >> 2) & 1, h = stream & 3;
    const int nsteps = dir ? 128 : 129;
    const unsigned char* pkbase = dir ? (ws + WS_PKB + (size_t)((b * 4 + h) * 128) * PK_BYTES) : (ws + WS_PKF + (size_t)((b * 4 + h) * 129) * PK_BYTES);
    const bf16_t* VP = (const bf16_t*)(ws + WS_VGT); const bf16_t* VMT = (const bf16_t*)(ws + WS_VMT);
    const int vcol0 = h * 256 + eighth * 32;
#define SCAN_PKIDX(s_) (dir ? (127 - (s_)) : (s_))
#define SCAN_STAGE(s_) do { const int ss_ = (s_); \
        if (dir == 0 && ss_ == 0) scan_stage(pkbase, VMT + (size_t)(vcol0 + (lane & 31)) * 64 + 8 * (lane >> 5), 16, lds + (size_t)(ss_ & 3) * SCAN_SLOT, lw, ih, lane); \
        else { const int cc_ = dir ? (127 - ss_) : (ss_ - 1); \
            scan_stage(pkbase + (size_t)SCAN_PKIDX(ss_) * PK_BYTES, VP + ((size_t)((b * 4 + h) * 128 + cc_) * 8 + eighth) * 2048 + lane * 8, 512, lds + (size_t)(ss_ & 3) * SCAN_SLOT, lw, ih, lane); } } while (0)
#define SCAN_LWAIT2() do { if (lw < 3) asm volatile("s_waitcnt vmcnt(14)" ::: "memory"); else asm volatile("s_waitcnt vmcnt(12)" ::: "memory"); } while (0)
#define SCAN_LWAIT() do { if (lw < 3) asm volatile("s_waitcnt vmcnt(7)" ::: "memory"); else asm volatile("s_waitcnt vmcnt(6)" ::: "memory"); } while (0)
    if (wave >= 3) {
        const int lw = wave - 3;
        SCAN_STAGE(0); SCAN_STAGE(1); SCAN_STAGE(2);
        SCAN_LWAIT2();
        SCAN_BAR();
        for (int n = 0; n < nsteps; ++n) {
            if (n + 3 < nsteps) { SCAN_STAGE(n + 3); SCAN_LWAIT2(); }
            else if (n + 2 < nsteps) SCAN_LWAIT();
            else asm volatile("s_waitcnt vmcnt(0)" ::: "memory");
            SCAN_BAR();
        }
        return;
    }
    unsigned char* SF = lds + SCAN_UB; unsigned char* XO = lds + SCAN_XO;
    const int r = lane & 31, hh = lane >> 5;
    if (wave < 2) {
        f32x16 S[2];
#pragma unroll
        for (int dt = 0; dt < 2; ++dt)
#pragma unroll
            for (int i = 0; i < 16; ++i) S[dt][i] = 0.f;
#pragma unroll
        for (int f = 0; f < 8; ++f) *(u32x4*)(SF + (wave * 8 + f) * 1024 + lane * 16) = (u32x4){0u, 0u, 0u, 0u};
        SCAN_BAR();
        for (int n = 0; n < nsteps; ++n) {
            const unsigned char* buf = lds + (size_t)(n & 3) * SCAN_SLOT;
            bf16x8 vt[4], kf[8];
            f32x4 av[8];
#pragma unroll
            for (int i = 0; i < 8; ++i) av[i] = *(const f32x4*)(buf + 28 * 1024 + (64 * wave + 32 * (i >> 2) + 8 * (i & 3) + 4 * hh) * 4);
#pragma unroll
            for (int ks = 0; ks < 4; ++ks) vt[ks] = *(const bf16x8*)(buf + (29 + ks) * 1024 + lane * 16);
#pragma unroll
            for (int ks = 0; ks < 4; ++ks)
#pragma unroll
                for (int dt = 0; dt < 2; ++dt) kf[dt * 4 + ks] = SCAN_LDF((2 * wave + dt) * 4 + ks);
#pragma unroll
            for (int dt = 0; dt < 2; ++dt)
#pragma unroll
                for (int g4 = 0; g4 < 4; ++g4) { const f32x4 v = av[4 * dt + g4]; S[dt][4 * g4] *= v[0]; S[dt][4 * g4 + 1] *= v[1]; S[dt][4 * g4 + 2] *= v[2]; S[dt][4 * g4 + 3] *= v[3]; }
#pragma unroll
            for (int ks = 0; ks < 4; ++ks)
#pragma unroll
                for (int dt = 0; dt < 2; ++dt) S[dt] = MFMA32(kf[dt * 4 + ks], vt[ks], S[dt]);
            unsigned char* sfo = SF + (n & 1) * 8192;
#pragma unroll
            for (int dt = 0; dt < 2; ++dt) { const bf16x8 s0 = pack8(S[dt], 0), s1 = pack8(S[dt], 1);
                *(bf16x8*)(sfo + (4 * wave + 2 * dt) * 1024 + lane * 16) = s0; *(bf16x8*)(sfo + (4 * wave + 2 * dt + 1) * 1024 + lane * 16) = s1; }
            SCAN_BAR();
        }
        return;
    }
    bf16_t* OUT = dir ? (bf16_t*)(ws + WS_OB) : (bf16_t*)(ws + WS_AO); const int ldo = dir ? 1024 : 2048;
    SCAN_BAR();
    for (int n = 0; n < nsteps; ++n) {
        const unsigned char* buf = lds + (size_t)(n & 3) * SCAN_SLOT;
        if (dir == 0 && n == 0) { SCAN_BAR(); continue; }
        bf16x8 vt[4], qf[8], af[4], sf[8];
#pragma unroll
        for (int kd = 0; kd < 8; ++kd) { qf[kd] = SCAN_LDF(16 + kd); sf[kd] = *(const bf16x8*)(SF + ((n + 1) & 1) * 8192 + kd * 1024 + lane * 16); }
#pragma unroll
        for (int ks = 0; ks < 4; ++ks) { vt[ks] = *(const bf16x8*)(buf + (29 + ks) * 1024 + lane * 16); af[ks] = SCAN_LDF(24 + ks); }
        f32x16 oa, ob;
#pragma unroll
        for (int i = 0; i < 16; ++i) { oa[i] = 0.f; ob[i] = 0.f; }
#pragma unroll
        for (int kd = 0; kd < 4; ++kd) { oa = MFMA32(sf[kd], qf[kd], oa); ob = MFMA32(sf[4 + kd], qf[4 + kd], ob); }
        oa = MFMA32(vt[0], af[0], oa); ob = MFMA32(vt[2], af[2], ob);
        oa = MFMA32(vt[1], af[1], oa); ob = MFMA32(vt[3], af[3], ob);
        { const int c = dir ? (127 - n) : (n - 1);
          bf16_t* op = OUT + ((size_t)b * SEQ + c * 64 + 32 * ih + r) * ldo + vcol0 + 4 * hh;
#pragma unroll
          for (int g4 = 0; g4 < 4; ++g4) { u32x2 w; w.x = pk2(oa[4 * g4] + ob[4 * g4], oa[4 * g4 + 1] + ob[4 * g4 + 1]); w.y = pk2(oa[4 * g4 + 2] + ob[4 * g4 + 2], oa[4 * g4 + 3] + ob[4 * g4 + 3]);
              *(u32x2*)(op + 8 * g4) = w; } }
        SCAN_BAR();
    }
}

DI void combine_phase(const Args& a, int vcu, int G, int wave, int lane, bf16_t* CDST, int cstride) {
    unsigned char* ws = a.ws;
    bf16_t* AO = (bf16_t*)(ws + WS_AO); const bf16_t* OB = (const bf16_t*)(ws + WS_OB); const bf16_t* GG = (const bf16_t*)a.out;
    const int gw = vcu * NWAVES + wave, NGW = G * NWAVES;
    const f32x4 gn = *(const f32x4*)(a.gla_g + 4 * lane);
    for (int tok = gw; tok < NTOK; tok += NGW) {
        u32x2 f[4], bq[4], gg[4];
#pragma unroll
        for (int h = 0; h < 4; ++h) { f[h] = *(const u32x2*)(AO + (size_t)tok * 2048 + h * 256 + 4 * lane);
            bq[h] = *(const u32x2*)(OB + (size_t)tok * 1024 + h * 256 + 4 * lane); gg[h] = *(const u32x2*)(GG + (size_t)tok * 1024 + h * 256 + 4 * lane); }
#pragma unroll
        for (int h = 0; h < 4; ++h) {
            float o[4];
            o[0] = __uint_as_float(f[h].x << 16) + __uint_as_float(bq[h].x << 16); o[1] = __uint_as_float(f[h].x & 0xffff0000u) + __uint_as_float(bq[h].x & 0xffff0000u);
            o[2] = __uint_as_float(f[h].y << 16) + __uint_as_float(bq[h].y << 16); o[3] = __uint_as_float(f[h].y & 0xffff0000u) + __uint_as_float(bq[h].y & 0xffff0000u);
            const float ss = wave_sum((o[0] * o[0] + o[1] * o[1]) + (o[2] * o[2] + o[3] * o[3]));
            const float rstd = 1.0f / sqrtf(ss * (1.f / 256.f) + RMS_EPS);
            const float g0 = __uint_as_float(gg[h].x << 16), g1 = __uint_as_float(gg[h].x & 0xffff0000u), g2 = __uint_as_float(gg[h].y << 16), g3 = __uint_as_float(gg[h].y & 0xffff0000u);
            u32x2 w; w.x = pk2(o[0] * rstd * gn[0] * g0, o[1] * rstd * gn[1] * g1); w.y = pk2(o[2] * rstd * gn[2] * g2, o[3] * rstd * gn[3] * g3);
            *(u32x2*)(CDST + (size_t)tok * cstride + h * 256 + 4 * lane) = w;
        }
    }
}

#define LAS __attribute__((address_space(3)))
#define XB_TMO      128
#define XB_XCNT(j)  (256  + 64 * (j))
#define XB_XSUB(j)  (1280 + 64 * (j))
#define XB_XGEN(j)  (2304 + 64 * (j))
#define XB_TOP      3328
#define XB_TOPGEN   3392
#define XCD_BAR_WORDS 3456
#define XB_SPIN_CAP (1u << 18)

__device__ __forceinline__ unsigned xb_ld(unsigned* p)              { return __hip_atomic_load(p, __ATOMIC_RELAXED, __HIP_MEMORY_SCOPE_AGENT); }
__device__ __forceinline__ unsigned xb_add(unsigned* p, unsigned v) { return __hip_atomic_fetch_add(p, v, __ATOMIC_RELAXED, __HIP_MEMORY_SCOPE_AGENT); }
__device__ __forceinline__ unsigned xb_xcc_id() { return (unsigned)__builtin_amdgcn_s_getreg((3 << 11) | 20) & 0xFu; }
#define XB_SPIN(cond, bar) do { unsigned _sp = 0; while (cond) { __builtin_amdgcn_s_sleep(1); \
    if ((++_sp & 255u) == 0u) { if (xb_ld(&(bar)[XB_TMO])) break; if (_sp > XB_SPIN_CAP) { atomicAdd(&(bar)[XB_TMO], 1u); break; } } } } while (0)

struct XcdBarrier {
    unsigned* bar; unsigned x;
    volatile LAS unsigned* st;
};

__device__ __forceinline__ XcdBarrier xcd_barrier_post(unsigned* bar, volatile LAS unsigned* st) {
    XcdBarrier b; b.bar = bar; b.x = xb_xcc_id(); b.st = st;
    if (threadIdx.x == 0) (void)xb_add(&bar[XB_XCNT(b.x)], 1u);
    return b;
}
__device__ __forceinline__ void xcd_barrier_complete(unsigned* bar, unsigned x, unsigned& nloc, unsigned& nx) {
    const unsigned G = gridDim.x * gridDim.y * gridDim.z;
    unsigned sum, cnt, mine, sp = 0u;
    for (;;) {
        sum = 0u; cnt = 0u; mine = 0u;
#pragma unroll
        for (unsigned j = 0; j < 16; ++j) { const unsigned c = xb_ld(&bar[XB_XCNT(j)]); sum += c; cnt += (c > 0u) ? 1u : 0u; mine = (j == x) ? c : mine; }
        if (sum == G) break;
        __builtin_amdgcn_s_sleep(1);
        if ((++sp & 255u) == 0u) { if (xb_ld(&bar[XB_TMO])) break; if (sp > XB_SPIN_CAP) { atomicAdd(&bar[XB_TMO], 1u); break; } }
    }
    nloc = mine > 0u ? mine : 1u; nx = cnt > 0u ? cnt : 1u;
}

__device__ __forceinline__ void xcd_barrier(const XcdBarrier& b) {
    asm volatile("s_waitcnt vmcnt(0)" ::: "memory");
    __syncthreads();
    if (threadIdx.x == 0) {
        unsigned* bar = b.bar;
        __builtin_amdgcn_s_waitcnt(0);
        unsigned nloc = b.st[0], nx = b.st[1];
        if (nloc == 0u) { xcd_barrier_complete(bar, b.x, nloc, nx); b.st[0] = nloc; b.st[1] = nx; }
        const unsigned old = xb_add(&bar[XB_XSUB(b.x)], 1u);
        const unsigned gen = old / nloc;
        if (old + 1u == (gen + 1u) * nloc) {
            __builtin_amdgcn_fence(__ATOMIC_RELEASE, "agent");
            asm volatile("s_waitcnt vmcnt(0)" ::: "memory");
            const unsigned og = xb_add(&bar[XB_TOP], 1u);
            const unsigned tg = og / nx;
            if (og + 1u == (tg + 1u) * nx) xb_add(&bar[XB_TOPGEN], 1u);
            else XB_SPIN(xb_ld(&bar[XB_TOPGEN]) == tg, bar);
            __builtin_amdgcn_fence(__ATOMIC_ACQUIRE, "agent");
            xb_add(&bar[XB_XGEN(b.x)], 1u);
            asm volatile("s_waitcnt vmcnt(0)" ::: "memory");
        } else {
            XB_SPIN(xb_ld(&bar[XB_XGEN(b.x)]) == gen, bar);
            __builtin_amdgcn_fence(__ATOMIC_ACQUIRE, "agent");
            asm volatile("s_waitcnt vmcnt(0)" ::: "memory");
        }
    }
    __syncthreads();
}

__global__ void __launch_bounds__(NWAVES * 64, 2) hybrid_fwd(Args args, int ph_lo, int ph_hi) {
    extern __shared__ __attribute__((aligned(16))) unsigned char lds[];
    cg::grid_group grid = cg::this_grid();
    const int tid = threadIdx.x, lane = tid & 63, wave = __builtin_amdgcn_readfirstlane(tid >> 6);
    const int G = gridDim.x, bx = blockIdx.x;
    const int vcu = (G % 8 == 0) ? (bx % 8) * (G / 8) + bx / 8 : bx;
    unsigned char* ws = args.ws;
#ifndef REP_PHASE
#define REP_PHASE -1
#endif
#ifndef PHMASK
#define PHMASK 0x7f
#endif
#define IN(k) (ph_lo <= (k) && (k) < ph_hi && ((PHMASK >> (k)) & 1))
    volatile LAS unsigned* bst = (volatile LAS unsigned*)(lds + LDS_BYTES - 64);
    if (tid < 2) bst[tid] = 0u;
    __syncthreads();
    XcdBarrier bar = xcd_barrier_post((unsigned*)(ws + WS_CTL), bst);
    if (ph_lo < 0) grid.sync();
#define SEAM(k) do { if (IN(k) && IN((k) + 1)) xcd_barrier(bar); } while (0)
    if (IN(0)) { p0_phase(args, lds, vcu, G, wave, lane); if (REP_PHASE == 0 || REP_PHASE == 60) { xcd_barrier(bar); p0_phase(args, lds, vcu, G, wave, lane); } }
    SEAM(0);
    if (IN(1)) {
        p1_skinny(args, vcu, G, wave, lane);
        const bf16_t* XW = (const bf16_t*)(ws + WS_XW);
        pg8::Gemm g{XW, XW, NTOK, 7168, DM};
        OrderIn S{G, bx};
        EpiIn E{(bf16_t*)(ws + WS_QG), (bf16_t*)(ws + WS_KG), (bf16_t*)args.out, (bf16_t*)args.out + (size_t)NTOK * 1024, (bf16_t*)(ws + WS_AO), (bf16_t*)(ws + WS_NK),
                (bf16_t*)(ws + WS_VGT), (bf16_t*)(ws + WS_NVT), args.qn_g, args.kn_g};
        pg8::gemm_phase<EpiIn, OrderIn, true, true>((PG8_LAS unsigned char*)lds, g, S, E);
        }
#if REP_PHASE == 1
    if (IN(1)) { xcd_barrier(bar);
        p1_skinny(args, vcu, G, wave, lane);
        const bf16_t* XW = (const bf16_t*)(ws + WS_XW);
        pg8::Gemm g{XW, XW, NTOK, 7168, DM};
        OrderIn S{G, bx};
        EpiIn E{(bf16_t*)(ws + WS_QG), (bf16_t*)(ws + WS_KG), (bf16_t*)args.out, (bf16_t*)args.out + (size_t)NTOK * 1024, (bf16_t*)(ws + WS_AO), (bf16_t*)(ws + WS_NK),
                (bf16_t*)(ws + WS_VGT), (bf16_t*)(ws + WS_NVT), args.qn_g, args.kn_g};
        pg8::gemm_phase<EpiIn, OrderIn, true, true>((PG8_LAS unsigned char*)lds, g, S, E);
        }
#endif
    SEAM(1);
    if (IN(2)) {
#if REP_PHASE == 2
        na_phase(args, lds, vcu, G, wave, lane, (bf16_t*)(ws + WS_XW), 1024); xcd_barrier(bar);
#endif
        na_phase(args, lds, vcu, G, wave, lane, (bf16_t*)(ws + WS_AO) + 1024, 2048); }
    SEAM(2);
    if (IN(3)) { prep_phase(args, lds, vcu, G, wave, lane); if (REP_PHASE == 3) { xcd_barrier(bar); prep_phase(args, lds, vcu, G, wave, lane); } }
    SEAM(3);
    if (IN(4)) { scan_phase(args, lds, wave, lane); if (REP_PHASE == 4) { xcd_barrier(bar); scan_phase(args, lds, wave, lane); } }
    SEAM(4);
#ifdef REP_SYNC
    for (int i_ = 0; i_ < REP_SYNC; ++i_) xcd_barrier(bar);
#endif
    if (IN(5)) {
#if REP_PHASE == 5
        combine_phase(args, vcu, G, wave, lane, (bf16_t*)(ws + WS_XW), 1024); xcd_barrier(bar);
#endif
        combine_phase(args, vcu, G, wave, lane, (bf16_t*)(ws + WS_AO), 2048); }
    SEAM(5);
    if (IN(6)) {
        pg8::Gemm g{(const bf16_t*)(ws + WS_AO), (const bf16_t*)(ws + WS_WO), NTOK, DM, 2048};
        pg8::StaticOrder S; S.init(NTOK, DM, G, bx);
        EpiOut E{args.x, args.out};
        pg8::gemm_phase<EpiOut, pg8::StaticOrder, false, true>((PG8_LAS unsigned char*)lds, g, S, E);
        }
#if REP_PHASE == 6 || REP_PHASE == 60
    if (IN(6)) { xcd_barrier(bar);
        pg8::Gemm g{(const bf16_t*)(ws + WS_AO), (const bf16_t*)(ws + WS_WO), NTOK, DM, 2048};
        pg8::StaticOrder S; S.init(NTOK, DM, G, bx);
        EpiOut E{args.x, args.out};
        pg8::gemm_phase<EpiOut, pg8::StaticOrder, false, true>((PG8_LAS unsigned char*)lds, g, S, E);
        }
#endif
#ifdef SCAN_DBG
    if (bx == 0 && tid == 0) { const float* dbg = (const float*)(ws + WS_ZM + 480 * 1024); const float ratio = dbg[0] / dbg[1];
        args.out[0] = (DBG_WHAT == 0) ? (ratio < 0.33f ? 100.f : (ratio < 0.66f ? 200.f : 300.f)) : (dbg[1] < 10000.f ? 100.f : (dbg[1] < 15000.f ? 200.f : (dbg[1] < 20000.f ? 300.f : 400.f))); }
#endif
#ifdef SCAN_DBG
    if (bx == 0 && tid == 0) { const float* dbg = (const float*)(ws + WS_ZM + 480 * 1024);
        const float ratio = (DBG_WHAT == 0 ? dbg[0] : dbg[2]) / dbg[1];
        args.out[0] = (DBG_WHAT == 2) ? 100.f * floorf(dbg[1] * (1.f / 100000.f) + 1.f) : 100.f * (1.f + floorf(ratio * 5.f)); }
#endif
#undef IN
#undef SEAM
}

#ifndef N_LAUNCHES
#define N_LAUNCHES 1
#endif
extern "C" void kernel_launch(void* const* d_in, const int* in_sizes, int n_in, void* d_out, int out_size, void* d_ws, size_t ws_size, hipStream_t stream) {
    static int grid = 0;
    if (grid == 0) {
        if (n_in != 14 || out_size != NTOK * DM || ws_size < WS_END) { fprintf(stderr, "kernel_launch: unexpected problem (n_in %d out %d ws %zu)\n", n_in, out_size, ws_size); grid = -1; return; }
        int dev = 0, cus = 0, per_cu = 0;
        hipGetDevice(&dev); hipDeviceGetAttribute(&cus, hipDeviceAttributeMultiprocessorCount, dev);
        if (hipFuncSetAttribute((const void*)hybrid_fwd, hipFuncAttributeMaxDynamicSharedMemorySize, LDS_BYTES) != hipSuccess) { fprintf(stderr, "kernel_launch: hipFuncSetAttribute failed\n"); grid = -1; return; }
        if (hipOccupancyMaxActiveBlocksPerMultiprocessor(&per_cu, (const void*)hybrid_fwd, NWAVES * 64, LDS_BYTES) != hipSuccess || per_cu < 1) { fprintf(stderr, "kernel_launch: occupancy query gave %d\n", per_cu); per_cu = 1; }
        (void)hipGetLastError();
        grid = cus * per_cu;
        if (grid > 256) grid = 256;
    }
    if (grid < 0) return;
    Args a{};
    a.x = (const float*)d_in[0]; a.meta = (const float*)d_in[1]; a.norm_g = (const float*)d_in[2]; a.w_in = (const float*)d_in[3];
    a.wd_f = (const float*)d_in[4]; a.bd_f = (const float*)d_in[5]; a.wd_b = (const float*)d_in[6]; a.bd_b = (const float*)d_in[7];
    a.gla_g = (const float*)d_in[8]; a.qn_g = (const float*)d_in[9]; a.kn_g = (const float*)d_in[10]; a.rpb = (const float*)d_in[11];
    a.meta_bias = (const float*)d_in[12]; a.w_out = (const float*)d_in[13];
    a.out = (float*)d_out; a.ws = (unsigned char*)d_ws;
    if (hipMemsetAsync((char*)d_ws + WS_CTL, 0, 16384, stream) != hipSuccess) { fprintf(stderr, "kernel_launch: memset of the barrier words failed\n"); return; }
#if N_LAUNCHES == 1
    int lo = 0, hi = 7;
    void* kargs[] = {&a, &lo, &hi};
    hipError_t e = hipLaunchCooperativeKernel((const void*)hybrid_fwd, dim3(grid), dim3(NWAVES * 64), kargs, LDS_BYTES, stream);
    if (e != hipSuccess) fprintf(stderr, "kernel_launch: cooperative launch failed: %s (grid %d)\n", hipGetErrorString(e), grid);
#else
    for (int p = 0; p < 7; ++p) hipLaunchKernelGGL(hybrid_fwd, dim3(grid), dim3(NWAVES * 64), LDS_BYTES, stream, a, p, p + 1);
#endif
}
```

```cpp
#include <hip/hip_runtime.h>
#include <hip/hip_cooperative_groups.h>
#include <cstdio>
#include <cstdint>
namespace cg = cooperative_groups;
namespace pg8 {
#define PG8_LAS __attribute__((address_space(3)))
typedef unsigned short bf16_t;
typedef short bf16x8 __attribute__((ext_vector_type(8)));
typedef float f32x4 __attribute__((ext_vector_type(4)));
typedef unsigned u32x4 __attribute__((ext_vector_type(4)));
constexpr int BM = 256, BK = 64, HALF = 128, HTB = HALF * BK * 2  , STAGE_BYTES = 8 * HTB, NXCD = 8, WGM = 8;

__host__ __device__ __forceinline__ int lds_byte(int r, int c) { const int st = (r >> 4) * 2 + (c >> 5), rr = r & 15, cc = c & 31, ob = rr * 64 + cc * 2; return st * 1024 + (ob ^ (((ob >> 9) & 1) << 5)); }
__host__ __device__ __forceinline__ void stage_rc(int b, int& R, int& C) { const int st = b / 1024, sb = b % 1024, swz = sb ^ (((sb >> 9) & 1) << 5); R = (st >> 1) * 16 + swz / 64; C = (st & 1) * 32 + (swz % 64) / 2; }
__host__ __device__ __forceinline__ int perm32(int rho) { const int n = rho >> 4, i = rho & 15; return 8 * (i >> 2) + 4 * n + (i & 3); }

struct Unit { int pm, pn; };
struct Gemm { const bf16_t* A; const bf16_t* Bt; int M, N, K; };

struct StaticOrder {
    int nM, nN, nwg, G, c;
    __host__ __device__ void init(int M, int N, int G_, int c_) { nM = M / BM; nN = N / BM; nwg = nM * nN; G = G_; c = c_; }
    __host__ __device__ bool next(int i, Unit& u) const {
        const long L = (long)i * G + c; if (L >= nwg) return false;
        int wgid = (int)L; { const int q = nwg / NXCD, r = nwg % NXCD, xcd = wgid % NXCD, off = wgid / NXCD; wgid = (xcd < r ? xcd * (q + 1) : r * (q + 1) + (xcd - r) * q) + off; }
        const int nig = WGM * nN, gid = wgid / nig, fm = gid * WGM, gsz = (nM - fm) < WGM ? (nM - fm) : WGM;
        u.pm = fm + ((wgid % nig) % gsz); u.pn = (wgid % nig) / gsz; return true;
    }
    __device__ __forceinline__ void a_ready(const Unit&) const {}
    __device__ __forceinline__ void done(const Unit&) const {}
};

__device__ __forceinline__ unsigned cvt_pk_bf16(float lo, float hi) { unsigned r; asm volatile("v_cvt_pk_bf16_f32 %0, %1, %2" : "=v"(r) : "v"(lo), "v"(hi)); return r; }
template <class Epi, class Sched, bool ALIGN_EPI = false, bool SP2 = false>
__device__ __forceinline__ void gemm_phase(PG8_LAS unsigned char* lds, const Gemm g, const Sched& S, const Epi& E) {
    const int tid = threadIdx.x, wid = __builtin_amdgcn_readfirstlane(tid >> 6), lane = tid & 63, wr = wid >> 2, wc = wid & 3, fr = lane & 15, fq = lane >> 4;
    const int K = g.K, nt = K / BK;
    unsigned voffA[2], voffB[2];
#pragma unroll
    for (int i = 0; i < 2; ++i) { int R, C; stage_rc(tid * 16 + i * 8192, R, C); const int Rb = Epi::PERM ? ((R & ~31) + perm32(R & 31)) : R;
        voffA[i] = (unsigned)(R * K + C) * 2u; voffB[i] = (unsigned)(Rb * K + C) * 2u; }
    const size_t kstep = (size_t)(BK * 2);
    const size_t hstep = (size_t)HALF * K * 2;
    const size_t tstep = 2 * hstep;
    const unsigned ldsw = (unsigned)wid * 1024u;
    const int aoff = lds_byte(wr * 64 + fr, fq * 8), boff = lds_byte(wc * 32 + fr, fq * 8);
#define PG8_SA(b, h) (((b) * 2 + (h)) * HTB)
#define PG8_SB(b, h) ((4 + (b) * 2 + (h)) * HTB)
#define PG8_STAGE(bufoff, gbase, voff) do { _Pragma("unroll") for (int _i = 0; _i < 2; ++_i) \
        __builtin_amdgcn_global_load_lds((const unsigned*)((const char*)(gbase) + (voff)[_i]), (PG8_LAS unsigned*)(lds + (bufoff) + ldsw + _i * 8192), 16, 0, 0); } while (0)
#define PG8_LDA(dst, b, h) do { _Pragma("unroll") for (int m = 0; m < 4; ++m) _Pragma("unroll") for (int k = 0; k < 2; ++k) dst[m][k] = *(const PG8_LAS bf16x8*)(lds + PG8_SA(b, h) + aoff + m * 2048 + k * 1024); } while (0)
#define PG8_LDB(dst, b, h) do { _Pragma("unroll") for (int n = 0; n < 2; ++n) _Pragma("unroll") for (int k = 0; k < 2; ++k) dst[n][k] = *(const PG8_LAS bf16x8*)(lds + PG8_SB(b, h) + boff + n * 2048 + k * 1024); } while (0)
#define PG8_MMA(ai, bj, At, Bt) do { __builtin_amdgcn_s_setprio(1); _Pragma("unroll") for (int m = 0; m < 4; ++m) _Pragma("unroll") for (int n = 0; n < 2; ++n) _Pragma("unroll") for (int k = 0; k < 2; ++k) \
        acc[ai][bj][m][n] = __builtin_amdgcn_mfma_f32_16x16x32_bf16(Bt[n][k], At[m][k], acc[ai][bj][m][n], 0, 0, 0); __builtin_amdgcn_s_setprio(0); } while (0)
#define PG8_WAIT_V(n) asm volatile("s_waitcnt vmcnt(" #n ")" ::: "memory")
#define PG8_WAIT_L(n) asm volatile("s_waitcnt lgkmcnt(" #n ")" ::: "memory")
#define PG8_BAR __builtin_amdgcn_s_barrier()
#define PG8_SCHED __builtin_amdgcn_sched_barrier(0)
    Unit cur, nxt; int ui = 0;
    if (!S.next(0, cur)) return;
    f32x4 acc[2][2][4][2];
#pragma unroll
    for (int a = 0; a < 2; ++a)
#pragma unroll
        for (int b = 0; b < 2; ++b)
#pragma unroll
            for (int m = 0; m < 4; ++m)
#pragma unroll
                for (int n = 0; n < 2; ++n) acc[a][b][m][n] = (f32x4){0.f, 0.f, 0.f, 0.f};
    bf16x8 At[4][2], B0[2][2], B1[2][2];
    const char* cA = (const char*)g.A + (size_t)cur.pm * tstep; const char* cB = (const char*)g.Bt + (size_t)cur.pn * tstep;
    S.a_ready(cur);
    if constexpr (SP2) {
        PG8_STAGE(PG8_SB(0, 0), cB, voffB); PG8_STAGE(PG8_SB(0, 1), cB + hstep, voffB); PG8_STAGE(PG8_SA(0, 0), cA, voffA); PG8_STAGE(PG8_SA(0, 1), cA + hstep, voffA);
        if (wr == 1) PG8_BAR;
        PG8_WAIT_V(2); PG8_BAR;
        PG8_STAGE(PG8_SB(1, 0), cB + kstep, voffB); PG8_STAGE(PG8_SA(1, 0), cA + kstep, voffA); PG8_STAGE(PG8_SB(1, 1), cB + hstep + kstep, voffB);
        PG8_WAIT_V(6); PG8_BAR;
    } else {
        PG8_STAGE(PG8_SB(0, 0), cB, voffB); PG8_STAGE(PG8_SA(0, 0), cA, voffA); PG8_STAGE(PG8_SB(0, 1), cB + hstep, voffB); PG8_STAGE(PG8_SA(0, 1), cA + hstep, voffA);
        if (wr == 1) PG8_BAR;
        PG8_WAIT_V(4); PG8_BAR;
        PG8_STAGE(PG8_SB(1, 0), cB + kstep, voffB); PG8_STAGE(PG8_SA(1, 0), cA + kstep, voffA); PG8_STAGE(PG8_SB(1, 1), cB + hstep + kstep, voffB);
        PG8_WAIT_V(6); PG8_BAR;
    }
    for (;;) {
        const bool has_next = S.next(ui + 1, nxt);
        const char* nA = has_next ? (const char*)g.A + (size_t)nxt.pm * tstep : cA; const char* nB = has_next ? (const char*)g.Bt + (size_t)nxt.pn * tstep : cB;
        for (int t = 0; t < nt; t += 2) {
            const bool last = (t == nt - 2);
            const char* a1 = cA + (size_t)(t + 1) * kstep;
            const char* a2 = last ? nA : cA + (size_t)(t + 2) * kstep; const char* b2 = last ? nB : cB + (size_t)(t + 2) * kstep;
            const char* a3 = a2 + kstep; const char* b3 = b2 + kstep;
            if (last && has_next) S.a_ready(nxt);
            if constexpr (SP2) {
            PG8_LDB(B0, 0, 0); PG8_LDB(B1, 0, 1); PG8_SCHED; PG8_LDA(At, 0, 0); PG8_STAGE(PG8_SA(1, 1), a1 + hstep, voffA);
            PG8_WAIT_V(8); PG8_WAIT_L(0); PG8_BAR; PG8_MMA(0, 0, At, B0); PG8_MMA(0, 1, At, B1); PG8_BAR; PG8_SCHED;
            PG8_LDA(At, 0, 1); PG8_STAGE(PG8_SB(0, 0), b2, voffB); PG8_STAGE(PG8_SB(0, 1), b2 + hstep, voffB); PG8_STAGE(PG8_SA(0, 0), a2, voffA);
            PG8_WAIT_V(8); PG8_WAIT_L(0); PG8_BAR; PG8_MMA(1, 0, At, B0); PG8_MMA(1, 1, At, B1); PG8_BAR; PG8_SCHED;
            PG8_LDB(B0, 1, 0); PG8_LDB(B1, 1, 1); PG8_SCHED; PG8_LDA(At, 1, 0); PG8_STAGE(PG8_SA(0, 1), a2 + hstep, voffA);
            PG8_WAIT_V(8); PG8_WAIT_L(0); PG8_BAR; PG8_MMA(0, 0, At, B0); PG8_MMA(0, 1, At, B1); PG8_BAR; PG8_SCHED;
            PG8_LDA(At, 1, 1); PG8_STAGE(PG8_SB(1, 0), b3, voffB); PG8_STAGE(PG8_SB(1, 1), b3 + hstep, voffB); PG8_STAGE(PG8_SA(1, 0), a3, voffA);
            PG8_WAIT_V(8); PG8_WAIT_L(0); PG8_BAR; PG8_MMA(1, 0, At, B0); PG8_MMA(1, 1, At, B1); PG8_BAR; PG8_SCHED;
            } else {
            PG8_LDB(B0, 0, 0); PG8_SCHED; PG8_LDA(At, 0, 0); PG8_STAGE(PG8_SA(1, 1), a1 + hstep, voffA);
            PG8_WAIT_L(8); PG8_BAR; PG8_WAIT_L(0); PG8_MMA(0, 0, At, B0); PG8_BAR; PG8_SCHED;
            PG8_LDB(B1, 0, 1); PG8_STAGE(PG8_SB(0, 0), b2, voffB);
            PG8_BAR; PG8_WAIT_L(0); PG8_MMA(0, 1, At, B1); PG8_BAR;
            PG8_LDA(At, 0, 1); PG8_STAGE(PG8_SA(0, 0), a2, voffA);
            PG8_BAR; PG8_WAIT_L(0); PG8_MMA(1, 0, At, B0); PG8_BAR; PG8_SCHED;
            PG8_STAGE(PG8_SB(0, 1), b2 + hstep, voffB);
            PG8_WAIT_V(6); PG8_BAR; PG8_MMA(1, 1, At, B1); PG8_BAR;
            PG8_LDB(B0, 1, 0); PG8_SCHED; PG8_LDA(At, 1, 0); PG8_STAGE(PG8_SA(0, 1), a2 + hstep, voffA);
            PG8_WAIT_L(8); PG8_BAR; PG8_WAIT_L(0); PG8_MMA(0, 0, At, B0); PG8_BAR; PG8_SCHED;
            PG8_LDB(B1, 1, 1); PG8_STAGE(PG8_SB(1, 0), b3, voffB);
            PG8_BAR; PG8_WAIT_L(0); PG8_MMA(0, 1, At, B1); PG8_BAR;
            PG8_LDA(At, 1, 1); PG8_STAGE(PG8_SA(1, 0), a3, voffA);
            PG8_BAR; PG8_WAIT_L(0); PG8_MMA(1, 0, At, B0); PG8_BAR; PG8_SCHED;
            PG8_STAGE(PG8_SB(1, 1), b3 + hstep, voffB);
            PG8_WAIT_V(6); PG8_BAR; PG8_MMA(1, 1, At, B1); PG8_BAR;
            }
        }
        if constexpr (ALIGN_EPI) { if (wr == 0) PG8_BAR; }
        if constexpr (!Epi::AFTER_DRAIN) { E(acc, cur, wr, wc, fr, fq); S.done(cur); }
        if (!has_next) break;
#pragma unroll
        for (int a = 0; a < 2; ++a)
#pragma unroll
            for (int b = 0; b < 2; ++b)
#pragma unroll
                for (int m = 0; m < 4; ++m)
#pragma unroll
                    for (int n = 0; n < 2; ++n) acc[a][b][m][n] = (f32x4){0.f, 0.f, 0.f, 0.f};
        cur = nxt; cA = nA; cB = nB; ++ui;
        if constexpr (ALIGN_EPI) { if (wr == 1) PG8_BAR; }
    }
    PG8_WAIT_V(0);
    if constexpr (!ALIGN_EPI) { if (wr == 0) PG8_BAR; }
    PG8_BAR;
    if constexpr (Epi::AFTER_DRAIN) { E.fused(acc, cur, wr, wc, fr, fq, lds, wid, lane); S.done(cur); }
#undef PG8_SA
#undef PG8_SB
#undef PG8_STAGE
#undef PG8_LDA
#undef PG8_LDB
#undef PG8_MMA
#undef PG8_WAIT_V
#undef PG8_WAIT_L
#undef PG8_BAR
#undef PG8_SCHED
}
}

#define DI __device__ __forceinline__
typedef unsigned short bf16_t;
typedef short bf16x8 __attribute__((ext_vector_type(8)));
typedef float f32x4 __attribute__((ext_vector_type(4)));
typedef float f32x2 __attribute__((ext_vector_type(2)));
typedef float f32x16 __attribute__((ext_vector_type(16)));
typedef unsigned u32x4 __attribute__((ext_vector_type(4)));
typedef unsigned u32x2 __attribute__((ext_vector_type(2)));
typedef __bf16 bf2_t __attribute__((ext_vector_type(2)));

constexpr int NTOK = 16384, SEQ = 8192, DM = 1024, NIN = 7200, NWAVES = 8;
constexpr float RMS_EPS = 1e-6f;
constexpr float LOG2E = 1.4426950408889634f;
constexpr size_t MiB = (size_t)1 << 20;
constexpr size_t WS_ZM = 0, WS_VMT = 512 * 1024, WS_UM = 640 * 1024, WS_WS = 704 * 1024, WS_R = 1 * MiB, WS_WO = 3 * MiB, WS_XW = 8 * MiB,
                 WS_AO = 54 * MiB, WS_NK = 118 * MiB, WS_NVT = 150 * MiB, WS_VGT = 182 * MiB, WS_QG = 214 * MiB, WS_KG = 230 * MiB, WS_OB = 214 * MiB,
                 WS_PKF = WS_XW, WS_PKB = WS_NK, WS_CTL = 246 * MiB, WS_END = 247 * MiB;
constexpr int PK_BYTES = 41472;
constexpr int PK_A_OFF = 40960;
constexpr int LDS_BYTES = 163840;

DI unsigned pk2(float lo, float hi) { f32x2 v = {lo, hi}; bf2_t b = __builtin_convertvector(v, bf2_t); return __builtin_bit_cast(unsigned, b); }
DI float bf2f(bf16_t u) { return __uint_as_float(((unsigned)u) << 16); }
DI float wave_sum(float v) {
#pragma unroll
    for (int o = 1; o < 64; o <<= 1) v += __shfl_xor(v, o);
    return v;
}
DI float silu_f(float x) { return x * __builtin_amdgcn_rcpf(1.f + __expf(-x)); }
DI int crow(int reg, int h) { return (reg & 3) + 8 * (reg >> 2) + 4 * h; }
#define MFMA32(a, b, c) __builtin_amdgcn_mfma_f32_32x32x16_bf16((a), (b), (c), 0, 0, 0)
#define MFMA16(a, b, c) __builtin_amdgcn_mfma_f32_16x16x32_bf16((a), (b), (c), 0, 0, 0)

struct Args {
    const float *x, *meta, *norm_g, *w_in, *wd_f, *bd_f, *wd_b, *bd_b, *gla_g, *qn_g, *kn_g, *rpb, *meta_bias, *w_out;
    float* out; unsigned char* ws;
};

DI int phys_norm(int wt, int lc) { return 256 * wt + 128 * ((lc >> 5) & 1) + 32 * (lc >> 6) + (lc & 31); }

DI void p0_transpose_item(const float* W, int ldw, int k0, int n0, bf16_t* WT, int ldwt, int row0, float* scr, int lane) {
#pragma unroll 8
    for (int i = 0; i < 32; ++i) { const int kk = 2 * i + (lane >> 5); scr[kk * 33 + (lane & 31)] = W[(size_t)(k0 + kk) * ldw + n0 + (lane & 31)]; }
    asm volatile("s_waitcnt lgkmcnt(0)" ::: "memory");
    const int c = lane & 7;
#pragma unroll
    for (int j = 0; j < 4; ++j) { const int n = (lane >> 3) + 8 * j; const float* s = scr + (8 * c) * 33 + n;
        u32x4 o; o.x = pk2(s[0 * 33], s[1 * 33]); o.y = pk2(s[2 * 33], s[3 * 33]); o.z = pk2(s[4 * 33], s[5 * 33]); o.w = pk2(s[6 * 33], s[7 * 33]);
        *(u32x4*)(WT + (size_t)(row0 + n) * ldwt + k0 + 8 * c) = o; }
    asm volatile("s_waitcnt lgkmcnt(0)" ::: "memory");
}
DI int wt_base(int wt) {
    if (wt < 2) return 0 + 256 * wt;
    if (wt < 4) return 512 + 256 * (wt - 2);
    if (wt < 8) return 2080 + 256 * (wt - 4);
    if (wt < 12) return 3104 + 256 * (wt - 8);
    if (wt < 16) return 4128 + 256 * (wt - 12);
    if (wt < 20) return 6176 + 256 * (wt - 16);
    if (wt < 24) return 1024 + 256 * (wt - 20);
    return 5152 + 256 * (wt - 24);
}
DI void rms_row_to_bf16(const float* xrow, const float* g, bf16_t* orow, int lane) {
    const f32x4* xr = (const f32x4*)xrow + lane; const f32x4* gr = (const f32x4*)g + lane;
    f32x4 v[4]; float s = 0.f;
#pragma unroll
    for (int j = 0; j < 4; ++j) { v[j] = xr[64 * j]; s += (v[j].x * v[j].x + v[j].y * v[j].y) + (v[j].z * v[j].z + v[j].w * v[j].w); }
    const float rstd = 1.0f / sqrtf(wave_sum(s) * (1.f / DM) + RMS_EPS);
    unsigned long long* o8 = (unsigned long long*)orow + lane;
#pragma unroll
    for (int j = 0; j < 4; ++j) { const f32x4 gg = gr[64 * j];
        o8[64 * j] = (unsigned long long)pk2(v[j].x * rstd * gg.x, v[j].y * rstd * gg.y) | ((unsigned long long)pk2(v[j].z * rstd * gg.z, v[j].w * rstd * gg.w) << 32); }
}
DI void p0_block_item(const float* W, int ldw, int k0, int n0, bool perm, bf16_t* WT, int ldwt, int row0, float* T  , int tid) {
    f32x4 v[8];
#pragma unroll
    for (int i = 0; i < 8; ++i) { const int e = tid + 512 * i, kk = e >> 6, c4 = e & 63; v[i] = *(const f32x4*)(W + (size_t)(k0 + kk) * ldw + n0 + 4 * c4); }
#pragma unroll
    for (int i = 0; i < 8; ++i) { const int e = tid + 512 * i, kk = e >> 6, c4 = e & 63; float* t = T + kk * 257 + 4 * c4; t[0] = v[i][0]; t[1] = v[i][1]; t[2] = v[i][2]; t[3] = v[i][3]; }
    __syncthreads();
    { const int pp = tid >> 1, kh = tid & 1; const int lc = perm ? (64 * ((pp >> 5) & 3) + 32 * (pp >> 7) + (pp & 31)) : pp;
      const float* t = T + (32 * kh) * 257 + lc;
      unsigned w[16];
#pragma unroll
      for (int j = 0; j < 16; ++j) w[j] = pk2(t[(2 * j) * 257], t[(2 * j + 1) * 257]);
      u32x4* dst = (u32x4*)(WT + (size_t)(row0 + pp) * ldwt + k0 + 32 * kh);
#pragma unroll
      for (int j = 0; j < 4; ++j) dst[j] = (u32x4){w[4 * j], w[4 * j + 1], w[4 * j + 2], w[4 * j + 3]}; }
    __syncthreads();
}
DI void rms_rows2_to_bf16(const float* x0, const float* x1, const float* g, bf16_t* o0, bf16_t* o1, int lane) {
    const f32x4* xa = (const f32x4*)x0 + lane; const f32x4* xb = (const f32x4*)x1 + lane; const f32x4* gr = (const f32x4*)g + lane;
    f32x4 va[4], vb[4]; float sa = 0.f, sb2 = 0.f;
#pragma unroll
    for (int j = 0; j < 4; ++j) { va[j] = xa[64 * j]; vb[j] = xb[64 * j]; }
#pragma unroll
    for (int j = 0; j < 4; ++j) { sa += (va[j].x * va[j].x + va[j].y * va[j].y) + (va[j].z * va[j].z + va[j].w * va[j].w); sb2 += (vb[j].x * vb[j].x + vb[j].y * vb[j].y) + (vb[j].z * vb[j].z + vb[j].w * vb[j].w); }
    const float ra = 1.0f / sqrtf(wave_sum(sa) * (1.f / DM) + RMS_EPS), rb = 1.0f / sqrtf(wave_sum(sb2) * (1.f / DM) + RMS_EPS);
    unsigned long long* oa = (unsigned long long*)o0 + lane; unsigned long long* ob = (unsigned long long*)o1 + lane;
#pragma unroll
    for (int j = 0; j < 4; ++j) { const f32x4 gg = gr[64 * j];
        oa[64 * j] = (unsigned long long)pk2(va[j].x * ra * gg.x, va[j].y * ra * gg.y) | ((unsigned long long)pk2(va[j].z * ra * gg.z, va[j].w * ra * gg.w) << 32);
        ob[64 * j] = (unsigned long long)pk2(vb[j].x * rb * gg.x, vb[j].y * rb * gg.y) | ((unsigned long long)pk2(vb[j].z * rb * gg.z, vb[j].w * rb * gg.w) << 32); }
}
DI void p0_phase(const Args& a, unsigned char* lds, int vcu, int G, int wave, int lane) {
    unsigned char* ws = a.ws;
    bf16_t* XW = (bf16_t*)(ws + WS_XW); bf16_t* WSs = (bf16_t*)(ws + WS_WS); bf16_t* WO = (bf16_t*)(ws + WS_WO); bf16_t* UM = (bf16_t*)(ws + WS_UM);
    const int gw = vcu * NWAVES + wave, NGW = G * NWAVES, tid = wave * 64 + lane;
    for (int it = vcu; it < 448 + 128; it += G) {
        if (it < 448) { const int kb = it / 28, wt = it % 28; p0_block_item(a.w_in, NIN, 64 * kb, wt_base(wt), wt < 20, XW, DM, NTOK + 256 * wt, (float*)lds, tid); }
        else { const int r = it - 448, kb = r >> 2, nb = r & 3; p0_block_item(a.w_out, DM, 64 * kb, 256 * nb, false, WO, 2048, 256 * nb, (float*)lds, tid); }
    }
    { float* scr = (float*)(lds + wave * 16384);
      for (int it = gw; it < 16; it += NGW) p0_transpose_item(a.w_in, NIN, 64 * it, 2048, WSs, DM, 0, scr, lane); }
    for (int m = 2 * gw; m < NTOK; m += 2 * NGW) rms_rows2_to_bf16(a.x + (size_t)m * DM, a.x + (size_t)(m + 1) * DM, a.norm_g, XW + (size_t)m * DM, XW + (size_t)(m + 1) * DM, lane);
    for (int m = gw; m < 16; m += NGW) rms_row_to_bf16(a.meta + (size_t)m * DM, a.norm_g, UM + (size_t)m * DM, lane);
}

DI void skinny_task(const bf16_t* A, const bf16_t* B, float* O, int ldo, int lane) {
    const int r = lane & 15, q = lane >> 4;
    const bf16x8* ap = (const bf16x8*)(A + (size_t)r * DM + 8 * q);
    const bf16x8* b0 = (const bf16x8*)(B + (size_t)r * DM + 8 * q);
    const bf16x8* b1 = (const bf16x8*)(B + (size_t)(16 + r) * DM + 8 * q);
    f32x4 acc0 = {0.f, 0.f, 0.f, 0.f}, acc1 = {0.f, 0.f, 0.f, 0.f};
#pragma unroll
    for (int kh = 0; kh < 2; ++kh) {
        bf16x8 av[16], bv0[16], bv1[16];
#pragma unroll
        for (int ks = 0; ks < 16; ++ks) { av[ks] = ap[4 * (16 * kh + ks)]; bv0[ks] = b0[4 * (16 * kh + ks)]; bv1[ks] = b1[4 * (16 * kh + ks)]; }
#pragma unroll
        for (int ks = 0; ks < 16; ++ks) { acc0 = MFMA16(av[ks], bv0[ks], acc0); acc1 = MFMA16(av[ks], bv1[ks], acc1); }
    }
#pragma unroll
    for (int i = 0; i < 4; ++i) { O[(size_t)(4 * q + i) * ldo + r] = acc0[i]; O[(size_t)(4 * q + i) * ldo + 16 + r] = acc1[i]; }
}
DI void p1_skinny(const Args& a, int vcu, int G, int wave, int lane) {
    unsigned char* ws = a.ws;
    const bf16_t* XW = (const bf16_t*)(ws + WS_XW); const bf16_t* WSs = (const bf16_t*)(ws + WS_WS); const bf16_t* UM = (const bf16_t*)(ws + WS_UM);
    float* R = (float*)(ws + WS_R); float* ZM = (float*)(ws + WS_ZM);
    const int gw = vcu * NWAVES + wave, NGW = G * NWAVES;
    for (int t = gw; t < 1024 + 225; t += NGW) {
        if (t < 1024) skinny_task(XW + (size_t)t * 16 * DM, WSs, R + (size_t)t * 16 * 32, 32, lane);
        else { const int c = t - 1024;
            if (c < 224) skinny_task(UM, XW + (size_t)(NTOK + 32 * c) * DM, ZM + 32 * c, NIN, lane);
            else skinny_task(UM, WSs, ZM + 7168, NIN, lane); }
    }
}

struct OrderIn {
    int G, c;
    DI bool next(int i, pg8::Unit& u) const {
        const long L = (long)i * G + c; if (L >= 1792) return false;
        const int ii = (int)(L >> 8), cc = (int)(L & 255), xcd = cc & 7, j = cc >> 3, tok = 8 * xcd + (j & 7), w4 = j >> 3;
        if (ii < 5) { u.pm = tok; u.pn = 64 + 4 * ii + w4; } else { u.pm = 64 + 20 + 4 * (ii - 5) + w4; u.pn = tok; }
        return true;
    }
    DI void a_ready(const pg8::Unit&) const {}
    DI void done(const pg8::Unit&) const {}
};

struct EpiIn {
    static constexpr bool PERM = true, AFTER_DRAIN = false;
    bf16_t *QG, *KG, *GG, *NGt, *AO, *NK, *VGT, *NVT; const float *qn_g, *kn_g;
    DI void operator()(const f32x4 (&acc)[2][2][4][2], const pg8::Unit& u, int wr, int wc, int fr, int fq) const {
        if (u.pm < 64) {
            const int wt = u.pn - 64;
            const int row0 = u.pm * 256 + wr * 64 + fr;
            if (wt < 8 || wt >= 16) {
                bf16_t* base; int ld; float sc = 1.f; bool act = false;
                if (wt < 2) { base = QG + 256 * wt; ld = 512; sc = 0.08838834764831845f; }
                else if (wt < 4) { base = KG + 256 * (wt - 2); ld = 512; }
                else if (wt < 8) { base = GG + 256 * (wt - 4); ld = 1024; act = true; }
                else { base = NGt + 256 * (wt - 16); ld = 1024; act = true; }
#pragma unroll
                for (int ai = 0; ai < 2; ++ai)
#pragma unroll
                    for (int m = 0; m < 4; ++m) { bf16_t* rowp = base + (size_t)(row0 + ai * 128 + m * 16) * ld + 64 * wc + 8 * fq;
#pragma unroll
                        for (int bj = 0; bj < 2; ++bj) { f32x4 v0 = acc[ai][bj][m][0], v1 = acc[ai][bj][m][1];
                            if (act) { v0 = (f32x4){silu_f(v0[0]), silu_f(v0[1]), silu_f(v0[2]), silu_f(v0[3])}; v1 = (f32x4){silu_f(v1[0]), silu_f(v1[1]), silu_f(v1[2]), silu_f(v1[3])}; }
                            v0 = v0 * sc; v1 = v1 * sc;
                            u32x4 w; w.x = pk2(v0[0], v0[1]); w.y = pk2(v0[2], v0[3]); w.z = pk2(v1[0], v1[1]); w.w = pk2(v1[2], v1[3]);
                            *(u32x4*)(rowp + 32 * bj) = w; } }
            } else {
                const bool isq = wt < 12; const float* g = isq ? qn_g : kn_g; const float gs = isq ? (0.125f * LOG2E) : 1.0f;
                const int kb_ = u.pm >> 5, kgrow_ = (u.pm & 31) * 4 + wr;
                bf16_t* base = isq ? (AO + 1024 + 256 * (wt - 8)) : (NK + ((size_t)((kb_ * 16 + 4 * (wt - 12) + wc) * 128 + kgrow_) * 4096)); const int ld = isq ? 2048 : 1024;
                f32x4 gv[2][2];
#pragma unroll
                for (int bj = 0; bj < 2; ++bj)
#pragma unroll
                    for (int n = 0; n < 2; ++n) gv[bj][n] = *(const f32x4*)(g + 32 * bj + 8 * fq + 4 * n) * gs;
#pragma unroll
                for (int ai = 0; ai < 2; ++ai)
#pragma unroll
                    for (int m = 0; m < 4; ++m) {
                        float ss = 0.f;
#pragma unroll
                        for (int bj = 0; bj < 2; ++bj)
#pragma unroll
                            for (int n = 0; n < 2; ++n) { const f32x4 v = acc[ai][bj][m][n]; ss += (v[0] * v[0] + v[1] * v[1]) + (v[2] * v[2] + v[3] * v[3]); }
                        ss += __shfl_xor(ss, 16); ss += __shfl_xor(ss, 32);
                        const float rstd = 1.0f / sqrtf(ss * (1.f / 64.f) + RMS_EPS);
                        bf16_t* rowp = isq ? (base + (size_t)(row0 + ai * 128 + m * 16) * ld + 64 * wc + 8 * fq) : (base + (size_t)ai * 2 * 4096 + (m * 16 + fr) * 64 + 8 * fq);
#pragma unroll
                        for (int bj = 0; bj < 2; ++bj) { const f32x4 v0 = acc[ai][bj][m][0] * rstd * gv[bj][0], v1 = acc[ai][bj][m][1] * rstd * gv[bj][1];
                            u32x4 w; w.x = pk2(v0[0], v0[1]); w.y = pk2(v0[2], v0[3]); w.z = pk2(v1[0], v1[1]); w.w = pk2(v1[2], v1[3]);
                            *(u32x4*)(rowp + 32 * bj) = w; }
                    }
            }
        } else {
            const int wt = u.pm - 64;
            if (wt < 24) {
                const int bb = u.pn >> 5, cbase = (u.pn & 31) * 4 + (wc >> 1), ksb = (wc & 1) * 2;
                bf16_t* lp = VGT + ((fq & 1) * 32 + fr) * 8 + (fq >> 1) * 512;
#pragma unroll
                for (int ai = 0; ai < 2; ++ai)
#pragma unroll
                    for (int m = 0; m < 4; ++m)
#pragma unroll
                        for (int bj = 0; bj < 2; ++bj) { const f32x4 v0 = acc[ai][bj][m][0], v1 = acc[ai][bj][m][1];
                            u32x4 w; w.x = pk2(v0[0], v0[1]); w.y = pk2(v0[2], v0[3]); w.z = pk2(v1[0], v1[1]); w.w = pk2(v1[2], v1[3]);
                            const int frag = (((bb * 4 + (wt - 20)) * 128 + cbase + 2 * bj) * 8 + wr * 2 + ai * 4 + (m >> 1)) * 4 + ksb;
                            *(u32x4*)(lp + (size_t)frag * 512 + (m & 1) * 128) = w; }
            } else {
                const int vb_ = u.pn >> 5, vgrow_ = (u.pn & 31) * 4 + (wc >> 1);
                bf16_t* lp = NVT + fr * 64 + (wc & 1) * 32 + 8 * fq;
#pragma unroll
                for (int ai = 0; ai < 2; ++ai)
#pragma unroll
                    for (int m = 0; m < 4; ++m)
#pragma unroll
                        for (int bj = 0; bj < 2; ++bj) { const f32x4 v0 = acc[ai][bj][m][0], v1 = acc[ai][bj][m][1];
                            u32x4 w; w.x = pk2(v0[0], v0[1]); w.y = pk2(v0[2], v0[3]); w.z = pk2(v1[0], v1[1]); w.w = pk2(v1[2], v1[3]);
                            const int slab = (vb_ * 16 + 4 * (wt - 24) + 2 * ai + wr) * 128 + vgrow_ + 2 * bj;
                            *(u32x4*)(lp + (size_t)slab * 4096 + m * 16 * 64) = w; }
            }
        }
    }
};

struct EpiOut {
    static constexpr bool PERM = false, AFTER_DRAIN = false;
    const float* x; float* out;
    DI void operator()(const f32x4 (&acc)[2][2][4][2], const pg8::Unit& u, int wr, int wc, int fr, int fq) const {
        const int row0 = u.pm * 256 + wr * 64 + fr, col0 = u.pn * 256 + wc * 32 + 4 * fq;
#pragma unroll
        for (int ai = 0; ai < 2; ++ai) {
            f32x4 xs[4][2][2];
#pragma unroll
            for (int m = 0; m < 4; ++m) { const size_t off = (size_t)(row0 + ai * 128 + m * 16) * DM + col0;
#pragma unroll
                for (int bj = 0; bj < 2; ++bj)
#pragma unroll
                    for (int n = 0; n < 2; ++n) xs[m][bj][n] = *(const f32x4*)(x + off + bj * 128 + n * 16); }
            asm volatile("" ::: "memory");
#pragma unroll
            for (int m = 0; m < 4; ++m) { const size_t off = (size_t)(row0 + ai * 128 + m * 16) * DM + col0;
#pragma unroll
                for (int bj = 0; bj < 2; ++bj)
#pragma unroll
                    for (int n = 0; n < 2; ++n) *(f32x4*)(out + off + bj * 128 + n * 16) = xs[m][bj][n] + acc[ai][bj][m][n]; }
        }
    }
};

constexpr int NA_SLOT = 16384, NA_NSLOT = 9, NA_KM = NA_NSLOT * NA_SLOT, NA_VM = NA_KM + 2048, NA_RPB = NA_VM + 2048, NA_MB = NA_RPB + 1920;
#define NA_BAR() do { asm volatile("s_waitcnt lgkmcnt(0)" ::: "memory"); __builtin_amdgcn_s_barrier(); asm volatile("" ::: "memory"); } while (0)
DI void na_stage_row(const bf16_t* kslab, const bf16_t* vslab, unsigned char* slot, int lw, int lane) {
#pragma unroll
    for (int i = 0; i < 2; ++i) { const int piece = 2 * lw + i, P = 64 * piece + lane, line = P >> 4, pos = P & 15;
        { const int b0 = ((pos >> 3) & 1) ^ (line & 1), uu = (pos & 7) ^ (4 * b0 + ((line >> 2) & 3)), key = 2 * line + b0;
          __builtin_amdgcn_global_load_lds((const unsigned*)(kslab + key * 64 + uu * 8), (PG8_LAS unsigned*)(slot + piece * 1024), 16, 0, 0); }
        { const int x = pos ^ (line & 7), d = 2 * line + (x >> 3), uk = x & 7;
          __builtin_amdgcn_global_load_lds((const unsigned*)(vslab + d * 64 + uk * 8), (PG8_LAS unsigned*)(slot + 8192 + piece * 1024), 16, 0, 0); } }
}
DI int na_rs(int r) { int rs = r - 4; return rs < 0 ? 0 : (rs > 120 ? 120 : rs); }
DI void na_phase(const Args& a, unsigned char* lds, int vcu, int G, int wave, int lane, bf16_t* ODST, int ostride) {
    unsigned char* ws = a.ws;
    const float* ZM = (const float*)(ws + WS_ZM);
    bf16_t* AO = (bf16_t*)(ws + WS_AO); const bf16_t* NKP = (const bf16_t*)(ws + WS_NK); const bf16_t* NVP = (const bf16_t*)(ws + WS_NVT);
    const bf16_t* NGt = (const bf16_t*)a.out + (size_t)NTOK * 1024;
    bf16_t* KM = (bf16_t*)(lds + NA_KM); bf16_t* VM = (bf16_t*)(lds + NA_VM); float* RPB = (float*)(lds + NA_RPB); float* MB = (float*)(lds + NA_MB);
    const int tid = wave * 64 + lane;
    for (int task = vcu; task < 256; task += G) {
        const int b = task >> 7, h = (task >> 3) & 15, r0 = (task & 7) * 16;
        const bf16_t* kbase = NKP + (size_t)((b * 16 + h) * 128) * 4096; const bf16_t* vbase = NVP + (size_t)((b * 16 + h) * 128) * 4096;
        const int lo = na_rs(r0);
        if (wave >= 4) {
            const int lw = wave - 4;
            for (int x = lo; x < lo + 8; ++x) na_stage_row(kbase + (size_t)x * 4096, vbase + (size_t)x * 4096, lds + (x % NA_NSLOT) * NA_SLOT, lw, lane);
        } else {
            const int d = lane, t4 = wave * 64 + lane;
            float kv[4], vv[4];
#pragma unroll
            for (int j = 0; j < 4; ++j) kv[j] = ZM[(size_t)(wave + 4 * j) * NIN + 256 * (12 + (h >> 2)) + 128 * (d >> 5) + 32 * (h & 3) + (d & 31)];
            const float kg = a.kn_g[d];
#pragma unroll
            for (int j = 0; j < 4; ++j) { const int e = t4 + 256 * j; vv[j] = ZM[(size_t)(e & 15) * NIN + 256 * (24 + (h >> 2)) + 64 * (h & 3) + (e >> 4)]; }
            const float rb0 = a.rpb[h * 465 + t4], rb1 = (t4 + 256 < 465) ? a.rpb[h * 465 + t4 + 256] : 0.f;
            const float mb = (t4 < 16) ? a.meta_bias[h * 16 + t4] : 0.f;
#pragma unroll
            for (int j = 0; j < 4; ++j) { const float rstd = 1.0f / sqrtf(wave_sum(kv[j] * kv[j]) * (1.f / 64.f) + RMS_EPS);
                KM[(wave + 4 * j) * 64 + d] = (bf16_t)(pk2(kv[j] * rstd * kg, 0.f) & 0xffffu); }
#pragma unroll
            for (int j = 0; j < 4; ++j) VM[t4 + 256 * j] = (bf16_t)(pk2(vv[j], 0.f) & 0xffffu);
            RPB[t4] = rb0 * LOG2E; if (t4 + 256 < 465) RPB[t4 + 256] = rb1 * LOG2E;
            if (t4 < 16) MB[t4] = mb * LOG2E;
        }
        if (wave >= 4) {
            const int lw = wave - 4;
            asm volatile("s_waitcnt vmcnt(0)" ::: "memory");
            NA_BAR();
            for (int r = r0; r < r0 + 16; ++r) {
                if (r + 1 < r0 + 16 && na_rs(r + 1) > na_rs(r)) { const int x = na_rs(r + 1) + 7;
                    na_stage_row(kbase + (size_t)x * 4096, vbase + (size_t)x * 4096, lds + (x % NA_NSLOT) * NA_SLOT, lw, lane); }
                asm volatile("s_waitcnt vmcnt(0)" ::: "memory");
                NA_BAR();
            }
            continue;
        }
        const int n = lane & 15, q4 = lane >> 4, qt = wave;
        const int c0 = (qt == 0) ? 0 : (qt == 1) ? 8 : (qt == 2) ? 24 : 32;
        const int qc = 16 * qt + n;
        int cs = qc - 8; cs = cs < 0 ? 0 : (cs > 48 ? 48 : cs);
        bf16x8 qf[2], qn[2];
        { const size_t qtok = (size_t)b * SEQ + r0 * 64 + qc;
#pragma unroll
          for (int ks = 0; ks < 2; ++ks) qf[ks] = *(const bf16x8*)(AO + qtok * 2048 + 1024 + h * 64 + 32 * ks + 8 * q4); }
        int koff[2][2];
#pragma unroll
        for (int t = 0; t < 2; ++t) { const int key = c0 + 8 * (n >> 2) + 4 * t + (n & 3); const int f = ((key & 3) << 2) | ((key >> 3) & 3);
#pragma unroll
            for (int ks = 0; ks < 2; ++ks) koff[t][ks] = ((key >> 1) * 16 + ((((key & 1) * 8) + 4 * ks + q4) ^ f)) * 16; }
        int voff[4];
#pragma unroll
        for (int dt = 0; dt < 4; ++dt) { const int d = 16 * dt + n, uk = (c0 >> 3) + q4; voff[dt] = 8192 + ((d >> 1) * 16 + ((((d & 1) * 8) + uk) ^ ((d >> 1) & 7))) * 16; }
        float madd[2][4]; int boff[2][4];
#pragma unroll
        for (int t = 0; t < 2; ++t)
#pragma unroll
            for (int i = 0; i < 4; ++i) { const int kc = c0 + 8 * q4 + 4 * t + i; const bool valid = (kc >= cs) && (kc < cs + 16);
                int dcol = kc - qc + 15; dcol = dcol < 0 ? 0 : (dcol > 30 ? 30 : dcol); madd[t][i] = valid ? 0.f : -1e30f; boff[t][i] = dcol * 4; }
        NA_BAR();
        for (int r = r0; r < r0 + 16; ++r) {
            const int rs = na_rs(r);
            const size_t qtok = (size_t)b * SEQ + r * 64 + qc;
            if (r + 1 < r0 + 16) {
#pragma unroll
                for (int ks = 0; ks < 2; ++ks) qn[ks] = *(const bf16x8*)(AO + (qtok + 64) * 2048 + 1024 + h * 64 + 32 * ks + 8 * q4);
            }
            u32x2 gw[4];
#pragma unroll
            for (int dt = 0; dt < 4; ++dt) gw[dt] = *(const u32x2*)(NGt + qtok * 1024 + h * 64 + 16 * dt + 4 * q4);
            f32x4 sc[17];
#pragma unroll
            for (int kr = 0; kr < 8; ++kr) {
                const unsigned char* slot = lds + ((rs + kr) % NA_NSLOT) * NA_SLOT;
#pragma unroll
                for (int t = 0; t < 2; ++t) {
                    const bf16x8 k0 = *(const bf16x8*)(slot + koff[t][0]);
                    const bf16x8 k1 = *(const bf16x8*)(slot + koff[t][1]);
                    f32x4 z = {0.f, 0.f, 0.f, 0.f};
                    z = MFMA16(k0, qf[0], z); z = MFMA16(k1, qf[1], z);
                    sc[2 * kr + t] = z;
                }
            }
            {
                const bf16x8 k0 = *(const bf16x8*)(KM + n * 64 + 8 * q4);
                const bf16x8 k1 = *(const bf16x8*)(KM + n * 64 + 32 + 8 * q4);
                f32x4 z = {0.f, 0.f, 0.f, 0.f};
                z = MFMA16(k0, qf[0], z); z = MFMA16(k1, qf[1], z);
                sc[16] = z;
            }
            float mx = -1e30f;
            const unsigned char* rpb0 = (const unsigned char*)RPB + (rs - r + 7) * 124;
#pragma unroll
            for (int kr = 0; kr < 8; ++kr) {
#pragma unroll
                for (int t = 0; t < 2; ++t)
#pragma unroll
                    for (int i = 0; i < 4; ++i) {
                        const float bias = *(const float*)(rpb0 + kr * 124 + boff[t][i]);
                        const float sv = sc[2 * kr + t][i] + (bias + madd[t][i]);
                        sc[2 * kr + t][i] = sv; mx = fmaxf(mx, sv);
                    }
            }
#pragma unroll
            for (int i = 0; i < 4; ++i) { const float sv = sc[16][i] + MB[4 * q4 + i]; sc[16][i] = sv; mx = fmaxf(mx, sv); }
            mx = fmaxf(mx, __shfl_xor(mx, 16)); mx = fmaxf(mx, __shfl_xor(mx, 32));
            float sum = 0.f;
#pragma unroll
            for (int j = 0; j < 17; ++j)
#pragma unroll
                for (int i = 0; i < 4; ++i) { const float pp = __builtin_amdgcn_exp2f(sc[j][i] - mx); sc[j][i] = pp; sum += pp; }
            sum += __shfl_xor(sum, 16); sum += __shfl_xor(sum, 32);
            const float inv = 1.0f / sum;
            f32x4 o[4];
#pragma unroll
            for (int dt = 0; dt < 4; ++dt) o[dt] = (f32x4){0.f, 0.f, 0.f, 0.f};
#pragma unroll
            for (int kr = 0; kr < 8; ++kr) {
                const unsigned char* slot = lds + ((rs + kr) % NA_NSLOT) * NA_SLOT;
                u32x4 pw; pw.x = pk2(sc[2 * kr][0], sc[2 * kr][1]); pw.y = pk2(sc[2 * kr][2], sc[2 * kr][3]); pw.z = pk2(sc[2 * kr + 1][0], sc[2 * kr + 1][1]); pw.w = pk2(sc[2 * kr + 1][2], sc[2 * kr + 1][3]);
                const bf16x8 pf = __builtin_bit_cast(bf16x8, pw);
#pragma unroll
                for (int dt = 0; dt < 4; ++dt) { const bf16x8 vf = *(const bf16x8*)(slot + voff[dt]); o[dt] = MFMA16(vf, pf, o[dt]); }
            }
            {
                u32x4 pw; pw.x = pk2(sc[16][0], sc[16][1]); pw.y = pk2(sc[16][2], sc[16][3]); pw.z = 0u; pw.w = 0u;
                const bf16x8 pf = __builtin_bit_cast(bf16x8, pw);
#pragma unroll
                for (int dt = 0; dt < 4; ++dt) {
                    const u32x2 lo2 = *(const u32x2*)(VM + ((16 * dt + n) * 16 + 4 * q4));
                    u32x4 vw; vw.x = lo2.x; vw.y = lo2.y; vw.z = 0u; vw.w = 0u;
                    o[dt] = MFMA16(__builtin_bit_cast(bf16x8, vw), pf, o[dt]);
                }
            }
#pragma unroll
            for (int dt = 0; dt < 4; ++dt) {
                const int d0 = h * 64 + 16 * dt + 4 * q4;
                const float g0 = __uint_as_float(gw[dt].x << 16), g1 = __uint_as_float(gw[dt].x & 0xffff0000u), g2 = __uint_as_float(gw[dt].y << 16), g3 = __uint_as_float(gw[dt].y & 0xffff0000u);
                u32x2 w; w.x = pk2(o[dt][0] * inv * g0, o[dt][1] * inv * g1); w.y = pk2(o[dt][2] * inv * g2, o[dt][3] * inv * g3);
                *(u32x2*)(ODST + qtok * ostride + d0) = w;
            }
            qf[0] = qn[0]; qf[1] = qn[1];
            NA_BAR();
        }
    }
}

constexpr int PREP_LD = 136;
constexpr int PREP_TILE = 64 * PREP_LD * 2;
constexpr int PREP_R = 4 * PREP_TILE, PREP_PART = PREP_R + 8192;
DI float logsig16(float x) { return (fminf(x, 0.f) - __logf(1.f + __expf(-fabsf(x)))) * (1.f / 16.f); }
DI int phys_gk(int c) { return phys_norm(2 + (c >> 8), c & 255); }
DI void prep_phase(const Args& a, unsigned char* lds, int vcu, int G, int wave, int lane) {
    unsigned char* ws = a.ws;
    const float* ZM = (const float*)(ws + WS_ZM); const float* R = (const float*)(ws + WS_R);
    const bf16_t* QG = (const bf16_t*)(ws + WS_QG); const bf16_t* KG = (const bf16_t*)(ws + WS_KG);
    unsigned char* PKF = ws + WS_PKF; unsigned char* PKB = ws + WS_PKB; bf16_t* VMT = (bf16_t*)(ws + WS_VMT);
    const int tid = wave * 64 + lane;
    bf16_t* T_QF = (bf16_t*)(lds); bf16_t* T_KF = (bf16_t*)(lds + PREP_TILE); bf16_t* T_QB = (bf16_t*)(lds + 2 * PREP_TILE); bf16_t* T_KB = (bf16_t*)(lds + 3 * PREP_TILE);
    float* RS = (float*)(lds + PREP_R); float* PART = (float*)(lds + PREP_PART);
    for (int task = vcu; task < 1024 + 8; task += G) {
        if (task >= 1024) {
            const int mt = task - 1024, b = mt >> 2, h = mt & 3;
            unsigned char* pk = PKF + (size_t)((b * 4 + h) * 129) * PK_BYTES;
            for (int p = tid; p < PK_BYTES / 16; p += 512) *(u32x4*)(pk + p * 16) = (u32x4){0u, 0u, 0u, 0u};
            __syncthreads();
            if (tid < 128) { const int d = tid;
                float wd[16];
#pragma unroll
                for (int k = 0; k < 16; ++k) wd[k] = a.wd_f[k * 512 + h * 128 + d];
                const float bd = a.bd_f[h * 128 + d];
                float G_[16]; float run = 0.f;
#pragma unroll
                for (int m = 0; m < 16; ++m) { float dot = bd;
#pragma unroll
                    for (int k = 0; k < 16; ++k) dot += ZM[(size_t)m * NIN + 7168 + k] * wd[k];
                    run += logsig16(dot); G_[m] = run; }
                unsigned kw[8];
#pragma unroll
                for (int m = 0; m < 16; m += 2) { const float k0 = ZM[(size_t)m * NIN + phys_gk(h * 128 + d)] * __expf(run - G_[m]);
                    const float k1 = ZM[(size_t)(m + 1) * NIN + phys_gk(h * 128 + d)] * __expf(run - G_[m + 1]); kw[m >> 1] = pk2(k0, k1); }
                const int dt = d >> 5, r = d & 31;
                *(u32x4*)(pk + (dt * 4 + 3) * 1024 + (0 * 32 + r) * 16) = (u32x4){kw[0], kw[1], kw[2], kw[3]};
                *(u32x4*)(pk + (dt * 4 + 3) * 1024 + (1 * 32 + r) * 16) = (u32x4){kw[4], kw[5], kw[6], kw[7]};
                *(float*)(pk + PK_A_OFF + d * 4) = 1.0f;
            }
            if (b == 0 && tid < 256) { const int v = tid; const int c = h * 256 + v; bf16_t* row = VMT + (size_t)c * 64;
                for (int j = 0; j < 48; j += 8) *(u32x4*)(row + j) = (u32x4){0u, 0u, 0u, 0u};
                unsigned vw[8];
#pragma unroll
                for (int m = 0; m < 16; m += 2) vw[m >> 1] = pk2(ZM[(size_t)m * NIN + 256 * (20 + (c >> 8)) + (c & 255)], ZM[(size_t)(m + 1) * NIN + 256 * (20 + (c >> 8)) + (c & 255)]);
                *(u32x4*)(row + 48) = (u32x4){vw[0], vw[1], vw[2], vw[3]}; *(u32x4*)(row + 56) = (u32x4){vw[4], vw[5], vw[6], vw[7]}; }
            __syncthreads();
            continue;
        }
        const int b = task >> 9, h = (task >> 7) & 3, c = task & 127;
        const size_t tok0 = (size_t)b * SEQ + c * 64;
        unsigned char* pkf = PKF + (size_t)((b * 4 + h) * 129 + 1 + c) * PK_BYTES;
        unsigned char* pkb = PKB + (size_t)((b * 4 + h) * 128 + c) * PK_BYTES;
        { const f32x4* src = (const f32x4*)(R + tok0 * 32); ((f32x4*)RS)[tid] = src[tid]; }
        const int d = tid & 127, tq = tid >> 7;
        bf16_t qv[16], kv[16];
#pragma unroll
        for (int jj = 0; jj < 16; ++jj) { qv[jj] = QG[(tok0 + 16 * tq + jj) * 512 + h * 128 + d]; kv[jj] = KG[(tok0 + 16 * tq + jj) * 512 + h * 128 + d]; }
        float wf[16], wb[16];
#pragma unroll
        for (int k = 0; k < 16; ++k) { wf[k] = a.wd_f[k * 512 + h * 128 + d]; wb[k] = a.wd_b[k * 512 + h * 128 + d]; }
        const float bf_ = a.bd_f[h * 128 + d], bb_ = a.bd_b[h * 128 + d];
        __syncthreads();
        float pf[16], pb[16];
        { float rf = 0.f, rb = 0.f;
#pragma unroll
          for (int jj = 0; jj < 16; ++jj) { const float* rr = RS + (16 * tq + jj) * 32; float df = bf_, db = bb_;
#pragma unroll
              for (int k4 = 0; k4 < 4; ++k4) { const f32x4 x0 = *(const f32x4*)(rr + 4 * k4), x1 = *(const f32x4*)(rr + 16 + 4 * k4);
                  df += x0[0] * wf[4 * k4] + x0[1] * wf[4 * k4 + 1] + x0[2] * wf[4 * k4 + 2] + x0[3] * wf[4 * k4 + 3];
                  db += x1[0] * wb[4 * k4] + x1[1] * wb[4 * k4 + 1] + x1[2] * wb[4 * k4 + 2] + x1[3] * wb[4 * k4 + 3]; }
              rf += logsig16(df); rb += logsig16(db); pf[jj] = rf; pb[jj] = rb; }
          PART[(0 * 4 + tq) * 128 + d] = rf; PART[(1 * 4 + tq) * 128 + d] = rb; }
        __syncthreads();
        float offf = 0.f, totf = 0.f, offb = 0.f, totb = 0.f;
#pragma unroll
        for (int q = 0; q < 4; ++q) { const float tf = PART[(0 * 4 + q) * 128 + d], tb = PART[(1 * 4 + q) * 128 + d]; totf += tf; totb += tb; if (q < tq) offf += tf; if (q > tq) offb += tb; }
        const float mytb = pb[15];
        unsigned ksf[8], ksb[8];
#pragma unroll
        for (int jj = 0; jj < 16; jj += 2) {
            float kstf[2], kstb[2];
#pragma unroll
            for (int e = 0; e < 2; ++e) { const int j = 16 * tq + jj + e;
                const float q = bf2f(qv[jj + e]), k = bf2f(kv[jj + e]);
                const float Gf = offf + pf[jj + e];
                const float Gb = offb + (mytb - ((jj + e) ? pb[jj + e - 1] : 0.f));
                const float ef = __expf(Gf), eb = __expf(Gb);
                T_QF[j * PREP_LD + d] = (bf16_t)(pk2(q * ef, 0.f) & 0xffffu);
                T_KF[j * PREP_LD + d] = (bf16_t)(pk2(k * __expf(-Gf), 0.f) & 0xffffu);
                T_QB[j * PREP_LD + d] = (bf16_t)(pk2(q * eb, 0.f) & 0xffffu);
                T_KB[j * PREP_LD + d] = (bf16_t)(pk2(k * __expf(-Gb), 0.f) & 0xffffu);
                kstf[e] = k * __expf(totf - Gf); kstb[e] = k * __expf(totb - Gb); }
            ksf[jj >> 1] = pk2(kstf[0], kstf[1]); ksb[jj >> 1] = pk2(kstb[0], kstb[1]);
        }
        { const int dt = d >> 5, r = d & 31;
          *(u32x4*)(pkf + (dt * 4 + tq) * 1024 + (0 * 32 + r) * 16) = (u32x4){ksf[0], ksf[1], ksf[2], ksf[3]};
          *(u32x4*)(pkf + (dt * 4 + tq) * 1024 + (1 * 32 + r) * 16) = (u32x4){ksf[4], ksf[5], ksf[6], ksf[7]};
          *(u32x4*)(pkb + (dt * 4 + tq) * 1024 + (0 * 32 + r) * 16) = (u32x4){ksb[0], ksb[1], ksb[2], ksb[3]};
          *(u32x4*)(pkb + (dt * 4 + tq) * 1024 + (1 * 32 + r) * 16) = (u32x4){ksb[4], ksb[5], ksb[6], ksb[7]};
          if (tq == 0) { *(float*)(pkf + PK_A_OFF + d * 4) = __expf(totf); *(float*)(pkb + PK_A_OFF + d * 4) = __expf(totb); } }
        __syncthreads();
        {
            const int dir = wave >> 2, jt = (wave >> 1) & 1, it = wave & 1;
            const bf16_t* TQ = dir ? T_QB : T_QF; const bf16_t* TK = dir ? T_KB : T_KF; unsigned char* pk = dir ? pkb : pkf;
            const int rho = lane & 31, hh = lane >> 5;
            const int pj = (rho & ~12) | ((rho & 4) << 1) | ((rho & 8) >> 1);
            const int jrow = 32 * jt + pj, icol = 32 * it + rho;
            f32x16 acc;
#pragma unroll
            for (int i = 0; i < 16; ++i) acc[i] = 0.f;
#pragma unroll
            for (int kd = 0; kd < 8; ++kd) { const bf16x8 af = *(const bf16x8*)(TK + jrow * PREP_LD + 16 * kd + 8 * hh); const bf16x8 bfr = *(const bf16x8*)(TQ + icol * PREP_LD + 16 * kd + 8 * hh);
                acc = MFMA32(af, bfr, acc); }
#pragma unroll
            for (int s = 0; s < 2; ++s) {
                unsigned w[4];
#pragma unroll
                for (int e = 0; e < 8; e += 2) {
                    float v[2];
#pragma unroll
                    for (int x = 0; x < 2; ++x) { const int j = 32 * jt + 16 * s + 8 * hh + e + x; const bool keep = dir ? (j >= icol) : (j <= icol); v[x] = keep ? acc[8 * s + e + x] : 0.f; }
                    w[e >> 1] = pk2(v[0], v[1]);
                }
                *(u32x4*)(pk + (32 + it * 4 + 2 * jt + s) * 1024 + lane * 16) = (u32x4){w[0], w[1], w[2], w[3]};
            }
#pragma unroll
            for (int ff = 0; ff < 4; ++ff) { const int f = (wave & 3) * 4 + ff, it2 = f >> 3, kd = f & 7;
                const bf16_t* rowp = TQ + (32 * it2 + rho) * PREP_LD + 16 * kd + 4 * hh;
                const u32x2 lo = *(const u32x2*)(rowp), hi = *(const u32x2*)(rowp + 8);
                *(u32x4*)(pk + (16 + f) * 1024 + lane * 16) = (u32x4){lo.x, lo.y, hi.x, hi.y}; }
        }
        __syncthreads();
    }
}

constexpr int SCAN_BUF = 46080;
constexpr int SCAN_VT = 41984;
constexpr int SCAN_OST = 3 * SCAN_BUF;
DI bf16x8 pack8(const f32x16& x, int s) {
    u32x4 p; p.x = pk2(x[8 * s], x[8 * s + 1]); p.y = pk2(x[8 * s + 2], x[8 * s + 3]); p.z = pk2(x[8 * s + 4], x[8 * s + 5]); p.w = pk2(x[8 * s + 6], x[8 * s + 7]);
    return __builtin_bit_cast(bf16x8, p);
}
#define SCAN_BAR() do { asm volatile("s_waitcnt lgkmcnt(0)" ::: "memory"); __builtin_amdgcn_s_barrier(); asm volatile("" ::: "memory"); } while (0)
#define SCAN_LDF(f) (*(const bf16x8*)(buf + (f) * 1024 + lane * 16))
constexpr int SCAN_SLOT = 33 * 1024, SCAN_NSLOT = 4;
constexpr int SCAN_UB = SCAN_NSLOT * SCAN_SLOT;
constexpr int SCAN_XO = SCAN_UB + 16384;
DI void scan_stage(const unsigned char* src, const bf16_t* vsrc, int vstride, unsigned char* dst, int lw, int ih, int lane) {
#pragma unroll
    for (int k = 0; k < 7; ++k) { const int i = 5 * k + lw; if (i >= 33) continue;
        if (i < 29) { const int q = (i < 16) ? i : (i < 24) ? (16 + 8 * ih + (i - 16)) : (i < 28) ? (32 + 4 * ih + (i - 24)) : 40;
            __builtin_amdgcn_global_load_lds((const unsigned*)(src + (size_t)q * 1024 + lane * 16), (PG8_LAS unsigned*)(dst + i * 1024), 16, 0, 0); }
        else __builtin_amdgcn_global_load_lds((const unsigned*)(vsrc + (size_t)(i - 29) * vstride), (PG8_LAS unsigned*)(dst + i * 1024), 16, 0, 0); }
}
DI void scan_phase(const Args& a, unsigned char* lds, int wave, int lane) {
    const int sb = blockIdx.x; if (sb >= 256) return;
    unsigned char* ws = a.ws;
    const int stream = sb & 15, eighth = (sb >> 4) & 7, ih = sb >> 7;
    const int b = stream >> 3, dir = (stream >> 2) & 1, h = stream & 3;
    const int nsteps = dir ? 128 : 129;
    const unsigned char* pkbase = dir ? (ws + WS_PKB + (size_t)((b * 4 + h) * 128) * PK_BYTES) : (ws + WS_PKF + (size_t)((b * 4 + h) * 129) * PK_BYTES);
    const bf16_t* VP = (const bf16_t*)(ws + WS_VGT); const bf16_t* VMT = (const bf16_t*)(ws + WS_VMT);
    const int vcol0 = h * 256 + eighth * 32;
#define SCAN_PKIDX(s_) (dir ? (127 - (s_)) : (s_))
#define SCAN_STAGE(s_) do { const int ss_ = (s_); \
        if (dir == 0 && ss_ == 0) scan_stage(pkbase, VMT + (size_t)(vcol0 + (lane & 31)) * 64 + 8 * (lane >> 5), 16, lds + (size_t)(ss_ & 3) * SCAN_SLOT, lw, ih, lane); \
        else { const int cc_ = dir ? (127 - ss_) : (ss_ - 1); \
            scan_stage(pkbase + (size_t)SCAN_PKIDX(ss_) * PK_BYTES, VP + ((size_t)((b * 4 + h) * 128 + cc_) * 8 + eighth) * 2048 + lane * 8, 512, lds + (size_t)(ss_ & 3) * SCAN_SLOT, lw, ih, lane); } } while (0)
#define SCAN_LWAIT2() do { if (lw < 3) asm volatile("s_waitcnt vmcnt(14)" ::: "memory"); else asm volatile("s_waitcnt vmcnt(12)" ::: "memory"); } while (0)
#define SCAN_LWAIT() do { if (lw < 3) asm volatile("s_waitcnt vmcnt(7)" ::: "memory"); else asm volatile("s_waitcnt vmcnt(6)" ::: "memory"); } while (0)
    if (wave >= 3) {
        const int lw = wave - 3;
        SCAN_STAGE(0); SCAN_STAGE(1); SCAN_STAGE(2);
        SCAN_LWAIT2();
        SCAN_BAR();
        for (int n = 0; n < nsteps; ++n) {
            if (n + 3 < nsteps) { SCAN_STAGE(n + 3); SCAN_LWAIT2(); }
            else if (n + 2 < nsteps) SCAN_LWAIT();
            else asm volatile("s_waitcnt vmcnt(0)" ::: "memory");
            SCAN_BAR();
        }
        return;
    }
    unsigned char* SF = lds + SCAN_UB; unsigned char* XO = lds + SCAN_XO;
    const int r = lane & 31, hh = lane >> 5;
    if (wave < 2) {
        f32x16 S[2];
#pragma unroll
        for (int dt = 0; dt < 2; ++dt)
#pragma unroll
            for (int i = 0; i < 16; ++i) S[dt][i] = 0.f;
#pragma unroll
        for (int f = 0; f < 8; ++f) *(u32x4*)(SF + (wave * 8 + f) * 1024 + lane * 16) = (u32x4){0u, 0u, 0u, 0u};
        SCAN_BAR();
        for (int n = 0; n < nsteps; ++n) {
            const unsigned char* buf = lds + (size_t)(n & 3) * SCAN_SLOT;
            bf16x8 vt[4], kf[8];
            f32x4 av[8];
#pragma unroll
            for (int i = 0; i < 8; ++i) av[i] = *(const f32x4*)(buf + 28 * 1024 + (64 * wave + 32 * (i >> 2) + 8 * (i & 3) + 4 * hh) * 4);
#pragma unroll
            for (int ks = 0; ks < 4; ++ks) vt[ks] = *(const bf16x8*)(buf + (29 + ks) * 1024 + lane * 16);
#pragma unroll
            for (int ks = 0; ks < 4; ++ks)
#pragma unroll
                for (int dt = 0; dt < 2; ++dt) kf[dt * 4 + ks] = SCAN_LDF((2 * wave + dt) * 4 + ks);
#pragma unroll
            for (int dt = 0; dt < 2; ++dt)
#pragma unroll
                for (int g4 = 0; g4 < 4; ++g4) { const f32x4 v = av[4 * dt + g4]; S[dt][4 * g4] *= v[0]; S[dt][4 * g4 + 1] *= v[1]; S[dt][4 * g4 + 2] *= v[2]; S[dt][4 * g4 + 3] *= v[3]; }
#pragma unroll
            for (int ks = 0; ks < 4; ++ks)
#pragma unroll
                for (int dt = 0; dt < 2; ++dt) S[dt] = MFMA32(kf[dt * 4 + ks], vt[ks], S[dt]);
            unsigned char* sfo = SF + (n & 1) * 8192;
#pragma unroll
            for (int dt = 0; dt < 2; ++dt) { const bf16x8 s0 = pack8(S[dt], 0), s1 = pack8(S[dt], 1);
                *(bf16x8*)(sfo + (4 * wave + 2 * dt) * 1024 + lane * 16) = s0; *(bf16x8*)(sfo + (4 * wave + 2 * dt + 1) * 1024 + lane * 16) = s1; }
            SCAN_BAR();
        }
        return;
    }
    bf16_t* OUT = dir ? (bf16_t*)(ws + WS_OB) : (bf16_t*)(ws + WS_AO); const int ldo = dir ? 1024 : 2048;
    SCAN_BAR();
    for (int n = 0; n < nsteps; ++n) {
        const unsigned char* buf = lds + (size_t)(n & 3) * SCAN_SLOT;
        if (dir == 0 && n == 0) { SCAN_BAR(); continue; }
        bf16x8 vt[4], qf[8], af[4], sf[8];
#pragma unroll
        for (int kd = 0; kd < 8; ++kd) { qf[kd] = SCAN_LDF(16 + kd); sf[kd] = *(const bf16x8*)(SF + ((n + 1) & 1) * 8192 + kd * 1024 + lane * 16); }
#pragma unroll
        for (int ks = 0; ks < 4; ++ks) { vt[ks] = *(const bf16x8*)(buf + (29 + ks) * 1024 + lane * 16); af[ks] = SCAN_LDF(24 + ks); }
        f32x16 oa, ob;
#pragma unroll
        for (int i = 0; i < 16; ++i) { oa[i] = 0.f; ob[i] = 0.f; }
#pragma unroll
        for (int kd = 0; kd < 4; ++kd) { oa = MFMA32(sf[kd], qf[kd], oa); ob = MFMA32(sf[4 + kd], qf[4 + kd], ob); }
        oa = MFMA32(vt[0], af[0], oa); ob = MFMA32(vt[2], af[2], ob);
        oa = MFMA32(vt[1], af[1], oa); ob = MFMA32(vt[3], af[3], ob);
        { const int c = dir ? (127 - n) : (n - 1);
          bf16_t* op = OUT + ((size_t)b * SEQ + c * 64 + 32 * ih + r) * ldo + vcol0 + 4 * hh;
#pragma unroll
          for (int g4 = 0; g4 < 4; ++g4) { u32x2 w; w.x = pk2(oa[4 * g4] + ob[4 * g4], oa[4 * g4 + 1] + ob[4 * g4 + 1]); w.y = pk2(oa[4 * g4 + 2] + ob[4 * g4 + 2], oa[4 * g4 + 3] + ob[4 * g4 + 3]);
              *(u32x2*)(op + 8 * g4) = w; } }
        SCAN_BAR();
    }
}

DI void combine_phase(const Args& a, int vcu, int G, int wave, int lane, bf16_t* CDST, int cstride) {
    unsigned char* ws = a.ws;
    bf16_t* AO = (bf16_t*)(ws + WS_AO); const bf16_t* OB = (const bf16_t*)(ws + WS_OB); const bf16_t* GG = (const bf16_t*)a.out;
    const int gw = vcu * NWAVES + wave, NGW = G * NWAVES;
    const f32x4 gn = *(const f32x4*)(a.gla_g + 4 * lane);
    for (int tok = gw; tok < NTOK; tok += NGW) {
        u32x2 f[4], bq[4], gg[4];
#pragma unroll
        for (int h = 0; h < 4; ++h) { f[h] = *(const u32x2*)(AO + (size_t)tok * 2048 + h * 256 + 4 * lane);
            bq[h] = *(const u32x2*)(OB + (size_t)tok * 1024 + h * 256 + 4 * lane); gg[h] = *(const u32x2*)(GG + (size_t)tok * 1024 + h * 256 + 4 * lane); }
#pragma unroll
        for (int h = 0; h < 4; ++h) {
            float o[4];
            o[0] = __uint_as_float(f[h].x << 16) + __uint_as_float(bq[h].x << 16); o[1] = __uint_as_float(f[h].x & 0xffff0000u) + __uint_as_float(bq[h].x & 0xffff0000u);
            o[2] = __uint_as_float(f[h].y << 16) + __uint_as_float(bq[h].y << 16); o[3] = __uint_as_float(f[h].y & 0xffff0000u) + __uint_as_float(bq[h].y & 0xffff0000u);
            const float ss = wave_sum((o[0] * o[0] + o[1] * o[1]) + (o[2] * o[2] + o[3] * o[3]));
            const float rstd = 1.0f / sqrtf(ss * (1.f / 256.f) + RMS_EPS);
            const float g0 = __uint_as_float(gg[h].x << 16), g1 = __uint_as_float(gg[h].x & 0xffff0000u), g2 = __uint_as_float(gg[h].y << 16), g3 = __uint_as_float(gg[h].y & 0xffff0000u);
            u32x2 w; w.x = pk2(o[0] * rstd * gn[0] * g0, o[1] * rstd * gn[1] * g1); w.y = pk2(o[2] * rstd * gn[2] * g2, o[3] * rstd * gn[3] * g3);
            *(u32x2*)(CDST + (size_t)tok * cstride + h * 256 + 4 * lane) = w;
        }
    }
}

#define LAS __attribute__((address_space(3)))
#define XB_TMO      128
#define XB_XCNT(j)  (256  + 64 * (j))
#define XB_XSUB(j)  (1280 + 64 * (j))
#define XB_XGEN(j)  (2304 + 64 * (j))
#define XB_TOP      3328
#define XB_TOPGEN   3392
#define XCD_BAR_WORDS 3456
#define XB_SPIN_CAP (1u << 18)

__device__ __forceinline__ unsigned xb_ld(unsigned* p)              { return __hip_atomic_load(p, __ATOMIC_RELAXED, __HIP_MEMORY_SCOPE_AGENT); }
__device__ __forceinline__ unsigned xb_add(unsigned* p, unsigned v) { return __hip_atomic_fetch_add(p, v, __ATOMIC_RELAXED, __HIP_MEMORY_SCOPE_AGENT); }
__device__ __forceinline__ unsigned xb_xcc_id() { return (unsigned)__builtin_amdgcn_s_getreg((3 << 11) | 20) & 0xFu; }
#define XB_SPIN(cond, bar) do { unsigned _sp = 0; while (cond) { __builtin_amdgcn_s_sleep(1); \
    if ((++_sp & 255u) == 0u) { if (xb_ld(&(bar)[XB_TMO])) break; if (_sp > XB_SPIN_CAP) { atomicAdd(&(bar)[XB_TMO], 1u); break; } } } } while (0)

struct XcdBarrier {
    unsigned* bar; unsigned x;
    volatile LAS unsigned* st;
};

__device__ __forceinline__ XcdBarrier xcd_barrier_post(unsigned* bar, volatile LAS unsigned* st) {
    XcdBarrier b; b.bar = bar; b.x = xb_xcc_id(); b.st = st;
    if (threadIdx.x == 0) (void)xb_add(&bar[XB_XCNT(b.x)], 1u);
    return b;
}
__device__ __forceinline__ void xcd_barrier_complete(unsigned* bar, unsigned x, unsigned& nloc, unsigned& nx) {
    const unsigned G = gridDim.x * gridDim.y * gridDim.z;
    unsigned sum, cnt, mine, sp = 0u;
    for (;;) {
        sum = 0u; cnt = 0u; mine = 0u;
#pragma unroll
        for (unsigned j = 0; j < 16; ++j) { const unsigned c = xb_ld(&bar[XB_XCNT(j)]); sum += c; cnt += (c > 0u) ? 1u : 0u; mine = (j == x) ? c : mine; }
        if (sum == G) break;
        __builtin_amdgcn_s_sleep(1);
        if ((++sp & 255u) == 0u) { if (xb_ld(&bar[XB_TMO])) break; if (sp > XB_SPIN_CAP) { atomicAdd(&bar[XB_TMO], 1u); break; } }
    }
    nloc = mine > 0u ? mine : 1u; nx = cnt > 0u ? cnt : 1u;
}

__device__ __forceinline__ void xcd_barrier(const XcdBarrier& b) {
    asm volatile("s_waitcnt vmcnt(0)" ::: "memory");
    __syncthreads();
    if (threadIdx.x == 0) {
        unsigned* bar = b.bar;
        __builtin_amdgcn_s_waitcnt(0);
        unsigned nloc = b.st[0], nx = b.st[1];
        if (nloc == 0u) { xcd_barrier_complete(bar, b.x, nloc, nx); b.st[0] = nloc; b.st[1] = nx; }
        const unsigned old = xb_add(&bar[XB_XSUB(b.x)], 1u);
        const unsigned gen = old / nloc;
        if (old + 1u == (gen + 1u) * nloc) {
            __builtin_amdgcn_fence(__ATOMIC_RELEASE, "agent");
            asm volatile("s_waitcnt vmcnt(0)" ::: "memory");
            const unsigned og = xb_add(&bar[XB_TOP], 1u);
            const unsigned tg = og / nx;
            if (og + 1u == (tg + 1u) * nx) xb_add(&bar[XB_TOPGEN], 1u);
            else XB_SPIN(xb_ld(&bar[XB_TOPGEN]) == tg, bar);
            __builtin_amdgcn_fence(__ATOMIC_ACQUIRE, "agent");
            xb_add(&bar[XB_XGEN(b.x)], 1u);
            asm volatile("s_waitcnt vmcnt(0)" ::: "memory");
        } else {
            XB_SPIN(xb_ld(&bar[XB_XGEN(b.x)]) == gen, bar);
            __builtin_amdgcn_fence(__ATOMIC_ACQUIRE, "agent");
            asm volatile("s_waitcnt vmcnt(0)" ::: "memory");
        }
    }
    __syncthreads();
}

__global__ void __launch_bounds__(NWAVES * 64, 2) hybrid_fwd(Args args, int ph_lo, int ph_hi) {
    extern __shared__ __attribute__((aligned(16))) unsigned char lds[];
    cg::grid_group grid = cg::this_grid();
    const int tid = threadIdx.x, lane = tid & 63, wave = __builtin_amdgcn_readfirstlane(tid >> 6);
    const int G = gridDim.x, bx = blockIdx.x;
    const int vcu = (G % 8 == 0) ? (bx % 8) * (G / 8) + bx / 8 : bx;
    unsigned char* ws = args.ws;
#ifndef REP_PHASE
#define REP_PHASE -1
#endif
#ifndef PHMASK
#define PHMASK 0x7f
#endif
#define IN(k) (ph_lo <= (k) && (k) < ph_hi && ((PHMASK >> (k)) & 1))
    volatile LAS unsigned* bst = (volatile LAS unsigned*)(lds + LDS_BYTES - 64);
    if (tid < 2) bst[tid] = 0u;
    __syncthreads();
    XcdBarrier bar = xcd_barrier_post((unsigned*)(ws + WS_CTL), bst);
    if (ph_lo < 0) grid.sync();
#define SEAM(k) do { if (IN(k) && IN((k) + 1)) xcd_barrier(bar); } while (0)
    if (IN(0)) { p0_phase(args, lds, vcu, G, wave, lane); if (REP_PHASE == 0 || REP_PHASE == 60) { xcd_barrier(bar); p0_phase(args, lds, vcu, G, wave, lane); } }
    SEAM(0);
    if (IN(1)) {
        p1_skinny(args, vcu, G, wave, lane);
        const bf16_t* XW = (const bf16_t*)(ws + WS_XW);
        pg8::Gemm g{XW, XW, NTOK, 7168, DM};
        OrderIn S{G, bx};
        EpiIn E{(bf16_t*)(ws + WS_QG), (bf16_t*)(ws + WS_KG), (bf16_t*)args.out, (bf16_t*)args.out + (size_t)NTOK * 1024, (bf16_t*)(ws + WS_AO), (bf16_t*)(ws + WS_NK),
                (bf16_t*)(ws + WS_VGT), (bf16_t*)(ws + WS_NVT), args.qn_g, args.kn_g};
        pg8::gemm_phase<EpiIn, OrderIn, true, true>((PG8_LAS unsigned char*)lds, g, S, E);
        }
#if REP_PHASE == 1
    if (IN(1)) { xcd_barrier(bar);
        p1_skinny(args, vcu, G, wave, lane);
        const bf16_t* XW = (const bf16_t*)(ws + WS_XW);
        pg8::Gemm g{XW, XW, NTOK, 7168, DM};
        OrderIn S{G, bx};
        EpiIn E{(bf16_t*)(ws + WS_QG), (bf16_t*)(ws + WS_KG), (bf16_t*)args.out, (bf16_t*)args.out + (size_t)NTOK * 1024, (bf16_t*)(ws + WS_AO), (bf16_t*)(ws + WS_NK),
                (bf16_t*)(ws + WS_VGT), (bf16_t*)(ws + WS_NVT), args.qn_g, args.kn_g};
        pg8::gemm_phase<EpiIn, OrderIn, true, true>((PG8_LAS unsigned char*)lds, g, S, E);
        }
#endif
    SEAM(1);
    if (IN(2)) {
#if REP_PHASE == 2
        na_phase(args, lds, vcu, G, wave, lane, (bf16_t*)(ws + WS_XW), 1024); xcd_barrier(bar);
#endif
        na_phase(args, lds, vcu, G, wave, lane, (bf16_t*)(ws + WS_AO) + 1024, 2048); }
    SEAM(2);
    if (IN(3)) { prep_phase(args, lds, vcu, G, wave, lane); if (REP_PHASE == 3) { xcd_barrier(bar); prep_phase(args, lds, vcu, G, wave, lane); } }
    SEAM(3);
    if (IN(4)) { scan_phase(args, lds, wave, lane); if (REP_PHASE == 4) { xcd_barrier(bar); scan_phase(args, lds, wave, lane); } }
    SEAM(4);
#ifdef REP_SYNC
    for (int i_ = 0; i_ < REP_SYNC; ++i_) xcd_barrier(bar);
#endif
    if (IN(5)) {
#if REP_PHASE == 5
        combine_phase(args, vcu, G, wave, lane, (bf16_t*)(ws + WS_XW), 1024); xcd_barrier(bar);
#endif
        combine_phase(args, vcu, G, wave, lane, (bf16_t*)(ws + WS_AO), 2048); }
    SEAM(5);
    if (IN(6)) {
        pg8::Gemm g{(const bf16_t*)(ws + WS_AO), (const bf16_t*)(ws + WS_WO), NTOK, DM, 2048};
        pg8::StaticOrder S; S.init(NTOK, DM, G, bx);
        EpiOut E{args.x, args.out};
        pg8::gemm_phase<EpiOut, pg8::StaticOrder, false, true>((PG8_LAS unsigned char*)lds, g, S, E);
        }
#if REP_PHASE == 6 || REP_PHASE == 60
    if (IN(6)) { xcd_barrier(bar);
        pg8::Gemm g{(const bf16_t*)(ws + WS_AO), (const bf16_t*)(ws + WS_WO), NTOK, DM, 2048};
        pg8::StaticOrder S; S.init(NTOK, DM, G, bx);
        EpiOut E{args.x, args.out};
        pg8::gemm_phase<EpiOut, pg8::StaticOrder, false, true>((PG8_LAS unsigned char*)lds, g, S, E);
        }
#endif
#ifdef SCAN_DBG
    if (bx == 0 && tid == 0) { const float* dbg = (const float*)(ws + WS_ZM + 480 * 1024); const float ratio = dbg[0] / dbg[1];
        args.out[0] = (DBG_WHAT == 0) ? (ratio < 0.33f ? 100.f : (ratio < 0.66f ? 200.f : 300.f)) : (dbg[1] < 10000.f ? 100.f : (dbg[1] < 15000.f ? 200.f : (dbg[1] < 20000.f ? 300.f : 400.f))); }
#endif
#ifdef SCAN_DBG
    if (bx == 0 && tid == 0) { const float* dbg = (const float*)(ws + WS_ZM + 480 * 1024);
        const float ratio = (DBG_WHAT == 0 ? dbg[0] : dbg[2]) / dbg[1];
        args.out[0] = (DBG_WHAT == 2) ? 100.f * floorf(dbg[1] * (1.f / 100000.f) + 1.f) : 100.f * (1.f + floorf(ratio * 5.f)); }
#endif
#undef IN
#undef SEAM
}

#ifndef N_LAUNCHES
#define N_LAUNCHES 1
#endif
extern "C" void kernel_launch(void* const* d_in, const int* in_sizes, int n_in, void* d_out, int out_size, void* d_ws, size_t ws_size, hipStream_t stream) {
    static int grid = 0;
    if (grid == 0) {
        if (n_in != 14 || out_size != NTOK * DM || ws_size < WS_END) { fprintf(stderr, "kernel_launch: unexpected problem (n_in %d out %d ws %zu)\n", n_in, out_size, ws_size); grid = -1; return; }
        int dev = 0, cus = 0, per_cu = 0;
        hipGetDevice(&dev); hipDeviceGetAttribute(&cus, hipDeviceAttributeMultiprocessorCount, dev);
        if (hipFuncSetAttribute((const void*)hybrid_fwd, hipFuncAttributeMaxDynamicSharedMemorySize, LDS_BYTES) != hipSuccess) { fprintf(stderr, "kernel_launch: hipFuncSetAttribute failed\n"); grid = -1; return; }
        if (hipOccupancyMaxActiveBlocksPerMultiprocessor(&per_cu, (const void*)hybrid_fwd, NWAVES * 64, LDS_BYTES) != hipSuccess || per_cu < 1) { fprintf(stderr, "kernel_launch: occupancy query gave %d\n", per_cu); per_cu = 1; }
        (void)hipGetLastError();
        grid = cus * per_cu;
        if (grid > 256) grid = 256;
    }
    if (grid < 0) return;
    Args a{};
    a.x = (const float*)d_in[0]; a.meta = (const float*)d_in[1]; a.norm_g = (const float*)d_in[2]; a.w_in = (const float*)d_in[3];
    a.wd_f = (const float*)d_in[4]; a.bd_f = (const float*)d_in[5]; a.wd_b = (const float*)d_in[6]; a.bd_b = (const float*)d_in[7];
    a.gla_g = (const float*)d_in[8]; a.qn_g = (const float*)d_in[9]; a.kn_g = (const float*)d_in[10]; a.rpb = (const float*)d_in[11];
    a.meta_bias = (const float*)d_in[12]; a.w_out = (const float*)d_in[13];
    a.out = (float*)d_out; a.ws = (unsigned char*)d_ws;
    if (hipMemsetAsync((char*)d_ws + WS_CTL, 0, 16384, stream) != hipSuccess) { fprintf(stderr, "kernel_launch: memset of the barrier words failed\n"); return; }
#if N_LAUNCHES == 1
    int lo = 0, hi = 7;
    void* kargs[] = {&a, &lo, &hi};
    hipError_t e = hipLaunchCooperativeKernel((const void*)hybrid_fwd, dim3(grid), dim3(NWAVES * 64), kargs, LDS_BYTES, stream);
    if (e != hipSuccess) fprintf(stderr, "kernel_launch: cooperative launch failed: %s (grid %d)\n", hipGetErrorString(e), grid);
#else
    for (int p = 0; p < 7; ++p) hipLaunchKernelGGL(hybrid_fwd, dim3(grid), dim3(NWAVES * 64), LDS_BYTES, stream, a, p, p + 1);
#endif
}
```
